# Optimizing an MI355X kernel written in HIP

```python
import math
import jax
import jax.numpy as jnp
from jax import lax
import numpy as np

D_MODEL = 1024
BATCH = 4
SEQ = 8192
DEPTH = 2

GRID_W = 64
N_MEM = 256
HEAD_DIM = 64
N_MIXERS = 4
MIXER_WIDTH = D_MODEL // N_MIXERS
MIXER_HEADS = MIXER_WIDTH // HEAD_DIM
D_MIX = N_MIXERS * MIXER_WIDTH

NA_KH_MAX = 8
NA_KW = 16
NA_QCB = 16
NA_KCB = 32

RET_CHUNK = 128
ROPE_BASE = 10000.0

POOL_WINDOWS = (2, 4, 8, 16)
POOL_GROUP = MIXER_WIDTH // 4

GDN_CHUNK = 64
CONV_K = 4

MEM_HEADS = 4
MEM_HEAD_DIM = D_MODEL // MEM_HEADS

N_GROUPS = 4
EXPERTS_PER_GROUP = 8
N_EXPERTS = N_GROUPS * EXPERTS_PER_GROUP
TOP_K = 2
D_EXPERT = D_MODEL // 2
MOE_BLOCK = 128

EPS = 1e-6
F32 = jnp.float32

IN_SPLITS = (3 * MIXER_WIDTH, 7 * MIXER_WIDTH, 8 * MIXER_WIDTH, 12 * MIXER_WIDTH)
P_IN = 12 * MIXER_WIDTH + 4 * MIXER_HEADS

kernel_name = 'hybrid_parallel_heads_encoder'


def rmsnorm(x, g):
    xf = x.astype(F32)
    y = xf * lax.rsqrt(jnp.mean(xf * xf, axis=-1, keepdims=True) + EPS)
    return (y * g.astype(F32)).astype(x.dtype)


def neighbourhood_attention(q, k, v, rpb):
    b, s, _ = q.shape
    h, dh = MIXER_HEADS, HEAD_DIM
    rows = s // GRID_W
    kh = min(NA_KH_MAX, rows)
    ncb = GRID_W // NA_QCB
    r = np.arange(rows)
    key_rows = np.clip(r - kh // 2, 0, rows - kh)[:, None] + np.arange(kh)[None, :]
    band = np.clip(np.arange(ncb) * NA_QCB - NA_KW // 2, 0, GRID_W - NA_KCB)
    key_cols = band[:, None] + np.arange(NA_KCB)[None, :]
    q_cols = np.arange(GRID_W).reshape(ncb, NA_QCB)
    win = np.clip(q_cols - NA_KW // 2, 0, GRID_W - NA_KW)
    col_ok = (key_cols[:, None, :] >= win[:, :, None]) & (key_cols[:, None, :] < win[:, :, None] + NA_KW)
    n_keys = kh * NA_KCB
    mask = np.broadcast_to(col_ok[:, :, None, :], (ncb, NA_QCB, kh, NA_KCB)).reshape(ncb, NA_QCB, n_keys)
    key_idx = (key_rows[:, None, :, None] * GRID_W + key_cols[None, :, None, :]).reshape(rows, ncb, n_keys)
    d_row = key_rows - r[:, None] + (NA_KH_MAX - 1)
    d_col = np.clip(key_cols[:, None, :] - q_cols[:, :, None], -(NA_KW - 1), NA_KW - 1) + (NA_KW - 1)
    bias = rpb[:, d_row[:, None, None, :, None], d_col[None, :, :, None, :]]
    bias = bias.reshape(h, rows, ncb, NA_QCB, n_keys).astype(F32)
    qg = q.reshape(b, rows, ncb, NA_QCB, h, dh)
    kg = k.reshape(b, s, h, dh)[:, key_idx]
    vg = v.reshape(b, s, h, dh)[:, key_idx]
    scores = jnp.einsum('brnqhd,brnkhd->bhrnqk', qg, kg).astype(F32) * (dh ** -0.5) + bias
    scores = jnp.where(mask, scores, -jnp.inf)
    p = jax.nn.softmax(scores, axis=-1).astype(v.dtype)
    o = jnp.einsum('bhrnqk,brnkhd->brnqhd', p, vg)
    return o.reshape(b, s, h * dh)


def rotary(x):
    s, dh = x.shape[1], x.shape[-1]
    half = dh // 2
    inv = ROPE_BASE ** (-jnp.arange(half, dtype=F32) / half)
    ang = jnp.arange(s, dtype=F32)[:, None] * inv[None, :]
    cos = jnp.cos(ang)[None, :, None, :]
    sin = jnp.sin(ang)[None, :, None, :]
    x1, x2 = x[..., :half], x[..., half:]
    return jnp.concatenate([x1 * cos - x2 * sin, x1 * sin + x2 * cos], axis=-1)


def retention_direction(q, k, v, log_gamma, include_diag):
    b, h, s, d = q.shape
    c = RET_CHUNK
    nc = s // c
    q, k, v = (t.reshape(b, h, nc, c, d) for t in (q, k, v))
    pos = jnp.arange(c, dtype=F32)
    diff = pos[:, None] - pos[None, :]
    keep = diff >= 0 if include_diag else diff > 0
    decay = jnp.where(keep, jnp.exp(log_gamma[:, None, None] * jnp.maximum(diff, 0.0)), 0.0)
    scores = jnp.einsum('bhnid,bhnjd->bhnij', q, k) * decay[:, None]
    o = jnp.einsum('bhnij,bhnjd->bhnid', scores, v)
    k_dec = k * jnp.exp(log_gamma[:, None] * (c - 1 - pos))[:, None, :, None]
    kv = jnp.einsum('bhnjd,bhnje->nbhde', k_dec, v)
    chunk_decay = jnp.exp(log_gamma * c)[None, :, None, None]

    def step(state, kv_n):
        return state * chunk_decay + kv_n, state

    _, prev = lax.scan(step, jnp.zeros((b, h, d, d), kv.dtype), kv)
    q_dec = q * jnp.exp(log_gamma[:, None] * (pos + 1.0))[:, None, :, None]
    o = o + jnp.einsum('bhnid,nbhde->bhnie', q_dec, prev)
    return o.reshape(b, h, s, d)


def retention_mixer(q, k, v, gate, norm_g):
    b, s, _ = q.shape
    h, dh = MIXER_HEADS, HEAD_DIM
    heads = lambda t: t.astype(F32).reshape(b, s, h, dh)
    qh = jnp.swapaxes(rotary(heads(q)), 1, 2)
    kh = jnp.swapaxes(rotary(heads(k)) * (dh ** -0.5), 1, 2)
    vh = jnp.swapaxes(heads(v), 1, 2)
    log_g_fwd = jnp.log1p(-jnp.exp2(-5.0 - jnp.arange(h, dtype=F32)))
    log_g_bwd = log_g_fwd[::-1]
    flip = lambda t: jnp.flip(t, axis=2)
    o_f = retention_direction(qh, kh, vh, log_g_fwd, True)
    o_b = flip(retention_direction(flip(qh), flip(kh), flip(vh), log_g_bwd, False))
    o = jnp.swapaxes(o_f + o_b, 1, 2)
    mu = jnp.mean(o, axis=-1, keepdims=True)
    var = jnp.mean(jnp.square(o - mu), axis=-1, keepdims=True)
    o = ((o - mu) * lax.rsqrt(var + EPS)).reshape(b, s, h * dh) * norm_g.astype(F32)
    o = o * jax.nn.silu(gate.astype(F32))
    return o.astype(q.dtype)


def multiscale_pool(u, w_pool, scale):
    b, s, _ = u.shape
    uf = u.astype(F32)
    csum = jnp.concatenate([jnp.zeros((b, 1, MIXER_WIDTH), F32), jnp.cumsum(uf, axis=1)], axis=1)
    t = np.arange(s)
    diffs = []
    for gi, win in enumerate(POOL_WINDOWS):
        lo = np.clip(t - win // 2, 0, s)
        hi = np.clip(t + win // 2, 0, s)
        sl = slice(gi * POOL_GROUP, (gi + 1) * POOL_GROUP)
        mean = (csum[:, hi, sl] - csum[:, lo, sl]) / (hi - lo).astype(np.float32)[None, :, None]
        diffs.append(mean - uf[..., sl])
    d = jnp.stack(diffs, axis=2)
    y = jnp.einsum('bsgc,gce->bsge', d, w_pool.astype(F32)).reshape(b, s, MIXER_WIDTH) * scale.astype(F32)
    return y.astype(u.dtype)


def short_conv(u, w):
    pad = (CONV_K // 2, CONV_K - 1 - CONV_K // 2)
    return lax.conv_general_dilated(u, w[:, None, :], window_strides=(1,), padding=(pad,),
                                    dimension_numbers=('NWC', 'WIO', 'NWC'),
                                    feature_group_count=u.shape[-1])


def gated_delta_direction(q, k, v, g, beta):
    b, h, s, d = q.shape
    c = GDN_CHUNK
    nc = s // c
    q, k, v = (t.reshape(b, h, nc, c, d) for t in (q, k, v))
    g = g.reshape(b, h, nc, c)
    beta = beta.reshape(b, h, nc, c)
    gc = jnp.cumsum(g, axis=-1)
    idx = jnp.arange(c)
    incl = idx[:, None] >= idx[None, :]
    strict = idx[:, None] > idx[None, :]
    gdiff = gc[..., :, None] - gc[..., None, :]
    decay = jnp.where(incl, jnp.exp(jnp.where(incl, gdiff, 0.0)), 0.0)
    k_beta = k * beta[..., None]
    lmat = jnp.where(strict, jnp.einsum('bhnid,bhnjd->bhnij', k_beta, k) * decay, 0.0)
    rhs = jnp.concatenate([v * beta[..., None], k_beta * jnp.exp(gc)[..., None]], axis=-1)
    sol = lax.linalg.triangular_solve(lmat + jnp.eye(c, dtype=F32), rhs, left_side=True, lower=True)
    u_val, w_dec = sol[..., :d], sol[..., d:]
    attn = jnp.einsum('bhnid,bhnjd->bhnij', q, k) * decay
    q_dec = q * jnp.exp(gc)[..., None]
    g_last = gc[..., -1]
    k_state = k * jnp.exp(g_last[..., None] - gc)[..., None]

    def step(state, inp):
        q_n, u_n, w_n, a_n, ks_n, gl_n = inp
        v_new = u_n - jnp.einsum('bhcd,bhde->bhce', w_n, state)
        o_n = jnp.einsum('bhcd,bhde->bhce', q_n, state) + jnp.einsum('bhij,bhje->bhie', a_n, v_new)
        state = state * jnp.exp(gl_n)[..., None, None] + jnp.einsum('bhcd,bhce->bhde', ks_n, v_new)
        return state, o_n

    to_scan = lambda t: jnp.moveaxis(t, 2, 0)
    xs = (to_scan(q_dec), to_scan(u_val), to_scan(w_dec), to_scan(attn), to_scan(k_state), to_scan(g_last))
    _, o = lax.scan(step, jnp.zeros((b, h, d, d), F32), xs)
    return jnp.moveaxis(o, 0, 2).reshape(b, h, s, d)


def gated_deltanet_mixer(qkv, gate, ab, conv_w, a_log, dt_bias, norm_g):
    b, s, _ = qkv.shape
    h, dh = MIXER_HEADS, HEAD_DIM
    u = jax.nn.silu(short_conv(qkv.astype(F32), conv_w.astype(F32)))
    q, k, v = (jnp.swapaxes(t.reshape(b, s, h, dh), 1, 2) for t in jnp.split(u, 3, axis=-1))
    q = q * lax.rsqrt(jnp.sum(q * q, axis=-1, keepdims=True) + EPS) * (dh ** -0.5)
    k = k * lax.rsqrt(jnp.sum(k * k, axis=-1, keepdims=True) + EPS)
    a_f, a_b, b_f, b_b = jnp.transpose(ab.astype(F32).reshape(b, s, 4, h), (2, 0, 3, 1))
    a_log = a_log.astype(F32)
    dt_bias = dt_bias.astype(F32)
    g_f = -jnp.exp(a_log[0])[None, :, None] * jax.nn.softplus(a_f + dt_bias[0][None, :, None])
    g_b = -jnp.exp(a_log[1])[None, :, None] * jax.nn.softplus(a_b + dt_bias[1][None, :, None])
    flip = lambda t: jnp.flip(t, axis=2)
    o_f = gated_delta_direction(q, k, v, g_f, jax.nn.sigmoid(b_f))
    o_b = flip(gated_delta_direction(flip(q), flip(k), flip(v), flip(g_b), flip(jax.nn.sigmoid(b_b))))
    o = jnp.swapaxes(o_f + o_b, 1, 2)
    o = o * lax.rsqrt(jnp.mean(o * o, axis=-1, keepdims=True) + EPS) * norm_g.astype(F32)
    o = o * jax.nn.silu(gate.astype(F32).reshape(b, s, h, dh))
    return o.reshape(b, s, MIXER_WIDTH).astype(qkv.dtype)


def memory_cross_attention(hq, m, w_q, w_k, w_v, w_o):
    b, s, _ = hq.shape
    nm = m.shape[1]
    q = (hq @ w_q).reshape(b, s, MEM_HEADS, MEM_HEAD_DIM)
    k = (m @ w_k).reshape(b, nm, MEM_HEADS, MEM_HEAD_DIM)
    v = (m @ w_v).reshape(b, nm, MEM_HEADS, MEM_HEAD_DIM)
    scores = jnp.einsum('bshe,bmhe->bhsm', q, k).astype(F32) * (MEM_HEAD_DIM ** -0.5)
    p = jax.nn.softmax(scores, axis=-1).astype(v.dtype)
    o = jnp.einsum('bhsm,bmhe->bshe', p, v).reshape(b, s, D_MODEL)
    return o @ w_o


def hierarchical_moe(hx, w_group, b_group, w_router, b_router, w_gate, w_up, w_down):
    b, s, d = hx.shape
    n = b * s
    hf = hx.reshape(n, d)
    g_prob = jax.nn.softmax((hf @ w_group).astype(F32) + b_group.astype(F32), axis=-1)
    g_p, g_idx = lax.top_k(g_prob, 1)
    e_logits = ((hf @ w_router).astype(F32) + b_router.astype(F32)).reshape(n, N_GROUPS, EXPERTS_PER_GROUP)
    e_logits = jnp.take_along_axis(e_logits, g_idx[:, :, None], axis=1)[:, 0]
    e_p, e_loc = lax.top_k(jax.nn.softmax(e_logits, axis=-1), TOP_K)
    gate_w = g_p * e_p / jnp.sum(e_p, axis=-1, keepdims=True)
    expert = g_idx * EXPERTS_PER_GROUP + e_loc
    a = n * TOP_K
    flat_e = expert.reshape(a)
    order = jnp.argsort(flat_e)
    e_sorted = flat_e[order]
    tok_sorted = (order // TOP_K).astype(jnp.int32)
    w_sorted = gate_w.reshape(a)[order]
    counts = jax.ops.segment_sum(jnp.ones((a,), jnp.int32), flat_e, num_segments=N_EXPERTS)
    padded = (counts + MOE_BLOCK - 1) // MOE_BLOCK * MOE_BLOCK
    pad_end = jnp.cumsum(padded)
    pad_start = pad_end - padded
    start = jnp.cumsum(counts) - counts
    dest = pad_start[e_sorted] + jnp.arange(a, dtype=jnp.int32) - start[e_sorted]
    cap = a + N_EXPERTS * MOE_BLOCK
    n_blocks = cap // MOE_BLOCK
    buf_tok = jnp.zeros((cap,), jnp.int32).at[dest].set(tok_sorted)
    buf_w = jnp.zeros((cap,), F32).at[dest].set(w_sorted)
    blk_start = jnp.arange(n_blocks, dtype=jnp.int32) * MOE_BLOCK
    blk_expert = jnp.minimum(jnp.searchsorted(pad_end, blk_start, side='right'), N_EXPERTS - 1)

    def expert_block(args):
        tok, wt, e = args
        xb = hf[tok]
        y = (jax.nn.silu(xb @ w_gate[e]) * (xb @ w_up[e])) @ w_down[e]
        return y * wt[:, None].astype(y.dtype)

    ys = lax.map(expert_block, (buf_tok.reshape(n_blocks, MOE_BLOCK), buf_w.reshape(n_blocks, MOE_BLOCK), blk_expert))
    out = jax.ops.segment_sum(ys.reshape(cap, d), buf_tok, num_segments=n)
    return out.reshape(b, s, d)


def setup_inputs(seed: int = 0) -> dict:
    key = jax.random.key(seed)
    k = jax.random.split(key, 28)
    L, D, W, H = DEPTH, D_MODEL, MIXER_WIDTH, MIXER_HEADS

    def nrm(i, shape, scale):
        return jax.random.normal(k[i], shape, F32) * scale

    def gain(i, shape):
        return 1.0 + 0.05 * jax.random.normal(k[i], shape, F32)

    dt = jnp.exp(jax.random.uniform(k[10], (L, 2, H), F32, math.log(1e-3), math.log(1e-1)))
    return {
        'x': nrm(0, (BATCH, SEQ, D), 1.0),
        'mem': nrm(1, (BATCH, N_MEM, D), 1.0),
        'mix_norm_g': gain(2, (L, D)),
        'w_in': nrm(3, (L, D, P_IN), D ** -0.5),
        'na_rpb': nrm(4, (L, H, 2 * NA_KH_MAX - 1, 2 * NA_KW - 1), 0.1),
        'ret_norm_g': gain(5, (L, W)),
        'pool_w': nrm(6, (L, len(POOL_WINDOWS), POOL_GROUP, POOL_GROUP), POOL_GROUP ** -0.5),
        'pool_scale': gain(7, (L, W)),
        'gdn_conv_w': nrm(8, (L, CONV_K, 3 * W), CONV_K ** -0.5),
        'gdn_a_log': jnp.log(jax.random.uniform(k[9], (L, 2, H), F32, 1.0, 16.0)),
        'gdn_dt_bias': dt + jnp.log(-jnp.expm1(-dt)),
        'gdn_norm_g': gain(11, (L, HEAD_DIM)),
        'w_out': nrm(12, (L, D_MIX, D), D_MIX ** -0.5),
        'mem_q_norm_g': gain(13, (L, D)),
        'mem_kv_norm_g': gain(14, (L, D)),
        'mem_w_q': nrm(15, (L, D, D), D ** -0.5),
        'mem_w_k': nrm(16, (L, D, D), D ** -0.5),
        'mem_w_v': nrm(17, (L, D, D), D ** -0.5),
        'mem_w_o': nrm(18, (L, D, D), D ** -0.5),
        'ffn_norm_g': gain(19, (L, D)),
        'w_group': nrm(20, (L, D, N_GROUPS), D ** -0.5),
        'b_group': nrm(21, (L, N_GROUPS), 0.01),
        'w_router': nrm(22, (L, D, N_EXPERTS), D ** -0.5),
        'b_router': nrm(23, (L, N_EXPERTS), 0.01),
        'w_gate': nrm(24, (L, N_EXPERTS, D, D_EXPERT), D ** -0.5),
        'w_up': nrm(25, (L, N_EXPERTS, D, D_EXPERT), D ** -0.5),
        'w_down': nrm(26, (L, N_EXPERTS, D_EXPERT, D), D_EXPERT ** -0.5),
        'final_norm_g': gain(27, (D,)),
    }


def reference(x, mem, mix_norm_g, w_in, na_rpb, ret_norm_g, pool_w, pool_scale, gdn_conv_w,
              gdn_a_log, gdn_dt_bias, gdn_norm_g, w_out, mem_q_norm_g, mem_kv_norm_g, mem_w_q,
              mem_w_k, mem_w_v, mem_w_o, ffn_norm_g, w_group, b_group, w_router, b_router,
              w_gate, w_up, w_down, final_norm_g):
    W = MIXER_WIDTH
    for l in range(DEPTH):
        h = rmsnorm(x, mix_norm_g[l])
        proj = h @ w_in[l]
        p_a, p_b, p_c, p_d, p_ab = jnp.split(proj, IN_SPLITS, axis=-1)
        qa, ka, va = jnp.split(p_a, 3, axis=-1)
        y_a = neighbourhood_attention(qa, ka, va, na_rpb[l])
        qb, kb, vb, gb = jnp.split(p_b, 4, axis=-1)
        y_b = retention_mixer(qb, kb, vb, gb, ret_norm_g[l])
        y_c = multiscale_pool(p_c, pool_w[l], pool_scale[l])
        y_d = gated_deltanet_mixer(p_d[..., :3 * W], p_d[..., 3 * W:], p_ab, gdn_conv_w[l],
                                   gdn_a_log[l], gdn_dt_bias[l], gdn_norm_g[l])
        x = x + jnp.concatenate([y_a, y_b, y_c, y_d], axis=-1) @ w_out[l]
        x = x + memory_cross_attention(rmsnorm(x, mem_q_norm_g[l]), rmsnorm(mem, mem_kv_norm_g[l]),
                                       mem_w_q[l], mem_w_k[l], mem_w_v[l], mem_w_o[l])
        x = x + hierarchical_moe(rmsnorm(x, ffn_norm_g[l]), w_group[l], b_group[l], w_router[l],
                                 b_router[l], w_gate[l], w_up[l], w_down[l])
    return rmsnorm(x, final_norm_g)
```

```cpp
#include <hip/hip_runtime.h>
#include <stdint.h>
#include <stdio.h>

#define LAS __attribute__((address_space(3)))
#define GAS __attribute__((address_space(1)))
typedef unsigned short bf16_t;
typedef short bf16x8 __attribute__((ext_vector_type(8)));
typedef float f32x4 __attribute__((ext_vector_type(4)));
typedef float f32x2 __attribute__((ext_vector_type(2)));
typedef unsigned u32x4 __attribute__((ext_vector_type(4)));
typedef unsigned u32x2 __attribute__((ext_vector_type(2)));

#ifndef MK_ONE_LAUNCH
#define MK_ONE_LAUNCH 0
#endif

constexpr int NB = 4, SEQ = 8192, DM = 1024, NTOK = NB * SEQ, NMEM = 256, DEPTH = 2;
constexpr int PINP = 3328;
constexpr int NEXP = 32, DEXP = 512;
constexpr int CAP = NTOK * 2 + NEXP * 256;
constexpr float EPS = 1e-6f;
constexpr int NWAVES = 8, NTHREADS = 512;

constexpr size_t MiB = 1u << 20;
constexpr size_t WS_CTL   = 0;
constexpr size_t WS_WIN   = 1 * MiB;
constexpr size_t WS_WOUT  = 14 * MiB;
constexpr size_t WS_WQB   = 18 * MiB;
constexpr size_t WS_WKV   = 22 * MiB;
constexpr size_t WS_WOT   = 30 * MiB;
constexpr size_t WS_MEMN  = 34 * MiB;
constexpr size_t WS_KV    = 38 * MiB;
constexpr size_t WS_KQT   = 46 * MiB;
constexpr size_t WS_VOT   = 62 * MiB;
constexpr size_t WS_SSQ   = 78 * MiB;
constexpr size_t WS_TAB   = 80 * MiB;
constexpr size_t WS_XB    = 84 * MiB;
constexpr size_t WS_STAGE = 148 * MiB;
constexpr size_t WS_PROJ  = WS_STAGE;
constexpr size_t WS_AB    = WS_PROJ + 192 * MiB;
constexpr size_t WS_YCAT  = WS_AB + 2 * MiB;
constexpr size_t WS_MIXS  = WS_YCAT + 64 * MiB;
constexpr size_t WS_RET   = WS_MIXS + 128 * MiB;
constexpr size_t WS_MIX_END = WS_RET + 32 * MiB;
constexpr size_t WS_P     = WS_STAGE;
constexpr size_t WS_WGU   = WS_STAGE;
constexpr size_t WS_WD    = WS_WGU + 64 * MiB;
constexpr size_t WS_SORTA = WS_WD + 32 * MiB;
constexpr size_t WS_HMID  = WS_SORTA + 144 * MiB;
constexpr size_t WS_SLOT  = WS_HMID + 72 * MiB;
constexpr size_t WS_MOE_END = WS_SLOT + 2 * MiB;
constexpr size_t WS_END = WS_MIX_END > WS_MOE_END ? WS_MIX_END : WS_MOE_END;
static_assert(WS_END <= 580 * MiB, "workspace budget");
constexpr size_t TAB_ROPE = 0;
constexpr size_t TAB_RFR  = 2 * MiB;
constexpr size_t TAB_POOL = 3 * MiB;
constexpr size_t SL_TOK = 0, SL_W = 512 * 1024, SL_RSTD = 1024 * 1024, SL_TSLOT = 1536 * 1024;
constexpr size_t TAB_TOKE = 3 * MiB + 256 * 1024;
constexpr size_t TAB_TOKW = 3 * MiB + 512 * 1024;
constexpr int CW_BAR = 4096;
constexpr int CW_CNT = 16384;
constexpr int CW_CUR = 16384 + 64;
constexpr size_t CTL_ZERO_BYTES = 1 * MiB;

constexpr int LDS_RING = 0, LDS_RING_BYTES = 131072;
constexpr int LDS_EX = 131072;
constexpr int LDS_MISC = 131072 + 8192;
constexpr int LDS_BYTES = 147456;

__device__ __forceinline__ unsigned f2bf(float f) { unsigned u = __builtin_bit_cast(unsigned, f); return (u + 0x7fffu + ((u >> 16) & 1u)) >> 16; }
__device__ __forceinline__ unsigned pk2(float lo, float hi) { return f2bf(lo) | (f2bf(hi) << 16); }
__device__ __forceinline__ float bflo(unsigned w) { return __builtin_bit_cast(float, w << 16); }
__device__ __forceinline__ float bfhi(unsigned w) { return __builtin_bit_cast(float, w & 0xffff0000u); }
__device__ __forceinline__ float bf2f(bf16_t b) { return __builtin_bit_cast(float, ((unsigned)b) << 16); }
__device__ __forceinline__ float wave_sum(float v) {
#pragma unroll
    for (int o = 1; o < 64; o <<= 1) v += __shfl_xor(v, o);
    return v;
}
__device__ __forceinline__ float wave_max(float v) {
#pragma unroll
    for (int o = 1; o < 64; o <<= 1) v = fmaxf(v, __shfl_xor(v, o));
    return v;
}
__device__ __forceinline__ float silu_f(float x) { return x / (1.f + __expf(-x)); }
__device__ __forceinline__ float sigmoid_f(float x) { return 1.f / (1.f + __expf(-x)); }
__device__ __forceinline__ float softplus_f(float x) { return x > 20.f ? x : log1pf(__expf(x)); }
#define LDS_WAIT() asm volatile("s_waitcnt lgkmcnt(0)" ::: "memory")
#define VM_WAIT() asm volatile("s_waitcnt vmcnt(0)" ::: "memory")

#define XB_TMO      128
#define XB_XCNT(j)  (256  + 64 * (j))
#define XB_XSUB(j)  (1280 + 64 * (j))
#define XB_XGEN(j)  (2304 + 64 * (j))
#define XB_TOP      3328
#define XB_TOPGEN   3392
#define XCD_BAR_WORDS 3456
#define XB_SPIN_CAP (1u << 22)

__device__ __forceinline__ unsigned xb_ld(unsigned* p)              { return __hip_atomic_load(p, __ATOMIC_RELAXED, __HIP_MEMORY_SCOPE_AGENT); }
__device__ __forceinline__ unsigned xb_add(unsigned* p, unsigned v) { return __hip_atomic_fetch_add(p, v, __ATOMIC_RELAXED, __HIP_MEMORY_SCOPE_AGENT); }
__device__ __forceinline__ unsigned xb_xcc_id() { return (unsigned)__builtin_amdgcn_s_getreg((3 << 11) | 20) & 0xFu; }
#define XB_SPIN(cond, bar) do { unsigned _sp = 0; while (cond) { __builtin_amdgcn_s_sleep(1); \
    if ((++_sp & 255u) == 0u) { if (xb_ld(&(bar)[XB_TMO])) break; if (_sp > XB_SPIN_CAP) { atomicAdd(&(bar)[XB_TMO], 1u); break; } } } } while (0)

struct XcdBarrier { unsigned* bar; unsigned x; volatile LAS unsigned* st; };

__device__ __forceinline__ XcdBarrier xcd_barrier_post(unsigned* bar, volatile LAS unsigned* st, const bool leader) {
    XcdBarrier b; b.bar = bar; b.x = xb_xcc_id(); b.st = st;
    if (leader) (void)xb_add(&bar[XB_XCNT(b.x)], 1u);
    return b;
}
__device__ __forceinline__ void xcd_barrier_complete(unsigned* bar, unsigned x, unsigned& nloc, unsigned& nx) {
    const unsigned G = gridDim.x * gridDim.y * gridDim.z;
    unsigned sum, cnt, mine, sp = 0u;
    for (;;) {
        sum = 0u; cnt = 0u; mine = 0u;
#pragma unroll
        for (unsigned j = 0; j < 16; ++j) { const unsigned c = xb_ld(&bar[XB_XCNT(j)]); sum += c; cnt += (c > 0u) ? 1u : 0u; mine = (j == x) ? c : mine; }
        if (sum == G) break;
        __builtin_amdgcn_s_sleep(1);
        if ((++sp & 255u) == 0u) { if (xb_ld(&bar[XB_TMO])) break; if (sp > XB_SPIN_CAP) { atomicAdd(&bar[XB_TMO], 1u); break; } }
    }
    nloc = mine > 0u ? mine : 1u; nx = cnt > 0u ? cnt : 1u;
}
__device__ __forceinline__ void xcd_barrier(const XcdBarrier& b, const bool leader) {
    asm volatile("s_waitcnt vmcnt(0)" ::: "memory");
    __syncthreads();
    if (leader) {
        unsigned* bar = b.bar;
        __builtin_amdgcn_s_waitcnt(0);
        unsigned nloc = b.st[0], nx = b.st[1];
        if (nloc == 0u) { xcd_barrier_complete(bar, b.x, nloc, nx); b.st[0] = nloc; b.st[1] = nx; }
        const unsigned old = xb_add(&bar[XB_XSUB(b.x)], 1u);
        const unsigned gen = old / nloc;
        if (old + 1u == (gen + 1u) * nloc) {
            __builtin_amdgcn_fence(__ATOMIC_RELEASE, "agent");
            asm volatile("s_waitcnt vmcnt(0)" ::: "memory");
            const unsigned og = xb_add(&bar[XB_TOP], 1u);
            const unsigned tg = og / nx;
            if (og + 1u == (tg + 1u) * nx) xb_add(&bar[XB_TOPGEN], 1u);
            else XB_SPIN(xb_ld(&bar[XB_TOPGEN]) == tg, bar);
            __builtin_amdgcn_fence(__ATOMIC_ACQUIRE, "agent");
            xb_add(&bar[XB_XGEN(b.x)], 1u);
            asm volatile("s_waitcnt vmcnt(0)" ::: "memory");
        } else {
            XB_SPIN(xb_ld(&bar[XB_XGEN(b.x)]) == gen, bar);
            __builtin_amdgcn_fence(__ATOMIC_ACQUIRE, "agent");
            asm volatile("s_waitcnt vmcnt(0)" ::: "memory");
        }
    }
    __syncthreads();
}

namespace pg8 {
constexpr int BM = 256, BK = 64, HALF = 128, HTB = HALF * BK * 2, STAGE_BYTES = 8 * HTB, NXCD = 8, WGM = 8;
__host__ __device__ __forceinline__ int lds_byte(int r, int c) { const int st = (r >> 4) * 2 + (c >> 5), rr = r & 15, cc = c & 31, ob = rr * 64 + cc * 2; return st * 1024 + (ob ^ (((ob >> 9) & 1) << 5)); }
__host__ __device__ __forceinline__ void stage_rc(int b, int& R, int& C) { const int st = b / 1024, sb = b % 1024, swz = sb ^ (((sb >> 9) & 1) << 5); R = (st >> 1) * 16 + swz / 64; C = (st & 1) * 32 + (swz % 64) / 2; }
__host__ __device__ __forceinline__ int perm32(int rho) { const int n = rho >> 4, i = rho & 15; return 8 * (i >> 2) + 4 * n + (i & 3); }

struct Unit { int pm, pn, z; };
struct Gemm { int lda, ldb, K; };

__device__ __forceinline__ void static_map(int wgid, int nM, int nN, int& pm, int& pn) {
    const int nwg = nM * nN;
    { const int q = nwg / NXCD, r = nwg % NXCD, xcd = wgid % NXCD, off = wgid / NXCD; wgid = (xcd < r ? xcd * (q + 1) : r * (q + 1) + (xcd - r) * q) + off; }
    const int nig = WGM * nN, gid = wgid / nig, fm = gid * WGM, gsz = (nM - fm) < WGM ? (nM - fm) : WGM;
    pm = fm + ((wgid % nig) % gsz); pn = (wgid % nig) / gsz;
}

__device__ __forceinline__ unsigned cvt_pk_bf16(float lo, float hi) { unsigned r; asm volatile("v_cvt_pk_bf16_f32 %0, %1, %2" : "=v"(r) : "v"(lo), "v"(hi)); return r; }

template <class Epi, class Sched>
__device__ __forceinline__ void gemm_phase(LAS unsigned char* lds, const int tid, const Gemm g, const Sched& S, const Epi& E) {
    const int wid = __builtin_amdgcn_readfirstlane(tid >> 6), lane = tid & 63, wr = wid >> 2, wc = wid & 3, fr = lane & 15, fq = lane >> 4;
    const int K = g.K, nt = K / BK;
    unsigned voffA[2], voffB[2];
#pragma unroll
    for (int i = 0; i < 2; ++i) { int R, C; stage_rc(tid * 16 + i * 8192, R, C); const int Rb = Epi::PERM ? ((R & ~31) + perm32(R & 31)) : R;
        voffA[i] = (unsigned)(R * g.lda + C) * 2u; voffB[i] = (unsigned)(Rb * g.ldb + C) * 2u; }
    const size_t kstep = (size_t)(BK * 2);
    const size_t hstepA = (size_t)HALF * g.lda * 2, hstepB = (size_t)HALF * g.ldb * 2;
    const unsigned ldsw = (unsigned)wid * 1024u;
    const int aoff = lds_byte(wr * 64 + fr, fq * 8), boff = lds_byte(wc * 32 + fr, fq * 8);
#define PG8_SA(b, h) (((b) * 2 + (h)) * HTB)
#define PG8_SB(b, h) ((4 + (b) * 2 + (h)) * HTB)
#define PG8_STAGE(bufoff, gbase, voff) do { _Pragma("unroll") for (int _i = 0; _i < 2; ++_i) \
        __builtin_amdgcn_global_load_lds((const unsigned*)((const char*)(gbase) + (voff)[_i]), (LAS unsigned*)(lds + (bufoff) + ldsw + _i * 8192), 16, 0, 0); } while (0)
#define PG8_LDA(dst, b, h) do { _Pragma("unroll") for (int m = 0; m < 4; ++m) _Pragma("unroll") for (int k = 0; k < 2; ++k) dst[m][k] = *(const LAS bf16x8*)(lds + PG8_SA(b, h) + aoff + m * 2048 + k * 1024); } while (0)
#define PG8_LDB(dst, b, h) do { _Pragma("unroll") for (int n = 0; n < 2; ++n) _Pragma("unroll") for (int k = 0; k < 2; ++k) dst[n][k] = *(const LAS bf16x8*)(lds + PG8_SB(b, h) + boff + n * 2048 + k * 1024); } while (0)
#define PG8_MMA(ai, bj, At, Bt) do { __builtin_amdgcn_s_setprio(1); _Pragma("unroll") for (int m = 0; m < 4; ++m) _Pragma("unroll") for (int n = 0; n < 2; ++n) _Pragma("unroll") for (int k = 0; k < 2; ++k) \
        acc[ai][bj][m][n] = __builtin_amdgcn_mfma_f32_16x16x32_bf16(Bt[n][k], At[m][k], acc[ai][bj][m][n], 0, 0, 0); __builtin_amdgcn_s_setprio(0); } while (0)
#define PG8_WAIT_V(n) asm volatile("s_waitcnt vmcnt(" #n ")" ::: "memory")
#define PG8_WAIT_L(n) asm volatile("s_waitcnt lgkmcnt(" #n ")" ::: "memory")
#define PG8_BAR __builtin_amdgcn_s_barrier()
#define PG8_SCHED __builtin_amdgcn_sched_barrier(0)
    Unit cur, nxt; int ui = 0;
    if (!S.next(0, cur)) return;
    f32x4 acc[2][2][4][2];
#pragma unroll
    for (int a = 0; a < 2; ++a)
#pragma unroll
        for (int b = 0; b < 2; ++b)
#pragma unroll
            for (int m = 0; m < 4; ++m)
#pragma unroll
                for (int n = 0; n < 2; ++n) acc[a][b][m][n] = (f32x4){0.f, 0.f, 0.f, 0.f};
    bf16x8 At[4][2], B0[2][2], B1[2][2];
    const char* cA = S.a_ptr(cur); const char* cB = S.b_ptr(cur);
    {
        PG8_STAGE(PG8_SB(0, 0), cB, voffB); PG8_STAGE(PG8_SB(0, 1), cB + hstepB, voffB); PG8_STAGE(PG8_SA(0, 0), cA, voffA); PG8_STAGE(PG8_SA(0, 1), cA + hstepA, voffA);
        if (wr == 1) PG8_BAR;
        PG8_WAIT_V(2); PG8_BAR;
        PG8_STAGE(PG8_SB(1, 0), cB + kstep, voffB); PG8_STAGE(PG8_SA(1, 0), cA + kstep, voffA); PG8_STAGE(PG8_SB(1, 1), cB + hstepB + kstep, voffB);
        PG8_WAIT_V(6); PG8_BAR;
    }
    for (;;) {
        const bool has_next = S.next(ui + 1, nxt);
        const char* nA = has_next ? S.a_ptr(nxt) : cA; const char* nB = has_next ? S.b_ptr(nxt) : cB;
        for (int t = 0; t < nt; t += 2) {
            const bool last = (t == nt - 2);
            const char* a1 = cA + (size_t)(t + 1) * kstep;
            const char* a2 = last ? nA : cA + (size_t)(t + 2) * kstep; const char* b2 = last ? nB : cB + (size_t)(t + 2) * kstep;
            const char* a3 = a2 + kstep; const char* b3 = b2 + kstep;
            PG8_LDB(B0, 0, 0); PG8_LDB(B1, 0, 1); PG8_SCHED; PG8_LDA(At, 0, 0); PG8_STAGE(PG8_SA(1, 1), a1 + hstepA, voffA);
            PG8_WAIT_V(8); PG8_WAIT_L(0); PG8_BAR; PG8_MMA(0, 0, At, B0); PG8_MMA(0, 1, At, B1); PG8_BAR; PG8_SCHED;
            PG8_LDA(At, 0, 1); PG8_STAGE(PG8_SB(0, 0), b2, voffB); PG8_STAGE(PG8_SB(0, 1), b2 + hstepB, voffB); PG8_STAGE(PG8_SA(0, 0), a2, voffA);
            PG8_WAIT_V(8); PG8_WAIT_L(0); PG8_BAR; PG8_MMA(1, 0, At, B0); PG8_MMA(1, 1, At, B1); PG8_BAR; PG8_SCHED;
            PG8_LDB(B0, 1, 0); PG8_LDB(B1, 1, 1); PG8_SCHED; PG8_LDA(At, 1, 0); PG8_STAGE(PG8_SA(0, 1), a2 + hstepA, voffA);
            PG8_WAIT_V(8); PG8_WAIT_L(0); PG8_BAR; PG8_MMA(0, 0, At, B0); PG8_MMA(0, 1, At, B1); PG8_BAR; PG8_SCHED;
            PG8_LDA(At, 1, 1); PG8_STAGE(PG8_SB(1, 0), b3, voffB); PG8_STAGE(PG8_SB(1, 1), b3 + hstepB, voffB); PG8_STAGE(PG8_SA(1, 0), a3, voffA);
            PG8_WAIT_V(8); PG8_WAIT_L(0); PG8_BAR; PG8_MMA(1, 0, At, B0); PG8_MMA(1, 1, At, B1); PG8_BAR; PG8_SCHED;
        }
        if (wr == 0) PG8_BAR;
        E(acc, cur, wr, wc, fr, fq);
        if (!has_next) break;
#pragma unroll
        for (int a = 0; a < 2; ++a)
#pragma unroll
            for (int b = 0; b < 2; ++b)
#pragma unroll
                for (int m = 0; m < 4; ++m)
#pragma unroll
                    for (int n = 0; n < 2; ++n) acc[a][b][m][n] = (f32x4){0.f, 0.f, 0.f, 0.f};
        cur = nxt; cA = nA; cB = nB; ++ui;
        if (wr == 1) PG8_BAR;
    }
    PG8_WAIT_V(0);
    PG8_BAR;
#undef PG8_SA
#undef PG8_SB
#undef PG8_STAGE
#undef PG8_LDA
#undef PG8_LDB
#undef PG8_MMA
#undef PG8_WAIT_V
#undef PG8_WAIT_L
#undef PG8_BAR
#undef PG8_SCHED
}
}

struct OrdStd {
    const char* A; const char* B; size_t a_tile, b_tile, b_batch; int nM, nN, G, c;
    __device__ __forceinline__ bool next(int i, pg8::Unit& u) const {
        const long L = (long)i * G + c; if (L >= (long)nM * nN) return false;
        pg8::static_map((int)L, nM, nN, u.pm, u.pn); u.z = 0; return true; }
    __device__ __forceinline__ const char* a_ptr(const pg8::Unit& u) const { return A + (size_t)u.pm * a_tile; }
    __device__ __forceinline__ const char* b_ptr(const pg8::Unit& u) const { return B + (size_t)(u.pm >> 5) * b_batch + (size_t)u.pn * b_tile; }
};
struct OrdKV {
    const char* memn; const char* wkv; int G, c;
    __device__ __forceinline__ bool next(int i, pg8::Unit& u) const { const int L = i * G + c; if (L >= 64) return false; u.pm = L >> 3; u.pn = L & 7; u.z = 0; return true; }
    __device__ __forceinline__ const char* a_ptr(const pg8::Unit& u) const { return memn + (size_t)u.pm * 256 * 1024 * 2; }
    __device__ __forceinline__ const char* b_ptr(const pg8::Unit& u) const { return wkv + ((size_t)(u.pm >> 2) * 2048 + (size_t)u.pn * 256) * 1024 * 2; }
};
struct OrdKq {
    const char* kv; const char* wqb; int G, c;
    __device__ __forceinline__ bool next(int i, pg8::Unit& u) const { const int L = i * G + c; if (L >= 128) return false;
        const int l = L >> 6, b = (L >> 4) & 3, h = (L >> 2) & 3, q = L & 3; u.pm = (l * 4 + b) * 4 + h; u.pn = q; u.z = L; return true; }
    __device__ __forceinline__ const char* a_ptr(const pg8::Unit& u) const { const int L = u.z, l = L >> 6, b = (L >> 4) & 3, h = (L >> 2) & 3;
        return kv + (((size_t)l * 1024 + b * 256) * 2048 + h * 256) * 2; }
    __device__ __forceinline__ const char* b_ptr(const pg8::Unit& u) const { const int L = u.z, l = L >> 6, h = (L >> 2) & 3, q = L & 3;
        return wqb + ((size_t)l * 1048576 + (size_t)q * 256 * 1024 + h * 256) * 2; }
};
struct OrdVo {
    const char* kv; const char* wot; int G, c;
    __device__ __forceinline__ bool next(int i, pg8::Unit& u) const { const int L = i * G + c; if (L >= 128) return false;
        const int l = L >> 6, b = (L >> 4) & 3, h = (L >> 2) & 3, q = L & 3; u.pm = (l * 4 + b) * 4 + q; u.pn = h; u.z = L; return true; }
    __device__ __forceinline__ const char* a_ptr(const pg8::Unit& u) const { const int L = u.z, l = L >> 6, h = (L >> 2) & 3, q = L & 3;
        return wot + ((size_t)l * 1048576 + (size_t)q * 256 * 1024 + h * 256) * 2; }
    __device__ __forceinline__ const char* b_ptr(const pg8::Unit& u) const { const int L = u.z, l = L >> 6, b = (L >> 4) & 3, h = (L >> 2) & 3;
        return kv + (((size_t)l * 1024 + b * 256) * 2048 + 1024 + h * 256) * 2; }
};
struct OrdMoE {
    const char* A; const char* B; size_t a_tile, b_exp, b_tile; int nunits; const LAS int* pad_end; int G, c;
    __device__ __forceinline__ bool next(int i, pg8::Unit& u) const {
        const long L = (long)i * G + c; if (L >= nunits) return false;
        u.pm = (int)(L >> 2); u.pn = (int)(L & 3); int e = 0; const int r0 = u.pm * 256;
        for (int j = 0; j < NEXP; ++j) e += (pad_end[j] <= r0) ? 1 : 0;
        u.z = e < NEXP ? e : NEXP - 1; return true; }
    __device__ __forceinline__ const char* a_ptr(const pg8::Unit& u) const { return A + (size_t)u.pm * a_tile; }
    __device__ __forceinline__ const char* b_ptr(const pg8::Unit& u) const { return B + (size_t)u.z * b_exp + (size_t)u.pn * b_tile; }
};

typedef const f32x4 (&AccRef)[2][2][4][2];
__device__ __forceinline__ float row_rstd(const float* ssq, int row) {
    const f32x4* p = (const f32x4*)(ssq + (size_t)row * 16);
    const f32x4 a = p[0], b = p[1], c = p[2], d = p[3];
    const float s = ((a.x + a.y) + (a.z + a.w)) + ((b.x + b.y) + (b.z + b.w)) + ((c.x + c.y) + (c.z + c.w)) + ((d.x + d.y) + (d.z + d.w));
    return rsqrtf(s * (1.0f / DM) + EPS);
}
__device__ __forceinline__ u32x4 pack8(f32x4 v0, f32x4 v1) {
    u32x4 w; w.x = pg8::cvt_pk_bf16(v0[0], v0[1]); w.y = pg8::cvt_pk_bf16(v0[2], v0[3]); w.z = pg8::cvt_pk_bf16(v1[0], v1[1]); w.w = pg8::cvt_pk_bf16(v1[2], v1[3]); return w; }

struct EpiBf {
    static constexpr bool PERM = true; bf16_t* O; int ldc;
    __device__ __forceinline__ void operator()(AccRef acc, const pg8::Unit& u, int wr, int wc, int fr, int fq) const {
        asm volatile("" : "+v"(fr), "+v"(fq));
        const int row0 = u.pm * 256 + wr * 64 + fr, col0 = u.pn * 256 + wc * 32 + 8 * fq;
#pragma unroll
        for (int ai = 0; ai < 2; ++ai)
#pragma unroll
            for (int m = 0; m < 4; ++m) { asm volatile("" ::: "memory"); bf16_t* rowp = O + (size_t)(row0 + ai * 128 + m * 16) * ldc + col0;
#pragma unroll
                for (int bj = 0; bj < 2; ++bj) *(u32x4*)(rowp + bj * 128) = pack8(acc[ai][bj][m][0], acc[ai][bj][m][1]); }
    }
};
struct EpiProj {
    static constexpr bool PERM = true; bf16_t* proj; float* ab; const float* ssq;
    __device__ __forceinline__ void operator()(AccRef acc, const pg8::Unit& u, int wr, int wc, int fr, int fq) const {
        asm volatile("" : "+v"(fr), "+v"(fq));
        const int row0 = u.pm * 256 + wr * 64 + fr, col0 = u.pn * 256 + wc * 32 + 8 * fq;
#pragma unroll
        for (int ai = 0; ai < 2; ++ai)
#pragma unroll
            for (int m = 0; m < 4; ++m) { asm volatile("" ::: "memory"); const int row = row0 + ai * 128 + m * 16; const float rs = row_rstd(ssq, row);
                if (u.pn < 12) { bf16_t* rowp = proj + (size_t)row * 3072 + col0;
#pragma unroll
                    for (int bj = 0; bj < 2; ++bj) *(u32x4*)(rowp + bj * 128) = pack8(acc[ai][bj][m][0] * rs, acc[ai][bj][m][1] * rs);
                } else if (wc == 0 && fq < 2) { float* rowp = ab + (size_t)row * 16 + 8 * fq;
                    *(f32x4*)(rowp) = acc[ai][0][m][0] * rs; *(f32x4*)(rowp + 4) = acc[ai][0][m][1] * rs; }
            }
    }
};
struct EpiResid {
    static constexpr bool PERM = true; const float* xold; float* xnew; bf16_t* xb; float* ssq;
    __device__ __forceinline__ void operator()(AccRef acc, const pg8::Unit& u, int wr, int wc, int fr, int fq) const {
        asm volatile("" : "+v"(fr), "+v"(fq));
        const int row0 = u.pm * 256 + wr * 64 + fr, col0 = u.pn * 256 + wc * 32 + 8 * fq;
#pragma unroll
        for (int ai = 0; ai < 2; ++ai)
#pragma unroll
            for (int m = 0; m < 4; ++m) { asm volatile("" ::: "memory"); const int row = row0 + ai * 128 + m * 16; float s = 0.f;
#pragma unroll
                for (int bj = 0; bj < 2; ++bj) { const size_t o = (size_t)row * DM + col0 + bj * 128;
                    const f32x4 v0 = acc[ai][bj][m][0] + *(const f32x4*)(xold + o), v1 = acc[ai][bj][m][1] + *(const f32x4*)(xold + o + 4);
                    *(f32x4*)(xnew + o) = v0; *(f32x4*)(xnew + o + 4) = v1; *(u32x4*)(xb + o) = pack8(v0, v1);
                    s += (v0[0] * v0[0] + v0[1] * v0[1]) + (v0[2] * v0[2] + v0[3] * v0[3]) + (v1[0] * v1[0] + v1[1] * v1[1]) + (v1[2] * v1[2] + v1[3] * v1[3]); }
                s += __shfl_xor(s, 16); s += __shfl_xor(s, 32);
                if (fq == 0) ssq[(size_t)row * 16 + u.pn * 4 + wc] = s; }
    }
};
struct EpiSoftmax {
    static constexpr bool PERM = true; bf16_t* P; const float* ssq; LAS float* ex;
    __device__ __forceinline__ void operator()(AccRef acc, const pg8::Unit& u, int wr, int wc, int fr, int fq) const {
        asm volatile("" : "+v"(fr), "+v"(fq));
        const int rl0 = wr * 64 + fr, col0 = u.pn * 256 + wc * 32 + 8 * fq;
        LAS float* exm = ex; LAS float* exs = ex + 1024; LAS float* exr = ex + 1792 + 256;
#pragma unroll
        for (int ai = 0; ai < 2; ++ai)
#pragma unroll
            for (int m = 0; m < 4; ++m) { asm volatile("" ::: "memory"); const int rl = rl0 + ai * 128 + m * 16; const float rs = row_rstd(ssq, u.pm * 256 + rl);
                float mx = -3.0e38f;
#pragma unroll
                for (int bj = 0; bj < 2; ++bj)
#pragma unroll
                    for (int n = 0; n < 2; ++n) { const f32x4 v = acc[ai][bj][m][n] * rs; mx = fmaxf(mx, fmaxf(fmaxf(v[0], v[1]), fmaxf(v[2], v[3]))); }
                mx = fmaxf(mx, __shfl_xor(mx, 16)); mx = fmaxf(mx, __shfl_xor(mx, 32));
                if (fq == 0) { exm[rl * 4 + wc] = mx; if (wc == 0) exr[rl] = rs; } }
        asm volatile("s_waitcnt lgkmcnt(0)" ::: "memory"); __builtin_amdgcn_s_barrier(); asm volatile("" ::: "memory");
#pragma unroll
        for (int ai = 0; ai < 2; ++ai)
#pragma unroll
            for (int m = 0; m < 4; ++m) { asm volatile("" ::: "memory"); const int rl = rl0 + ai * 128 + m * 16; const f32x4 q = *(const LAS f32x4*)(exm + rl * 4); const float rs = exr[rl];
                const float mx = fmaxf(fmaxf(q[0], q[1]), fmaxf(q[2], q[3])); float s = 0.f;
#pragma unroll
                for (int bj = 0; bj < 2; ++bj)
#pragma unroll
                    for (int n = 0; n < 2; ++n) { const f32x4 v = acc[ai][bj][m][n] * rs - mx; s += (__expf(v[0]) + __expf(v[1])) + (__expf(v[2]) + __expf(v[3])); }
                s += __shfl_xor(s, 16); s += __shfl_xor(s, 32);
                if (fq == 0) exs[rl * 4 + wc] = s; }
        asm volatile("s_waitcnt lgkmcnt(0)" ::: "memory"); __builtin_amdgcn_s_barrier(); asm volatile("" ::: "memory");
#pragma unroll
        for (int ai = 0; ai < 2; ++ai)
#pragma unroll
            for (int m = 0; m < 4; ++m) { asm volatile("" ::: "memory"); const int rl = rl0 + ai * 128 + m * 16; const f32x4 q = *(const LAS f32x4*)(exs + rl * 4), qm = *(const LAS f32x4*)(exm + rl * 4);
                const float rs = exr[rl];
                const float inv = 1.0f / ((q[0] + q[1]) + (q[2] + q[3])); const float mx = fmaxf(fmaxf(qm[0], qm[1]), fmaxf(qm[2], qm[3]));
                bf16_t* rowp = P + (size_t)(u.pm * 256 + rl) * DM + col0;
#pragma unroll
                for (int bj = 0; bj < 2; ++bj) { f32x4 v0 = acc[ai][bj][m][0] * rs - mx, v1 = acc[ai][bj][m][1] * rs - mx;
#pragma unroll
                    for (int j = 0; j < 4; ++j) { v0[j] = __expf(v0[j]) * inv; v1[j] = __expf(v1[j]) * inv; }
                    *(u32x4*)(rowp + bj * 128) = pack8(v0, v1); } }
        asm volatile("s_waitcnt lgkmcnt(0)" ::: "memory");
    }
};
struct EpiGateUp {
    static constexpr bool PERM = true; bf16_t* hmid; const float* slot_rstd;
    __device__ __forceinline__ void operator()(AccRef acc, const pg8::Unit& u, int wr, int wc, int fr, int fq) const {
        asm volatile("" : "+v"(fr), "+v"(fq));
        const int row0 = u.pm * 256 + wr * 64 + fr, col0 = u.pn * 128 + wc * 16 + 4 * fq;
#pragma unroll
        for (int ai = 0; ai < 2; ++ai)
#pragma unroll
            for (int m = 0; m < 4; ++m) { asm volatile("" ::: "memory"); const int row = row0 + ai * 128 + m * 16; const float rs = slot_rstd[row];
#pragma unroll
                for (int bj = 0; bj < 2; ++bj) { const f32x4 v0 = acc[ai][bj][m][0] * rs, v1 = acc[ai][bj][m][1] * rs;
                    u32x2 w; w.x = pg8::cvt_pk_bf16(silu_f(v0[0]) * v0[1], silu_f(v0[2]) * v0[3]); w.y = pg8::cvt_pk_bf16(silu_f(v1[0]) * v1[1], silu_f(v1[2]) * v1[3]);
                    *(u32x2*)(hmid + (size_t)row * DEXP + col0 + bj * 64) = w; } }
    }
};
struct EpiDown {
    static constexpr bool PERM = true; bf16_t* Y; const float* slot_w;
    __device__ __forceinline__ void operator()(AccRef acc, const pg8::Unit& u, int wr, int wc, int fr, int fq) const {
        asm volatile("" : "+v"(fr), "+v"(fq));
        const int row0 = u.pm * 256 + wr * 64 + fr, col0 = u.pn * 256 + wc * 32 + 8 * fq;
#pragma unroll
        for (int ai = 0; ai < 2; ++ai)
#pragma unroll
            for (int m = 0; m < 4; ++m) { asm volatile("" ::: "memory"); const int row = row0 + ai * 128 + m * 16; const float gw = slot_w[row]; bf16_t* rowp = Y + (size_t)row * DM + col0;
#pragma unroll
                for (int bj = 0; bj < 2; ++bj) *(u32x4*)(rowp + bj * 128) = pack8(acc[ai][bj][m][0] * gw, acc[ai][bj][m][1] * gw); }
    }
};

#define CAS __attribute__((address_space(4)))
struct Frame {
    LAS unsigned char* lds; int tid, lane, wave, G, gw, ngw;
    const CAS unsigned char* ka; float* out; unsigned char* ws;
    __device__ __forceinline__ const float* inp(int i) const { const CAS unsigned char* p = ka; asm volatile("" : "+s"(p)); return ((const float* const CAS*)p)[i]; }
};
enum { I_X = 0, I_MEM, I_MIXG, I_WIN, I_RPB, I_RETG, I_POOLW, I_POOLS, I_CONVW, I_ALOG, I_DTB, I_GDNG, I_WOUT, I_MQG, I_MKVG, I_WQ, I_WK, I_WV, I_WO, I_FFNG, I_WGRP, I_BGRP, I_WRT, I_BRT, I_WGATE, I_WUP, I_WDOWN, I_FING };

__device__ __forceinline__ void tr_item(const float* W, int ldw, int nvalid, const float* gain, float scale, bf16_t* WT, int ldt, int row_off, int row_mul,
                                        LAS float* scr, int kb, int nb, int lane) {
    const int k0 = 64 * kb, n0 = 32 * nb;
#pragma unroll 8
    for (int i = 0; i < 32; ++i) { const int kk = 2 * i + (lane >> 5), n = n0 + (lane & 31);
        float v = 0.f; if (n < nvalid) { v = W[(size_t)(k0 + kk) * ldw + n] * scale; if (gain) v *= gain[k0 + kk]; }
        scr[kk * 33 + (lane & 31)] = v; }
    LDS_WAIT(); asm volatile("" ::: "memory");
    const int c = lane & 7;
#pragma unroll
    for (int j = 0; j < 4; ++j) { const int n = (lane >> 3) + 8 * j; const LAS float* s = scr + (8 * c) * 33 + n;
        u32x4 o; o.x = pk2(s[0 * 33], s[1 * 33]); o.y = pk2(s[2 * 33], s[3 * 33]); o.z = pk2(s[4 * 33], s[5 * 33]); o.w = pk2(s[6 * 33], s[7 * 33]);
        *(u32x4*)(WT + (size_t)(row_off + (n0 + n) * row_mul) * ldt + k0 + 8 * c) = o; }
    LDS_WAIT(); asm volatile("" ::: "memory");
}

__device__ __forceinline__ float row_to_bf16(const float* xrow, bf16_t* orow, const float* gain, bool norm, int lane) {
    const f32x4* xr = (const f32x4*)xrow + lane;
    f32x4 v[4]; float s = 0.f;
#pragma unroll
    for (int j = 0; j < 4; ++j) { v[j] = xr[64 * j]; s += (v[j].x * v[j].x + v[j].y * v[j].y) + (v[j].z * v[j].z + v[j].w * v[j].w); }
    s = wave_sum(s);
    if (norm) { const float rs = rsqrtf(s * (1.0f / DM) + EPS);
#pragma unroll
        for (int j = 0; j < 4; ++j) { const f32x4 g = ((const f32x4*)gain)[lane + 64 * j]; v[j] = v[j] * rs * g; } }
    u32x2* o8 = (u32x2*)orow + lane;
#pragma unroll
    for (int j = 0; j < 4; ++j) { u32x2 w; w.x = pk2(v[j].x, v[j].y); w.y = pk2(v[j].z, v[j].w); o8[64 * j] = w; }
    return s;
}

__device__ __forceinline__ void p0_prologue(Frame& F) {
    unsigned char* ws = F.ws;
    LAS float* scr = (LAS float*)(F.lds + F.wave * 16384);
    constexpr int I_IN = 16 * 104, I_SQ = 16 * 32;
    constexpr int PER_L = I_IN + 4 * I_SQ;
    for (int it = F.gw; it < 2 * PER_L; it += F.ngw) {
        const int l = it / PER_L; int r = it % PER_L;
        if (r < I_IN) { tr_item(F.inp(I_WIN) + (size_t)l * DM * 3088, 3088, 3088, F.inp(I_MIXG) + l * DM, 1.f, (bf16_t*)(ws + WS_WIN) + (size_t)l * PINP * DM, DM, 0, 1, scr, r / 104, r % 104, F.lane); continue; }
        r -= I_IN;
        if (r < I_SQ) { tr_item(F.inp(I_WOUT) + (size_t)l * DM * DM, DM, DM, nullptr, 1.f, (bf16_t*)(ws + WS_WOUT) + (size_t)l * DM * DM, DM, 0, 1, scr, r / 32, r % 32, F.lane); continue; }
        r -= I_SQ;
        if (r < I_SQ) { tr_item(F.inp(I_WK) + (size_t)l * DM * DM, DM, DM, nullptr, 1.f, (bf16_t*)(ws + WS_WKV) + (size_t)l * 2048 * DM, DM, 0, 1, scr, r / 32, r % 32, F.lane); continue; }
        r -= I_SQ;
        if (r < I_SQ) { tr_item(F.inp(I_WV) + (size_t)l * DM * DM, DM, DM, nullptr, 1.f, (bf16_t*)(ws + WS_WKV) + (size_t)l * 2048 * DM, DM, 1024, 1, scr, r / 32, r % 32, F.lane); continue; }
        r -= I_SQ;
        tr_item(F.inp(I_WO) + (size_t)l * DM * DM, DM, DM, nullptr, 1.f, (bf16_t*)(ws + WS_WOT) + (size_t)l * DM * DM, DM, 0, 1, scr, r / 32, r % 32, F.lane);
    }
    for (int m = F.gw; m < NTOK + 2048; m += F.ngw) {
        if (m < NTOK) {
            const float s = row_to_bf16(F.inp(I_X) + (size_t)m * DM, (bf16_t*)(ws + WS_XB) + (size_t)m * DM, nullptr, false, F.lane);
            if (F.lane < 16) ((float*)(ws + WS_SSQ))[(size_t)m * 16 + F.lane] = (F.lane == 0) ? s : 0.f;
        } else { const int r = m - NTOK, l = r >> 10;
            row_to_bf16(F.inp(I_MEM) + (size_t)(r & 1023) * DM, (bf16_t*)(ws + WS_MEMN) + (size_t)r * DM, F.inp(I_MKVG) + l * DM, true, F.lane); }
    }
    const size_t gt = (size_t)blockIdx.x * NTHREADS + F.tid, ngt = (size_t)F.G * NTHREADS;
    {
        bf16_t* o = (bf16_t*)(ws + WS_WQB);
        for (size_t i = gt; i < (size_t)2 * DM * DM / 4; i += ngt) { const size_t e = i * 4; const int l = (int)(e >> 20), k = (int)((e >> 10) & 1023);
            const f32x4 w = *(const f32x4*)(F.inp(I_WQ) + e); const float g = F.inp(I_MQG)[l * DM + k] * 0.0625f;
            u32x2 p; p.x = pk2(w.x * g, w.y * g); p.y = pk2(w.z * g, w.w * g); *(u32x2*)(o + e) = p; }
    }
    {
        float* tab = (float*)(ws + WS_TAB + TAB_ROPE);
        for (size_t i = gt; i < (size_t)SEQ * 32; i += ngt) { const int pos = (int)(i >> 5), j = (int)(i & 31);
            const float inv = powf(10000.0f, -(float)j / 32.0f); const float ang = (float)pos * inv;
            const double rev = (double)ang * 0.15915494309189535; const float fr = (float)(rev - floor(rev));
            tab[i * 2] = __builtin_amdgcn_cosf(fr); tab[i * 2 + 1] = __builtin_amdgcn_sinf(fr); }
    }
    {
        bf16_t* fr = (bf16_t*)(ws + WS_TAB + TAB_RFR);
        for (size_t i = gt; i < (size_t)2 * 49152; i += ngt) { const int l = (int)(i / 49152), r = (int)(i % 49152), j = r & 7, ln = (r >> 3) & 63, ct = (r >> 9) % 3, ks = r / 1536;
            const int k = 32 * ks + 8 * (ln >> 4) + j, o = 16 * ct + (ln & 15);
            float w = 0.f; if (o < 32) w = F.inp(I_WRT)[(size_t)l * DM * 32 + (size_t)k * 32 + o]; else if (o < 36) w = F.inp(I_WGRP)[(size_t)l * DM * 4 + (size_t)k * 4 + (o - 32)];
            w *= F.inp(I_FFNG)[l * DM + k];
            const unsigned hi = f2bf(w); const float lo = w - __builtin_bit_cast(float, hi << 16);
            fr[(size_t)l * 98304 + r] = (bf16_t)hi; fr[(size_t)l * 98304 + 49152 + r] = (bf16_t)f2bf(lo); }
    }
    {
        bf16_t* pt = (bf16_t*)(ws + WS_TAB + TAB_POOL);
        for (size_t i = gt; i < (size_t)2 * 4 * 64 * 64; i += ngt) { const int c = (int)(i & 63), e = (int)((i >> 6) & 63), gi = (int)((i >> 12) & 3), l = (int)(i >> 14);
            pt[i] = (bf16_t)f2bf(F.inp(I_POOLW)[(((size_t)l * 4 + gi) * 64 + c) * 64 + e] * F.inp(I_POOLS)[l * 256 + gi * 64 + e]); }
    }
}

__device__ __forceinline__ void convert_experts(Frame& F, int l) {
    unsigned char* ws = F.ws;
    LAS float* scr = (LAS float*)(F.lds + F.wave * 16384);
    constexpr int IG = 16 * 16, ID = 8 * 32, PER_E = 2 * IG + ID;
    for (int it = F.gw; it < NEXP * PER_E; it += F.ngw) {
        const int e = it / PER_E; int r = it % PER_E; const size_t le = (size_t)l * NEXP + e;
        if (r < IG) { tr_item(F.inp(I_WGATE) + le * DM * DEXP, DEXP, DEXP, F.inp(I_FFNG) + l * DM, 1.f, (bf16_t*)(ws + WS_WGU) + (size_t)e * 1024 * DM, DM, 0, 2, scr, r / 16, r % 16, F.lane); continue; }
        r -= IG;
        if (r < IG) { tr_item(F.inp(I_WUP) + le * DM * DEXP, DEXP, DEXP, F.inp(I_FFNG) + l * DM, 1.f, (bf16_t*)(ws + WS_WGU) + (size_t)e * 1024 * DM, DM, 1, 2, scr, r / 16, r % 16, F.lane); continue; }
        r -= IG;
        tr_item(F.inp(I_WDOWN) + le * DEXP * DM, DM, DM, nullptr, 1.f, (bf16_t*)(ws + WS_WD) + (size_t)e * DM * DEXP, DEXP, 0, 1, scr, r / 32, r % 32, F.lane);
    }
}

#define MFMA16(a, b, c) __builtin_amdgcn_mfma_f32_16x16x32_bf16((a), (b), (c), 0, 0, 0)

__device__ __forceinline__ void pool_item(Frame& F, const bf16_t* proj, const bf16_t* pt, bf16_t* ycat, int item) {
    const int lane = F.lane, g = lane >> 4, t = item * 16 + (lane & 15), s = t & (SEQ - 1);
    const bf16_t* base = proj + (size_t)(t - s) * 3072 + 1792;
#pragma unroll
    for (int gi = 0; gi < 4; ++gi) {
        const int half = 1 << gi; const int lo = max(s - half, 0), hi = min(s + half, SEQ); const float inv = 1.0f / (float)(hi - lo);
        f32x4 acc[4];
#pragma unroll
        for (int et = 0; et < 4; ++et) acc[et] = (f32x4){0.f, 0.f, 0.f, 0.f};
#pragma unroll
        for (int ks = 0; ks < 2; ++ks) {
            const int cb = gi * 64 + ks * 32 + g * 8;
            float sum[8];
#pragma unroll
            for (int j = 0; j < 8; ++j) sum[j] = 0.f;
            for (int s2 = lo; s2 < hi; ++s2) { const u32x4 v = *(const u32x4*)(base + (size_t)s2 * 3072 + cb);
                sum[0] += bflo(v.x); sum[1] += bfhi(v.x); sum[2] += bflo(v.y); sum[3] += bfhi(v.y); sum[4] += bflo(v.z); sum[5] += bfhi(v.z); sum[6] += bflo(v.w); sum[7] += bfhi(v.w); }
            const u32x4 c = *(const u32x4*)(base + (size_t)s * 3072 + cb);
            u32x4 dd; dd.x = pk2(sum[0] * inv - bflo(c.x), sum[1] * inv - bfhi(c.x)); dd.y = pk2(sum[2] * inv - bflo(c.y), sum[3] * inv - bfhi(c.y));
            dd.z = pk2(sum[4] * inv - bflo(c.z), sum[5] * inv - bfhi(c.z)); dd.w = pk2(sum[6] * inv - bflo(c.w), sum[7] * inv - bfhi(c.w));
            const bf16x8 bfrag = __builtin_bit_cast(bf16x8, dd);
#pragma unroll
            for (int et = 0; et < 4; ++et) { const bf16x8 afrag = *(const bf16x8*)(pt + ((size_t)gi * 64 + et * 16 + (lane & 15)) * 64 + ks * 32 + g * 8);
                acc[et] = MFMA16(afrag, bfrag, acc[et]); }
        }
#pragma unroll
        for (int et = 0; et < 4; ++et) { u32x2 w; w.x = pk2(acc[et][0], acc[et][1]); w.y = pk2(acc[et][2], acc[et][3]);
            *(u32x2*)(ycat + (size_t)t * DM + 512 + gi * 64 + et * 16 + g * 4) = w; }
    }
}

__device__ __forceinline__ void na_naive_item(Frame& F, const bf16_t* proj, const float* rpb, bf16_t* ycat, int item) {
    const int lane = F.lane, t = item >> 2, h = item & 3, s = t & (SEQ - 1), r = s >> 6, c = s & 63; const size_t tb = (size_t)(t - s);
    const int kr0 = min(max(r - 4, 0), 120), win = min(max(c - 8, 0), 48);
    const int ki = lane >> 3, cj = (lane & 7) * 2, krow = kr0 + ki, kcol = win + cj;
    const bf16_t* qp = proj + (size_t)t * 3072 + h * 64;
    const bf16_t* kp = proj + (tb + (size_t)krow * 64 + kcol) * 3072 + 256 + h * 64;
    float d0 = 0.f, d1 = 0.f;
#pragma unroll
    for (int dc = 0; dc < 8; ++dc) { const u32x4 q = *(const u32x4*)(qp + dc * 8), a = *(const u32x4*)(kp + dc * 8), b = *(const u32x4*)(kp + 3072 + dc * 8);
        d0 += bflo(q.x) * bflo(a.x) + bfhi(q.x) * bfhi(a.x) + bflo(q.y) * bflo(a.y) + bfhi(q.y) * bfhi(a.y) + bflo(q.z) * bflo(a.z) + bfhi(q.z) * bfhi(a.z) + bflo(q.w) * bflo(a.w) + bfhi(q.w) * bfhi(a.w);
        d1 += bflo(q.x) * bflo(b.x) + bfhi(q.x) * bfhi(b.x) + bflo(q.y) * bflo(b.y) + bfhi(q.y) * bfhi(b.y) + bflo(q.z) * bflo(b.z) + bfhi(q.z) * bfhi(b.z) + bflo(q.w) * bflo(b.w) + bfhi(q.w) * bfhi(b.w); }
    const float* rp = rpb + ((size_t)h * 15 + (krow - r + 7)) * 31 + (kcol - c + 15);
    const float s0 = d0 * 0.125f + rp[0], s1 = d1 * 0.125f + rp[1];
    const float mx = wave_max(fmaxf(s0, s1)); float p0 = __expf(s0 - mx), p1 = __expf(s1 - mx);
    const float inv = 1.0f / wave_sum(p0 + p1); p0 *= inv; p1 *= inv;
    float o = 0.f;
    const bf16_t* vb = proj + tb * 3072 + 512 + h * 64 + lane;
    for (int kk = 0; kk < 128; ++kk) { const float pv = __shfl((kk & 1) ? p1 : p0, kk >> 1);
        const size_t vt = (size_t)(kr0 + (kk >> 4)) * 64 + win + (kk & 15); o += pv * bf2f(vb[vt * 3072]); }
    ycat[(size_t)t * DM + h * 64 + lane] = (bf16_t)f2bf(o);
}

__device__ __forceinline__ float rdl(float x, int d) { return __builtin_bit_cast(float, __builtin_amdgcn_readlane(__builtin_bit_cast(int, x), d)); }

__device__ void ret_naive_chain(Frame& F, const bf16_t* proj, const float* rope, float* O, int chain) {
    const int lane = F.lane, dir = chain & 1, h = (chain >> 1) & 3, b = chain >> 3;
    const int hh = dir ? 3 - h : h; const float gamma = 1.0f - exp2f(-5.0f - (float)hh);
    float S[64];
#pragma unroll
    for (int d = 0; d < 64; ++d) S[d] = 0.f;
    for (int step = 0; step < SEQ; ++step) {
        const int s = dir ? SEQ - 1 - step : step; const size_t t = (size_t)b * SEQ + s;
        const bf16_t* row = proj + t * 3072 + 768 + h * 64 + lane;
        float q = bf2f(row[0]), k = bf2f(row[256]); const float v = bf2f(row[512]);
        const f32x2 cs = *(const f32x2*)(rope + ((size_t)s * 32 + (lane & 31)) * 2);
        const float qp = __shfl_xor(q, 32), kp = __shfl_xor(k, 32);
        q = (lane < 32) ? q * cs.x - qp * cs.y : qp * cs.y + q * cs.x;
        k = ((lane < 32) ? k * cs.x - kp * cs.y : kp * cs.y + k * cs.x) * 0.125f;
        float o = 0.f;
        if (dir == 0) {
#pragma unroll
            for (int d = 0; d < 64; ++d) { S[d] = gamma * S[d] + rdl(k, d) * v; o += rdl(q, d) * S[d]; }
        } else {
#pragma unroll
            for (int d = 0; d < 64; ++d) { o += rdl(q, d) * S[d]; S[d] = gamma * (S[d] + rdl(k, d) * v); }
        }
        O[((size_t)dir * NTOK + t) * 256 + h * 64 + lane] = o;
    }
}

__device__ void gdn_naive_chain(Frame& F, const bf16_t* proj, const float* ab, const float* convw, const float* alog, const float* dtb, float* O, int chain) {
    const int lane = F.lane, dir = chain & 1, h = (chain >> 1) & 3, b = chain >> 3;
    const float ea = __expf(alog[dir * 4 + h]), db = dtb[dir * 4 + h];
    float w[3][4];
#pragma unroll
    for (int p = 0; p < 3; ++p)
#pragma unroll
        for (int tp = 0; tp < 4; ++tp) w[p][tp] = convw[tp * 768 + p * 256 + h * 64 + lane];
    float S[64];
#pragma unroll
    for (int d = 0; d < 64; ++d) S[d] = 0.f;
    for (int step = 0; step < SEQ; ++step) {
        const int s = dir ? SEQ - 1 - step : step; const size_t t = (size_t)b * SEQ + s;
        float u[3] = {0.f, 0.f, 0.f};
#pragma unroll
        for (int tp = 0; tp < 4; ++tp) { const int s2 = s + tp - 2;
            if (s2 >= 0 && s2 < SEQ) { const bf16_t* row = proj + ((size_t)b * SEQ + s2) * 3072 + 2048 + h * 64 + lane;
#pragma unroll
                for (int p = 0; p < 3; ++p) u[p] += w[p][tp] * bf2f(row[p * 256]); } }
        float q = silu_f(u[0]), k = silu_f(u[1]); const float v = silu_f(u[2]);
        q = q * rsqrtf(wave_sum(q * q) + EPS) * 0.125f; k = k * rsqrtf(wave_sum(k * k) + EPS);
        const float a = ab[t * 16 + dir * 4 + h], bb = ab[t * 16 + 8 + dir * 4 + h];
        const float alpha = __expf(-ea * softplus_f(a + db)), beta = sigmoid_f(bb);
        float ks = 0.f;
#pragma unroll
        for (int d = 0; d < 64; ++d) ks += rdl(k, d) * S[d];
        const float vn = beta * (v - alpha * ks);
        float o = 0.f;
#pragma unroll
        for (int d = 0; d < 64; ++d) { S[d] = alpha * S[d] + rdl(k, d) * vn; o += rdl(q, d) * S[d]; }
        O[((size_t)dir * NTOK + t) * 256 + h * 64 + lane] = o;
    }
}

__device__ __forceinline__ void finalize_item(Frame& F, const bf16_t* proj, const float* Oret, const float* Ogdn, const float* retg, const float* gdng, bf16_t* ycat, int item) {
    const int lane = F.lane, t = item >> 2, h = item & 3; const size_t o = (size_t)t * 256 + h * 64 + lane;
    {   const float x = Oret[o] + Oret[(size_t)NTOK * 256 + o];
        const float mu = wave_sum(x) * (1.0f / 64.0f), dx = x - mu, var = wave_sum(dx * dx) * (1.0f / 64.0f);
        const float gate = bf2f(proj[(size_t)t * 3072 + 1536 + h * 64 + lane]);
        ycat[(size_t)t * DM + 256 + h * 64 + lane] = (bf16_t)f2bf(dx * rsqrtf(var + EPS) * retg[h * 64 + lane] * silu_f(gate)); }
    {   const float x = Ogdn[o] + Ogdn[(size_t)NTOK * 256 + o];
        const float ms = wave_sum(x * x) * (1.0f / 64.0f);
        const float gate = bf2f(proj[(size_t)t * 3072 + 2816 + h * 64 + lane]);
        ycat[(size_t)t * DM + 768 + h * 64 + lane] = (bf16_t)f2bf(x * rsqrtf(ms + EPS) * gdng[lane] * silu_f(gate)); }
}

__device__ __forceinline__ void router_phase(Frame& F, int l) {
    unsigned char* ws = F.ws; const int lane = F.lane, g = lane >> 4;
    const float* X = F.out; const float* ssq = (const float*)(ws + WS_SSQ);
    const bf16x8* fh = (const bf16x8*)(ws + WS_TAB + TAB_RFR + (size_t)l * 196608); const bf16x8* fl = fh + 6144;
    int* toke = (int*)(ws + WS_TAB + TAB_TOKE); float* tokw = (float*)(ws + WS_TAB + TAB_TOKW);
    LAS float* lg = (LAS float*)(F.lds + F.wave * 4096);
    LAS int* hist = (LAS int*)(F.lds + LDS_MISC + 256);
    if (F.tid < NEXP) hist[F.tid] = 0;
    __syncthreads();
    const float* bg = F.inp(I_BGRP) + l * 4; const float* br = F.inp(I_BRT) + l * 32;
    for (int tile = F.gw; tile < NTOK / 16; tile += F.ngw) {
        const int t0 = tile * 16; const float* xr = X + (size_t)(t0 + (lane & 15)) * DM + g * 8;
        f32x4 acc[3];
#pragma unroll
        for (int ct = 0; ct < 3; ++ct) acc[ct] = (f32x4){0.f, 0.f, 0.f, 0.f};
#pragma unroll 4
        for (int ks = 0; ks < 32; ++ks) {
            const f32x4 a0 = *(const f32x4*)(xr + ks * 32), a1 = *(const f32x4*)(xr + ks * 32 + 4);
            u32x4 hi, lo;
            { const unsigned h0 = f2bf(a0.x), h1 = f2bf(a0.y), h2 = f2bf(a0.z), h3 = f2bf(a0.w), h4 = f2bf(a1.x), h5 = f2bf(a1.y), h6 = f2bf(a1.z), h7 = f2bf(a1.w);
              hi.x = h0 | (h1 << 16); hi.y = h2 | (h3 << 16); hi.z = h4 | (h5 << 16); hi.w = h6 | (h7 << 16);
              lo.x = pk2(a0.x - bflo(h0), a0.y - bflo(h1)); lo.y = pk2(a0.z - bflo(h2), a0.w - bflo(h3)); lo.z = pk2(a1.x - bflo(h4), a1.y - bflo(h5)); lo.w = pk2(a1.z - bflo(h6), a1.w - bflo(h7)); }
            const bf16x8 xh = __builtin_bit_cast(bf16x8, hi), xl = __builtin_bit_cast(bf16x8, lo);
#pragma unroll
            for (int ct = 0; ct < 3; ++ct) { const bf16x8 wh = fh[(ks * 3 + ct) * 64 + lane], wl = fl[(ks * 3 + ct) * 64 + lane];
                acc[ct] = MFMA16(wh, xh, acc[ct]); acc[ct] = MFMA16(wl, xh, acc[ct]); acc[ct] = MFMA16(wh, xl, acc[ct]); }
        }
#pragma unroll
        for (int ct = 0; ct < 3; ++ct)
#pragma unroll
            for (int j = 0; j < 4; ++j) lg[(lane & 15) * 48 + ct * 16 + g * 4 + j] = acc[ct][j];
        LDS_WAIT(); asm volatile("" ::: "memory");
        if (lane < 16) {
            const int t = t0 + lane; const float rs = row_rstd(ssq, t); const LAS float* L = lg + lane * 48;
            int gi = 0; float gm = L[32] * rs + bg[0];
            float gl[4]; gl[0] = gm;
#pragma unroll
            for (int j = 1; j < 4; ++j) { gl[j] = L[32 + j] * rs + bg[j]; if (gl[j] > gm) { gm = gl[j]; gi = j; } }
            float gs = 0.f;
#pragma unroll
            for (int j = 0; j < 4; ++j) gs += __expf(gl[j] - gm);
            const float gp = 1.0f / gs;
            int e1 = 0, e2 = 0; float l1 = -3.0e38f, l2 = -3.0e38f;
            for (int j = 0; j < 8; ++j) { const float v = L[gi * 8 + j] * rs + br[gi * 8 + j];
                if (v > l1) { l2 = l1; e2 = e1; l1 = v; e1 = j; } else if (v > l2) { l2 = v; e2 = j; } }
            const float p2 = __expf(l2 - l1), w1 = gp / (1.0f + p2), w2 = gp * p2 / (1.0f + p2);
            const int x1 = gi * 8 + e1, x2 = gi * 8 + e2;
            toke[t * 2] = x1; toke[t * 2 + 1] = x2; tokw[t * 2] = w1; tokw[t * 2 + 1] = w2;
            atomicAdd((int*)hist + x1, 1); atomicAdd((int*)hist + x2, 1);
        }
        LDS_WAIT(); asm volatile("" ::: "memory");
    }
    __syncthreads();
    if (F.tid < NEXP) atomicAdd((unsigned*)(ws + WS_CTL) + CW_CNT + l * 32 + F.tid, (unsigned)hist[F.tid]);
}

__device__ __forceinline__ int moe_pad_table(Frame& F, int l, LAS int* pad_end) {
    if (F.tid == 0) { const unsigned* cnt = (const unsigned*)(F.ws + WS_CTL) + CW_CNT + l * 32; int acc = 0;
        for (int e = 0; e < NEXP; ++e) { const unsigned c = __hip_atomic_load(cnt + e, __ATOMIC_RELAXED, __HIP_MEMORY_SCOPE_AGENT); acc += (int)((c + 255u) & ~255u); pad_end[e] = acc; } }
    __syncthreads();
    return pad_end[NEXP - 1];
}

__device__ __forceinline__ void assign_gather_phase(Frame& F, int l) {
    unsigned char* ws = F.ws;
    LAS int* pad_end = (LAS int*)(F.lds + LDS_MISC + 64);
    LAS int* lhist = (LAS int*)(F.lds + LDS_MISC + 256);
    LAS int* lbase = (LAS int*)(F.lds + LDS_MISC + 512);
    LAS int* aslot = (LAS int*)(F.lds);
    LAS int* atok = (LAS int*)(F.lds + 1024);
    moe_pad_table(F, l, pad_end);
    const int* toke = (const int*)(ws + WS_TAB + TAB_TOKE); const float* tokw = (const float*)(ws + WS_TAB + TAB_TOKW);
    int* slot_tok = (int*)(ws + WS_SLOT + SL_TOK); float* slot_w = (float*)(ws + WS_SLOT + SL_W); float* slot_rstd = (float*)(ws + WS_SLOT + SL_RSTD); int* tok_slot = (int*)(ws + WS_SLOT + SL_TSLOT);
    const float* ssq = (const float*)(ws + WS_SSQ);
    const bf16_t* xb = (const bf16_t*)(ws + WS_XB); bf16_t* sa = (bf16_t*)(ws + WS_SORTA);
    unsigned* cur = (unsigned*)(ws + WS_CTL) + CW_CUR + l * 32;
    for (int ch = blockIdx.x; ch < NTOK / 128; ch += F.G) {
        if (F.tid < NEXP) lhist[F.tid] = 0;
        __syncthreads();
        int e = 0, pos = 0, t = 0;
        if (F.tid < 256) { t = ch * 128 + (F.tid >> 1); e = toke[t * 2 + (F.tid & 1)]; pos = atomicAdd((int*)lhist + e, 1); }
        __syncthreads();
        if (F.tid < NEXP) lbase[F.tid] = (int)atomicAdd(cur + F.tid, (unsigned)lhist[F.tid]);
        __syncthreads();
        if (F.tid < 256) { const int slot = (e ? pad_end[e - 1] : 0) + lbase[e] + pos;
            slot_tok[slot] = t; slot_w[slot] = tokw[t * 2 + (F.tid & 1)]; slot_rstd[slot] = row_rstd(ssq, t); tok_slot[t * 2 + (F.tid & 1)] = slot;
            aslot[F.tid] = slot; atok[F.tid] = t; }
        __syncthreads();
        for (int a = F.wave; a < 256; a += NWAVES) { const int slot = aslot[a], tt = atok[a];
            const u32x4* src = (const u32x4*)(xb + (size_t)tt * DM); u32x4* dst = (u32x4*)(sa + (size_t)slot * DM);
            dst[F.lane] = src[F.lane]; dst[F.lane + 64] = src[F.lane + 64]; }
        __syncthreads();
    }
}

__device__ __forceinline__ void combine_phase(Frame& F, int l) {
    unsigned char* ws = F.ws; const int lane = F.lane;
    const int* tok_slot = (const int*)(ws + WS_SLOT + SL_TSLOT); const bf16_t* Y = (const bf16_t*)(ws + WS_SORTA);
    bf16_t* xb = (bf16_t*)(ws + WS_XB); float* ssq = (float*)(ws + WS_SSQ);
    for (int t = F.gw; t < NTOK; t += F.ngw) {
        const int s0 = tok_slot[t * 2], s1 = tok_slot[t * 2 + 1];
        f32x4* xr = (f32x4*)(F.out + (size_t)t * DM) + lane;
        const u32x2* y0 = (const u32x2*)(Y + (size_t)s0 * DM) + lane; const u32x2* y1 = (const u32x2*)(Y + (size_t)s1 * DM) + lane;
        f32x4 v[4]; float s = 0.f;
#pragma unroll
        for (int j = 0; j < 4; ++j) { v[j] = xr[64 * j]; const u32x2 a = y0[64 * j], b = y1[64 * j];
            v[j].x += bflo(a.x) + bflo(b.x); v[j].y += bfhi(a.x) + bfhi(b.x); v[j].z += bflo(a.y) + bflo(b.y); v[j].w += bfhi(a.y) + bfhi(b.y);
            s += (v[j].x * v[j].x + v[j].y * v[j].y) + (v[j].z * v[j].z + v[j].w * v[j].w); }
        s = wave_sum(s);
        if (l == DEPTH - 1) { const float rs = rsqrtf(s * (1.0f / DM) + EPS);
#pragma unroll
            for (int j = 0; j < 4; ++j) { const f32x4 gn = ((const f32x4*)F.inp(I_FING))[lane + 64 * j]; xr[64 * j] = v[j] * rs * gn; }
        } else {
            u32x2* o8 = (u32x2*)(xb + (size_t)t * DM) + lane;
#pragma unroll
            for (int j = 0; j < 4; ++j) { xr[64 * j] = v[j]; u32x2 w; w.x = pk2(v[j].x, v[j].y); w.y = pk2(v[j].z, v[j].w); o8[64 * j] = w; }
            if (lane < 16) ssq[(size_t)t * 16 + lane] = (lane == 0) ? s : 0.f;
        }
    }
}

constexpr int PH_PRO = 0, PH_KV = 1, PH_FOLD = 2, PH_L0 = 3, PPL = 11, NPH = PH_L0 + DEPTH * PPL;
enum { LP_INPROJ = 0, LP_MIX, LP_FIN, LP_OUTPROJ, LP_SCORES, LP_PV, LP_ROUTER, LP_ASSIGN, LP_GATEUP, LP_DOWN, LP_COMBINE };

struct Args { const float* in[28]; float* out; unsigned char* ws; int ph_lo, ph_hi; };

__global__ void __launch_bounds__(NTHREADS, 2) fwd_kernel(Args args) {
    extern __shared__ __attribute__((aligned(16))) unsigned char lds_raw[];
    Frame F;
    F.lds = (LAS unsigned char*)lds_raw;
    F.tid = threadIdx.x; F.lane = F.tid & 63; F.wave = __builtin_amdgcn_readfirstlane(F.tid >> 6);
    F.G = gridDim.x; F.gw = blockIdx.x * NWAVES + F.wave; F.ngw = F.G * NWAVES;
    F.ka = (const CAS unsigned char*)__builtin_amdgcn_kernarg_segment_ptr();
    F.out = args.out; F.ws = args.ws;
    unsigned char* ws0 = args.ws;
    for (int u = F.tid; u < (LDS_BYTES - LDS_MISC) / 4; u += NTHREADS) ((LAS unsigned*)(F.lds + LDS_MISC))[u] = 0u;
    __syncthreads();
    const int lo = args.ph_lo, hi = args.ph_hi;
    XcdBarrier bar; bar.bar = (unsigned*)(ws0 + WS_CTL) + CW_BAR; bar.x = 0; bar.st = (volatile LAS unsigned*)(F.lds + LDS_MISC);
    if (hi - lo > 1) bar = xcd_barrier_post((unsigned*)(ws0 + WS_CTL) + CW_BAR, (volatile LAS unsigned*)(F.lds + LDS_MISC), F.tid == 0);
#ifndef LPMASK
#define LPMASK 0x7ff
#endif
#ifndef PMASK
#define PMASK 7
#endif
#define IN(k) (lo <= (k) && (k) < hi)
#define INP(k) (((PMASK >> (k)) & 1) && IN(k))
#define INL(k) (((LPMASK >> (k)) & 1) && IN(pb + (k)))
#define SEAM(k) do { if (IN(k) && IN((k) + 1)) xcd_barrier(bar, F.tid == 0); } while (0)
#define PH_ENTER() int c_id; unsigned char* ws; do { int _t = F.wave * 64 + (int)__builtin_amdgcn_mbcnt_hi(~0u, __builtin_amdgcn_mbcnt_lo(~0u, 0u)); asm volatile("" : "+v"(_t)); F.tid = _t; F.lane = _t & 63; unsigned char* _w = args.ws; asm volatile("" : "+s"(_w)); F.ws = _w; ws = _w; \
        float* _o = args.out; asm volatile("" : "+s"(_o)); F.out = _o; int _c = blockIdx.x; asm volatile("" : "+s"(_c)); c_id = _c; F.gw = _c * NWAVES + F.wave; } while (0)

    if (INP(PH_PRO)) { PH_ENTER(); (void)c_id; (void)ws; p0_prologue(F); }
    SEAM(PH_PRO);
    if (INP(PH_KV)) { PH_ENTER();
        OrdKV S{(const char*)(ws + WS_MEMN), (const char*)(ws + WS_WKV), F.G, c_id};
        EpiBf E{(bf16_t*)(ws + WS_KV), 2048};
        pg8::gemm_phase<EpiBf, OrdKV>(F.lds, F.tid, pg8::Gemm{DM, DM, DM}, S, E);
    }
    SEAM(PH_KV);
    if (INP(PH_FOLD)) {
        { PH_ENTER(); OrdKq S{(const char*)(ws + WS_KV), (const char*)(ws + WS_WQB), F.G, c_id}; EpiBf E{(bf16_t*)(ws + WS_KQT), DM};
          int kf = 256; asm volatile("" : "+s"(kf)); pg8::gemm_phase<EpiBf, OrdKq>(F.lds, F.tid, pg8::Gemm{2048, DM, kf}, S, E); }
        { PH_ENTER(); OrdVo S{(const char*)(ws + WS_KV), (const char*)(ws + WS_WOT), F.G, (c_id + 128) % F.G}; EpiBf E{(bf16_t*)(ws + WS_VOT), DM};
          int kf = 256; asm volatile("" : "+s"(kf)); pg8::gemm_phase<EpiBf, OrdVo>(F.lds, F.tid, pg8::Gemm{DM, 2048, kf}, S, E); }
    }
    SEAM(PH_FOLD);

    for (int l = 0; l < DEPTH; ++l) {
        const int pb = PH_L0 + l * PPL;
        if (INL(LP_INPROJ)) { PH_ENTER();
            OrdStd S{(const char*)(ws + WS_XB), (const char*)(ws + WS_WIN) + (size_t)l * PINP * DM * 2, (size_t)256 * DM * 2, (size_t)256 * DM * 2, 0, NTOK / 256, PINP / 256, F.G, c_id};
            EpiProj E{(bf16_t*)(ws + WS_PROJ), (float*)(ws + WS_AB), (const float*)(ws + WS_SSQ)};
            pg8::gemm_phase<EpiProj, OrdStd>(F.lds, F.tid, pg8::Gemm{DM, DM, DM}, S, E);
        }
        SEAM(pb + LP_INPROJ);
        if (INL(LP_MIX)) { PH_ENTER(); (void)c_id;
            const bf16_t* proj = (const bf16_t*)(ws + WS_PROJ); bf16_t* ycat = (bf16_t*)(ws + WS_YCAT);
            float* Oret = (float*)(ws + WS_MIXS); float* Ogdn = Oret + (size_t)2 * NTOK * 256;
            const float* rope = (const float*)(ws + WS_TAB + TAB_ROPE);
            for (int c = F.gw; c < 64; c += F.ngw) {
                if (c < 32) ret_naive_chain(F, proj, rope, Oret, c);
                else gdn_naive_chain(F, proj, (const float*)(ws + WS_AB), F.inp(I_CONVW) + (size_t)l * 4 * 768, F.inp(I_ALOG) + l * 8, F.inp(I_DTB) + l * 8, Ogdn, c - 32);
            }
            const bf16_t* pt = (const bf16_t*)(ws + WS_TAB + TAB_POOL) + (size_t)l * 4 * 64 * 64;
            const float* rpb = F.inp(I_RPB) + (size_t)l * 4 * 15 * 31;
            for (int it = F.gw; it < NTOK * 4 + NTOK / 16; it += F.ngw) {
                if (it < NTOK * 4) na_naive_item(F, proj, rpb, ycat, it); else pool_item(F, proj, pt, ycat, it - NTOK * 4);
            }
        }
        SEAM(pb + LP_MIX);
        if (INL(LP_FIN)) { PH_ENTER(); (void)c_id;
            const float* Oret = (const float*)(ws + WS_MIXS); const float* Ogdn = Oret + (size_t)2 * NTOK * 256;
            const float* retg = F.inp(I_RETG) + l * 256; const float* gdng = F.inp(I_GDNG) + l * 64;
            for (int it = F.gw; it < NTOK * 4; it += F.ngw) finalize_item(F, (const bf16_t*)(ws + WS_PROJ), Oret, Ogdn, retg, gdng, (bf16_t*)(ws + WS_YCAT), it);
        }
        SEAM(pb + LP_FIN);
        if (INL(LP_OUTPROJ)) { PH_ENTER();
            OrdStd S{(const char*)(ws + WS_YCAT), (const char*)(ws + WS_WOUT) + (size_t)l * DM * DM * 2, (size_t)256 * DM * 2, (size_t)256 * DM * 2, 0, NTOK / 256, 4, F.G, c_id};
            EpiResid E{l == 0 ? F.inp(I_X) : (const float*)F.out, F.out, (bf16_t*)(ws + WS_XB), (float*)(ws + WS_SSQ)};
            pg8::gemm_phase<EpiResid, OrdStd>(F.lds, F.tid, pg8::Gemm{DM, DM, DM}, S, E);
        }
        SEAM(pb + LP_OUTPROJ);
        if (INL(LP_SCORES)) { PH_ENTER();
            OrdStd S{(const char*)(ws + WS_XB), (const char*)(ws + WS_KQT) + (size_t)l * 4 * DM * DM * 2, (size_t)256 * DM * 2, (size_t)256 * DM * 2, (size_t)DM * DM * 2, NTOK / 256, 4, F.G, c_id};
            EpiSoftmax E{(bf16_t*)(ws + WS_P), (const float*)(ws + WS_SSQ), (LAS float*)(F.lds + LDS_EX)};
            pg8::gemm_phase<EpiSoftmax, OrdStd>(F.lds, F.tid, pg8::Gemm{DM, DM, DM}, S, E);
        }
        SEAM(pb + LP_SCORES);
        if (INL(LP_PV)) { PH_ENTER();
            OrdStd S{(const char*)(ws + WS_P), (const char*)(ws + WS_VOT) + (size_t)l * 4 * DM * DM * 2, (size_t)256 * DM * 2, (size_t)256 * DM * 2, (size_t)DM * DM * 2, NTOK / 256, 4, F.G, c_id};
            EpiResid E{(const float*)F.out, F.out, (bf16_t*)(ws + WS_XB), (float*)(ws + WS_SSQ)};
            pg8::gemm_phase<EpiResid, OrdStd>(F.lds, F.tid, pg8::Gemm{DM, DM, DM}, S, E);
        }
        SEAM(pb + LP_PV);
        if (INL(LP_ROUTER)) { { PH_ENTER(); (void)c_id; (void)ws; router_phase(F, l); } { PH_ENTER(); (void)c_id; (void)ws; convert_experts(F, l); } }
        SEAM(pb + LP_ROUTER);
        if (INL(LP_ASSIGN)) { PH_ENTER(); (void)c_id; (void)ws; assign_gather_phase(F, l); }
        SEAM(pb + LP_ASSIGN);
        if (INL(LP_GATEUP)) { PH_ENTER();
            LAS int* pad_end = (LAS int*)(F.lds + LDS_MISC + 64);
            const int total = moe_pad_table(F, l, pad_end);
            OrdMoE S{(const char*)(ws + WS_SORTA), (const char*)(ws + WS_WGU), (size_t)256 * DM * 2, (size_t)1024 * DM * 2, (size_t)256 * DM * 2, (total / 256) * 4, pad_end, F.G, c_id};
            EpiGateUp E{(bf16_t*)(ws + WS_HMID), (const float*)(ws + WS_SLOT + SL_RSTD)};
            pg8::gemm_phase<EpiGateUp, OrdMoE>(F.lds, F.tid, pg8::Gemm{DM, DM, DM}, S, E);
        }
        SEAM(pb + LP_GATEUP);
        if (INL(LP_DOWN)) { PH_ENTER();
            LAS int* pad_end = (LAS int*)(F.lds + LDS_MISC + 64);
            const int total = moe_pad_table(F, l, pad_end);
            OrdMoE S{(const char*)(ws + WS_HMID), (const char*)(ws + WS_WD), (size_t)256 * DEXP * 2, (size_t)1024 * DEXP * 2, (size_t)256 * DEXP * 2, (total / 256) * 4, pad_end, F.G, c_id};
            EpiDown E{(bf16_t*)(ws + WS_SORTA), (const float*)(ws + WS_SLOT + SL_W)};
            pg8::gemm_phase<EpiDown, OrdMoE>(F.lds, F.tid, pg8::Gemm{DEXP, DEXP, DEXP}, S, E);
        }
        SEAM(pb + LP_DOWN);
        if (INL(LP_COMBINE)) { PH_ENTER(); (void)c_id; (void)ws; combine_phase(F, l); }
        SEAM(pb + LP_COMBINE);
    }
#undef IN
#undef SEAM
}

extern "C" void kernel_launch(void* const* d_in, const int* in_sizes, int n_in, void* d_out, int out_size, void* d_ws, size_t ws_size, hipStream_t stream) {
    static int grid = 0;
    if (grid == 0) {
        if (n_in != 28 || out_size != NTOK * DM || ws_size < WS_END) { fprintf(stderr, "kernel_launch: unexpected shapes (n_in %d out %d ws %zu need %zu)\n", n_in, out_size, ws_size, (size_t)WS_END); grid = -1; return; }
        int dev = 0, cus = 0;
        if (hipGetDevice(&dev) != hipSuccess || hipDeviceGetAttribute(&cus, hipDeviceAttributeMultiprocessorCount, dev) != hipSuccess) { grid = -1; return; }
        if (hipFuncSetAttribute((const void*)fwd_kernel, hipFuncAttributeMaxDynamicSharedMemorySize, LDS_BYTES) != hipSuccess) { grid = -1; return; }
        int per_cu = 0;
        if (hipOccupancyMaxActiveBlocksPerMultiprocessor(&per_cu, (const void*)fwd_kernel, NTHREADS, LDS_BYTES) != hipSuccess || per_cu < 1) { fprintf(stderr, "occupancy query: %d\n", per_cu); }
        (void)hipGetLastError();
        grid = cus;
    }
    if (grid < 0) return;
    (void)hipMemsetAsync((char*)d_ws + WS_CTL, 0, CTL_ZERO_BYTES, stream);
    Args a{};
    for (int i = 0; i < 28; ++i) a.in[i] = (const float*)d_in[i];
    a.out = (float*)d_out; a.ws = (unsigned char*)d_ws;
#if MK_ONE_LAUNCH
    a.ph_lo = 0; a.ph_hi = NPH;
    hipLaunchKernelGGL(fwd_kernel, dim3(grid), dim3(NTHREADS), LDS_BYTES, stream, a);
#else
    for (int p = 0; p < NPH; ++p) { a.ph_lo = p; a.ph_hi = p + 1; hipLaunchKernelGGL(fwd_kernel, dim3(grid), dim3(NTHREADS), LDS_BYTES, stream, a); }
#endif
}
```

```cpp
#include <hip/hip_runtime.h>
#include <stdint.h>
#include <stdio.h>

#define LAS __attribute__((address_space(3)))
#define GAS __attribute__((address_space(1)))
typedef unsigned short bf16_t;
typedef short bf16x8 __attribute__((ext_vector_type(8)));
typedef float f32x4 __attribute__((ext_vector_type(4)));
typedef float f32x2 __attribute__((ext_vector_type(2)));
typedef unsigned u32x4 __attribute__((ext_vector_type(4)));
typedef unsigned u32x2 __attribute__((ext_vector_type(2)));

#ifndef MK_ONE_LAUNCH
#define MK_ONE_LAUNCH 1
#endif

constexpr int NB = 4, SEQ = 8192, DM = 1024, NTOK = NB * SEQ, NMEM = 256, DEPTH = 2;
constexpr int PINP = 3072;
constexpr int NEXP = 32, DEXP = 512;
constexpr int CAP = NTOK * 2 + NEXP * 256;
constexpr float EPS = 1e-6f;
constexpr int NWAVES = 8, NTHREADS = 512;

constexpr size_t MiB = 1u << 20;
constexpr size_t WS_CTL   = 0;
constexpr size_t WS_WIN   = 1 * MiB;
constexpr size_t WS_WOUT  = 14 * MiB;
constexpr size_t WS_WQB   = 18 * MiB;
constexpr size_t WS_WKV   = 22 * MiB;
constexpr size_t WS_WOT   = 30 * MiB;
constexpr size_t WS_MEMN  = 34 * MiB;
constexpr size_t WS_KV    = 38 * MiB;
constexpr size_t WS_KQT   = 46 * MiB;
constexpr size_t WS_VOT   = 62 * MiB;
constexpr size_t WS_SSQ   = 78 * MiB;
constexpr size_t WS_TAB   = 80 * MiB;
constexpr size_t WS_XB    = 84 * MiB;
constexpr size_t WS_STAGE = 148 * MiB;
constexpr size_t WS_PROJ  = WS_STAGE;
constexpr size_t WS_VTA   = WS_PROJ + 32 * MiB;
constexpr size_t WS_WD    = WS_PROJ;
constexpr size_t WS_P     = WS_PROJ + 48 * MiB;
constexpr size_t WS_WGU   = WS_PROJ + 112 * MiB;
constexpr size_t WS_AB    = WS_PROJ + 192 * MiB;
constexpr size_t WS_YCAT  = WS_AB + 2 * MiB;
constexpr size_t WS_MIXS  = WS_YCAT + 64 * MiB;
constexpr size_t WS_RET   = WS_MIXS + 128 * MiB;
constexpr size_t WS_MIX_END = WS_RET + 16 * MiB;
constexpr size_t WS_SORTA = WS_AB;
constexpr size_t WS_HMID  = WS_SORTA + 144 * MiB;
constexpr size_t WS_SLOT  = WS_HMID + 72 * MiB;
constexpr size_t WS_MOE_END = WS_SLOT + 2 * MiB;
constexpr size_t WS_END = WS_MIX_END > WS_MOE_END ? WS_MIX_END : WS_MOE_END;
static_assert(WS_END <= 580 * MiB, "workspace budget");
constexpr size_t TAB_ROPE = 0;
constexpr size_t TAB_RFR  = 2 * MiB;
constexpr size_t TAB_POOL = 3 * MiB;
constexpr size_t SL_TOK = 0, SL_W = 512 * 1024, SL_RSTD = 1024 * 1024, SL_TSLOT = 1536 * 1024;
constexpr size_t TAB_TOKE = 3 * MiB + 256 * 1024;
constexpr size_t TAB_TOKW = 3 * MiB + 512 * 1024;
constexpr size_t TAB_RSTD = 3 * MiB + 832 * 1024;
constexpr size_t TAB_ABF  = 3 * MiB + 768 * 1024;
constexpr int CW_BAR = 4096;
constexpr int CW_CNT = 16384;
constexpr int CW_CUR = 16384 + 64;
constexpr int CW_PAN = 16384 + 1024;
constexpr int CW_CQ = 16384 + 256;
constexpr size_t CTL_ZERO_BYTES = 1 * MiB;

constexpr int LDS_RING = 0, LDS_RING_BYTES = 131072;
constexpr int LDS_EX = 131072;
constexpr int LDS_MISC = 131072 + 8192;
constexpr int LDS_BYTES = 147456;

typedef __bf16 bf16v2_t __attribute__((ext_vector_type(2)));
__device__ __forceinline__ unsigned pk2(float lo, float hi) { const f32x2 v = (f32x2){lo, hi}; const bf16v2_t r = __builtin_convertvector(v, bf16v2_t); return __builtin_bit_cast(unsigned, r); }
__device__ __forceinline__ unsigned f2bf(float f) { return pk2(f, f) & 0xffffu; }
__device__ __forceinline__ float bflo(unsigned w) { return __builtin_bit_cast(float, w << 16); }
__device__ __forceinline__ float bfhi(unsigned w) { return __builtin_bit_cast(float, w & 0xffff0000u); }
__device__ __forceinline__ float bf2f(bf16_t b) { return __builtin_bit_cast(float, ((unsigned)b) << 16); }
__device__ __forceinline__ int lane_now() { unsigned z = 0u; asm volatile("" : "+v"(z)); return (int)__builtin_amdgcn_mbcnt_hi(~0u, __builtin_amdgcn_mbcnt_lo(~0u, z)); }
__device__ __forceinline__ float shfl_xor_f(float v, int m) { return __builtin_bit_cast(float, __builtin_amdgcn_ds_bpermute((lane_now() ^ m) << 2, __builtin_bit_cast(int, v))); }
__device__ __forceinline__ float shfl_f(float v, int src) { return __builtin_bit_cast(float, __builtin_amdgcn_ds_bpermute(src << 2, __builtin_bit_cast(int, v))); }
__device__ __forceinline__ float wave_sum(float v) {
#pragma unroll
    for (int o = 1; o < 64; o <<= 1) v += shfl_xor_f(v, o);
    return v;
}
__device__ __forceinline__ float wave_max(float v) {
#pragma unroll
    for (int o = 1; o < 64; o <<= 1) v = fmaxf(v, shfl_xor_f(v, o));
    return v;
}
__device__ __forceinline__ float silu_f(float x) { return x * __builtin_amdgcn_rcpf(1.f + __expf(-x)); }
__device__ __forceinline__ float sigmoid_f(float x) { return __builtin_amdgcn_rcpf(1.f + __expf(-x)); }
__device__ __forceinline__ float softplus_f(float x) { const float e = __expf(x); return x > 15.f ? x : (x < -15.f ? e : __logf(1.0f + e)); }
#define LDS_WAIT() asm volatile("s_waitcnt lgkmcnt(0)" ::: "memory")
#define VM_WAIT() asm volatile("s_waitcnt vmcnt(0)" ::: "memory")

#define XB_TMO      128
#define XB_XCNT(j)  (256  + 64 * (j))
#define XB_XSUB(j)  (1280 + 64 * (j))
#define XB_XGEN(j)  (2304 + 64 * (j))
#define XB_TOP      3328
#define XB_TOPGEN   3392
#define XCD_BAR_WORDS 3456
#define XB_SPIN_CAP (1u << 22)

__device__ __forceinline__ unsigned xb_ld(GAS unsigned* p)              { return __hip_atomic_load(p, __ATOMIC_RELAXED, __HIP_MEMORY_SCOPE_AGENT); }
__device__ __forceinline__ unsigned xb_add(GAS unsigned* p, unsigned v) { return __hip_atomic_fetch_add(p, v, __ATOMIC_RELAXED, __HIP_MEMORY_SCOPE_AGENT); }
__device__ __forceinline__ unsigned xb_xcc_id() { return (unsigned)__builtin_amdgcn_s_getreg((3 << 11) | 20) & 0xFu; }
#define XB_SPIN(cond, bar) do { unsigned _sp = 0; while (cond) { __builtin_amdgcn_s_sleep(1); \
    if ((++_sp & 255u) == 0u) { if (xb_ld(&(bar)[XB_TMO])) break; if (_sp > XB_SPIN_CAP) { xb_add(&(bar)[XB_TMO], 1u); break; } } } } while (0)

struct XcdBarrier { GAS unsigned* bar; unsigned x; volatile LAS unsigned* st; };

__device__ __forceinline__ XcdBarrier xcd_barrier_post(GAS unsigned* bar, volatile LAS unsigned* st, const bool leader) {
    XcdBarrier b; b.bar = bar; b.x = xb_xcc_id(); b.st = st;
    if (leader) (void)xb_add(&bar[XB_XCNT(b.x)], 1u);
    return b;
}
__device__ __forceinline__ void xcd_barrier_complete(GAS unsigned* bar, unsigned x, unsigned& nloc, unsigned& nx) {
    const unsigned G = gridDim.x * gridDim.y * gridDim.z;
    unsigned sum, cnt, mine, sp = 0u;
    for (;;) {
        sum = 0u; cnt = 0u; mine = 0u;
#pragma unroll
        for (unsigned j = 0; j < 16; ++j) { const unsigned c = xb_ld(&bar[XB_XCNT(j)]); sum += c; cnt += (c > 0u) ? 1u : 0u; mine = (j == x) ? c : mine; }
        if (sum == G) break;
        __builtin_amdgcn_s_sleep(1);
        if ((++sp & 255u) == 0u) { if (xb_ld(&bar[XB_TMO])) break; if (sp > XB_SPIN_CAP) { xb_add(&bar[XB_TMO], 1u); break; } }
    }
    nloc = mine > 0u ? mine : 1u; nx = cnt > 0u ? cnt : 1u;
}
__device__ __forceinline__ void xcd_barrier(const XcdBarrier& b, const bool leader) {
    asm volatile("s_waitcnt vmcnt(0)" ::: "memory");
    __syncthreads();
    if (leader) {
        GAS unsigned* bar = b.bar;
        __builtin_amdgcn_s_waitcnt(0);
        unsigned nloc = b.st[0], nx = b.st[1];
        if (nloc == 0u) { xcd_barrier_complete(bar, b.x, nloc, nx); b.st[0] = nloc; b.st[1] = nx; }
        const unsigned old = xb_add(&bar[XB_XSUB(b.x)], 1u);
        const unsigned gen = old / nloc;
        if (old + 1u == (gen + 1u) * nloc) {
            __builtin_amdgcn_fence(__ATOMIC_RELEASE, "agent");
            asm volatile("s_waitcnt vmcnt(0)" ::: "memory");
            const unsigned og = xb_add(&bar[XB_TOP], 1u);
            const unsigned tg = og / nx;
            if (og + 1u == (tg + 1u) * nx) xb_add(&bar[XB_TOPGEN], 1u);
            else XB_SPIN(xb_ld(&bar[XB_TOPGEN]) == tg, bar);
            __builtin_amdgcn_fence(__ATOMIC_ACQUIRE, "agent");
            xb_add(&bar[XB_XGEN(b.x)], 1u);
            asm volatile("s_waitcnt vmcnt(0)" ::: "memory");
        } else {
            XB_SPIN(xb_ld(&bar[XB_XGEN(b.x)]) == gen, bar);
            __builtin_amdgcn_fence(__ATOMIC_ACQUIRE, "agent");
            asm volatile("s_waitcnt vmcnt(0)" ::: "memory");
        }
    }
    __syncthreads();
}

namespace pg8 {
constexpr int BM = 256, BK = 64, HALF = 128, HTB = HALF * BK * 2, STAGE_BYTES = 8 * HTB, NXCD = 8, WGM = 8;
__host__ __device__ __forceinline__ int lds_byte(int r, int c) { const int st = (r >> 4) * 2 + (c >> 5), rr = r & 15, cc = c & 31, ob = rr * 64 + cc * 2; return st * 1024 + (ob ^ (((ob >> 9) & 1) << 5)); }
__host__ __device__ __forceinline__ void stage_rc(int b, int& R, int& C) { const int st = b / 1024, sb = b % 1024, swz = sb ^ (((sb >> 9) & 1) << 5); R = (st >> 1) * 16 + swz / 64; C = (st & 1) * 32 + (swz % 64) / 2; }
__host__ __device__ __forceinline__ int perm32(int rho) { const int n = rho >> 4, i = rho & 15; return 8 * (i >> 2) + 4 * n + (i & 3); }

struct Unit { int pm, pn, z; };
struct Gemm { int lda, ldb, K; };

__device__ __forceinline__ void static_map(int wgid, int nM, int nN, int& pm, int& pn) {
    const int nwg = nM * nN;
    { const int q = nwg / NXCD, r = nwg % NXCD, xcd = wgid % NXCD, off = wgid / NXCD; wgid = (xcd < r ? xcd * (q + 1) : r * (q + 1) + (xcd - r) * q) + off; }
    const int nig = WGM * nN, gid = wgid / nig, fm = gid * WGM, gsz = (nM - fm) < WGM ? (nM - fm) : WGM;
    pm = fm + ((wgid % nig) % gsz); pn = (wgid % nig) / gsz;
}

__device__ __forceinline__ unsigned cvt_pk_bf16(float lo, float hi) { unsigned r; asm volatile("v_cvt_pk_bf16_f32 %0, %1, %2" : "=v"(r) : "v"(lo), "v"(hi)); return r; }

template <class Epi, class Sched, bool GATHER = false, bool ABLK = false, bool HOOKS = false>
__device__ __forceinline__ void gemm_phase(LAS unsigned char* lds, const int tid, const Gemm g, const Sched& S, const Epi& E) {
    const int wid = __builtin_amdgcn_readfirstlane(tid >> 6), lane = tid & 63, wr = wid >> 2, wc = wid & 3, fr = lane & 15, fq = lane >> 4;
    const int K = g.K, nt = K / BK;
    unsigned voffA[2], voffB[2];
#pragma unroll
    for (int i = 0; i < 2; ++i) { int R, C; stage_rc(tid * 16 + i * 8192, R, C); const int Rb = Epi::PERM ? ((R & ~31) + perm32(R & 31)) : R;
        voffA[i] = ABLK ? (unsigned)((R >> 4) * 16 * g.lda) * 2u + (unsigned)(((C >> 5) * 4 + (lane >> 4)) * 256 + (lane & 15) * 16) : (unsigned)(R * g.lda + C) * 2u; voffB[i] = (unsigned)(Rb * g.ldb + C) * 2u; }
    unsigned voA[2][2]; int gr[2][2];
#define PG8_GROWS(u) do { _Pragma("unroll") for (int _h = 0; _h < 2; ++_h) _Pragma("unroll") for (int _i = 0; _i < 2; ++_i) { int _R, _C; stage_rc(tid * 16 + _i * 8192, _R, _C); gr[_h][_i] = S.row_of((u), _h * HALF + _R); } } while (0)
#define PG8_GOFFS(dst) do { _Pragma("unroll") for (int _h = 0; _h < 2; ++_h) _Pragma("unroll") for (int _i = 0; _i < 2; ++_i) { int _R, _C; stage_rc(tid * 16 + _i * 8192, _R, _C); (dst)[_h][_i] = (unsigned)(gr[_h][_i] * g.lda + _C) * 2u; } } while (0)
    const size_t kstep = (size_t)(BK * 2), kstepA = ABLK ? (size_t)2048 : kstep;
    const size_t hstepA = (size_t)HALF * g.lda * 2, hstepB = (size_t)HALF * g.ldb * 2;
    const unsigned ldsw = (unsigned)wid * 1024u;
    const int aoff = ABLK ? wr * 8192 + fq * 256 + fr * 16 : lds_byte(wr * 64 + fr, fq * 8), boff = lds_byte(wc * 32 + fr, fq * 8);
#define PG8_SA(b, h) (((b) * 2 + (h)) * HTB)
#define PG8_SB(b, h) ((4 + (b) * 2 + (h)) * HTB)
#define PG8_STAGE(bufoff, gbase, voff) do { _Pragma("unroll") for (int _i = 0; _i < 2; ++_i) \
        __builtin_amdgcn_global_load_lds((const GAS unsigned*)((const GAS char*)(gbase) + (voff)[_i]), (LAS unsigned*)(lds + (bufoff) + ldsw + _i * 8192), 16, 0, 0); } while (0)
#define PG8_LDA(dst, b, h) do { _Pragma("unroll") for (int m = 0; m < 4; ++m) _Pragma("unroll") for (int k = 0; k < 2; ++k) dst[m][k] = *(const LAS bf16x8*)(lds + PG8_SA(b, h) + aoff + m * 2048 + k * 1024); } while (0)
#define PG8_LDB(dst, b, h) do { _Pragma("unroll") for (int n = 0; n < 2; ++n) _Pragma("unroll") for (int k = 0; k < 2; ++k) dst[n][k] = *(const LAS bf16x8*)(lds + PG8_SB(b, h) + boff + n * 2048 + k * 1024); } while (0)
#define PG8_MMA(ai, bj, At, Bt) do { __builtin_amdgcn_s_setprio(1); _Pragma("unroll") for (int m = 0; m < 4; ++m) _Pragma("unroll") for (int n = 0; n < 2; ++n) _Pragma("unroll") for (int k = 0; k < 2; ++k) \
        acc[ai][bj][m][n] = __builtin_amdgcn_mfma_f32_16x16x32_bf16(Bt[n][k], At[m][k], acc[ai][bj][m][n], 0, 0, 0); __builtin_amdgcn_s_setprio(0); } while (0)
#define PG8_WAIT_V(n) asm volatile("s_waitcnt vmcnt(" #n ")" ::: "memory")
#define PG8_WAIT_L(n) asm volatile("s_waitcnt lgkmcnt(" #n ")" ::: "memory")
#define PG8_BAR __builtin_amdgcn_s_barrier()
#define PG8_SCHED __builtin_amdgcn_sched_barrier(0)
    Unit cur, nxt; int ui = 0;
    if (!S.next(0, cur)) return;
    if constexpr (HOOKS) S.a_ready(cur, wid);
    f32x4 acc[2][2][4][2];
#pragma unroll
    for (int a = 0; a < 2; ++a)
#pragma unroll
        for (int b = 0; b < 2; ++b)
#pragma unroll
            for (int m = 0; m < 4; ++m)
#pragma unroll
                for (int n = 0; n < 2; ++n) acc[a][b][m][n] = (f32x4){0.f, 0.f, 0.f, 0.f};
    bf16x8 At[4][2], B0[2][2], B1[2][2];
    const GAS char* cA = S.a_ptr(cur); const GAS char* cB = S.b_ptr(cur);
    {
        if constexpr (GATHER) { PG8_GROWS(cur); PG8_GOFFS(voA); }
        else { _Pragma("unroll") for (int _i = 0; _i < 2; ++_i) { voA[0][_i] = voffA[_i]; voA[1][_i] = voffA[_i] + (unsigned)hstepA; } }
        PG8_STAGE(PG8_SB(0, 0), cB, voffB); PG8_STAGE(PG8_SB(0, 1), cB + hstepB, voffB); PG8_STAGE(PG8_SA(0, 0), cA, voA[0]); PG8_STAGE(PG8_SA(0, 1), cA, voA[1]);
        if (wr == 1) PG8_BAR;
        PG8_WAIT_V(2); PG8_BAR;
        PG8_STAGE(PG8_SB(1, 0), cB + kstep, voffB); PG8_STAGE(PG8_SA(1, 0), cA + kstepA, voA[0]); PG8_STAGE(PG8_SB(1, 1), cB + hstepB + kstep, voffB);
        PG8_WAIT_V(6); PG8_BAR;
    }
    for (;;) {
        const bool has_next = S.next(ui + 1, nxt);
        const GAS char* nA = has_next ? S.a_ptr(nxt) : cA; const GAS char* nB = has_next ? S.b_ptr(nxt) : cB;
        if constexpr (HOOKS) { if (has_next) S.a_ready(nxt, wid); }
        if constexpr (GATHER) { if (has_next) PG8_GROWS(nxt); }
        for (int t = 0; t < nt; t += 2) {
            const bool last = (t == nt - 2);
            const GAS char* a1 = cA + (size_t)(t + 1) * kstepA;
            const GAS char* a2 = last ? nA : cA + (size_t)(t + 2) * kstepA; const GAS char* b2 = last ? nB : cB + (size_t)(t + 2) * kstep;
            const GAS char* a3 = a2 + kstepA; const GAS char* b3 = b2 + kstep;
            PG8_LDB(B0, 0, 0); PG8_LDB(B1, 0, 1); PG8_SCHED; PG8_LDA(At, 0, 0); PG8_STAGE(PG8_SA(1, 1), a1, voA[1]);
            if constexpr (GATHER) { if (last && has_next) { asm volatile("" : "+v"(gr[0][0]), "+v"(gr[0][1]), "+v"(gr[1][0]), "+v"(gr[1][1])); PG8_GOFFS(voA); } }
            PG8_WAIT_V(8); PG8_WAIT_L(0); PG8_BAR; PG8_MMA(0, 0, At, B0); PG8_MMA(0, 1, At, B1); PG8_BAR; PG8_SCHED;
            PG8_LDA(At, 0, 1); PG8_STAGE(PG8_SB(0, 0), b2, voffB); PG8_STAGE(PG8_SB(0, 1), b2 + hstepB, voffB); PG8_STAGE(PG8_SA(0, 0), a2, voA[0]);
            PG8_WAIT_V(8); PG8_WAIT_L(0); PG8_BAR; PG8_MMA(1, 0, At, B0); PG8_MMA(1, 1, At, B1); PG8_BAR; PG8_SCHED;
            PG8_LDB(B0, 1, 0); PG8_LDB(B1, 1, 1); PG8_SCHED; PG8_LDA(At, 1, 0); PG8_STAGE(PG8_SA(0, 1), a2, voA[1]);
            PG8_WAIT_V(8); PG8_WAIT_L(0); PG8_BAR; PG8_MMA(0, 0, At, B0); PG8_MMA(0, 1, At, B1); PG8_BAR; PG8_SCHED;
            PG8_LDA(At, 1, 1); PG8_STAGE(PG8_SB(1, 0), b3, voffB); PG8_STAGE(PG8_SB(1, 1), b3 + hstepB, voffB); PG8_STAGE(PG8_SA(1, 0), a3, voA[0]);
            PG8_WAIT_V(8); PG8_WAIT_L(0); PG8_BAR; PG8_MMA(1, 0, At, B0); PG8_MMA(1, 1, At, B1); PG8_BAR; PG8_SCHED;
        }
        if (wr == 0) PG8_BAR;
        E(acc, cur, wr, wc, fr, fq);
        if constexpr (HOOKS) S.done(cur);
        if (!has_next) break;
#pragma unroll
        for (int a = 0; a < 2; ++a)
#pragma unroll
            for (int b = 0; b < 2; ++b)
#pragma unroll
                for (int m = 0; m < 4; ++m)
#pragma unroll
                    for (int n = 0; n < 2; ++n) acc[a][b][m][n] = (f32x4){0.f, 0.f, 0.f, 0.f};
        cur = nxt; cA = nA; cB = nB; ++ui;
        if (wr == 1) PG8_BAR;
    }
    PG8_WAIT_V(0);
    PG8_BAR;
#undef PG8_GROWS
#undef PG8_GOFFS
#undef PG8_SA
#undef PG8_SB
#undef PG8_STAGE
#undef PG8_LDA
#undef PG8_LDB
#undef PG8_MMA
#undef PG8_WAIT_V
#undef PG8_WAIT_L
#undef PG8_BAR
#undef PG8_SCHED
}
}

struct OrdStd {
    const GAS char* A; const GAS char* B; size_t a_tile, b_tile, b_batch; int nM, nN, G, c;
    __device__ __forceinline__ bool next(int i, pg8::Unit& u) const {
        const long L = (long)i * G + c; if (L >= (long)nM * nN) return false;
        pg8::static_map((int)L, nM, nN, u.pm, u.pn); u.z = 0; return true; }
    __device__ __forceinline__ const GAS char* a_ptr(const pg8::Unit& u) const { return A + (size_t)u.pm * a_tile; }
    __device__ __forceinline__ const GAS char* b_ptr(const pg8::Unit& u) const { return B + (size_t)(u.pm >> 5) * b_batch + (size_t)u.pn * b_tile; }
};
struct OrdInProj {
    const GAS char* A; const GAS char* B; size_t tile; int nM, nN, G, c;
    __device__ __forceinline__ bool next(int i, pg8::Unit& u) const {
        const long L = (long)i * G + c; if (L >= (long)nM * nN) return false;
        pg8::static_map((int)L, nM, nN, u.pm, u.pn); u.z = 0; return true; }
    __device__ __forceinline__ const GAS char* a_ptr(const pg8::Unit& u) const { return u.pn == 2 ? B + (size_t)u.pn * tile : A + (size_t)u.pm * tile; }
    __device__ __forceinline__ const GAS char* b_ptr(const pg8::Unit& u) const { return u.pn == 2 ? A + (size_t)u.pm * tile : B + (size_t)u.pn * tile; }
};
struct OrdKV {
    const GAS char* memn; const GAS char* wkv; int G, c;
    __device__ __forceinline__ bool next(int i, pg8::Unit& u) const { const int L = i * G + c; if (L >= 64) return false; u.pm = L >> 3; u.pn = L & 7; u.z = 0; return true; }
    __device__ __forceinline__ const GAS char* a_ptr(const pg8::Unit& u) const { return memn + (size_t)u.pm * 256 * 1024 * 2; }
    __device__ __forceinline__ const GAS char* b_ptr(const pg8::Unit& u) const { return wkv + ((size_t)(u.pm >> 2) * 2048 + (size_t)u.pn * 256) * 1024 * 2; }
};
struct OrdKq {
    const GAS char* kv; const GAS char* wqb; int G, c;
    __device__ __forceinline__ bool next(int i, pg8::Unit& u) const { const int L = i * G + c; if (L >= 128) return false;
        const int l = L >> 6, b = (L >> 4) & 3, h = (L >> 2) & 3, q = L & 3; u.pm = (l * 4 + b) * 4 + h; u.pn = q; u.z = L; return true; }
    __device__ __forceinline__ const GAS char* a_ptr(const pg8::Unit& u) const { const int L = u.z, l = L >> 6, b = (L >> 4) & 3, h = (L >> 2) & 3;
        return kv + (((size_t)l * 1024 + b * 256) * 2048 + h * 256) * 2; }
    __device__ __forceinline__ const GAS char* b_ptr(const pg8::Unit& u) const { const int L = u.z, l = L >> 6, h = (L >> 2) & 3, q = L & 3;
        return wqb + ((size_t)l * 1048576 + (size_t)q * 256 * 1024 + h * 256) * 2; }
};
struct OrdVo {
    const GAS char* kv; const GAS char* wot; int G, c;
    __device__ __forceinline__ bool next(int i, pg8::Unit& u) const { const int L = i * G + c; if (L >= 128) return false;
        const int l = L >> 6, b = (L >> 4) & 3, h = (L >> 2) & 3, q = L & 3; u.pm = (l * 4 + b) * 4 + q; u.pn = h; u.z = L; return true; }
    __device__ __forceinline__ const GAS char* a_ptr(const pg8::Unit& u) const { const int L = u.z, l = L >> 6, h = (L >> 2) & 3, q = L & 3;
        return wot + ((size_t)l * 1048576 + (size_t)q * 256 * 1024 + h * 256) * 2; }
    __device__ __forceinline__ const GAS char* b_ptr(const pg8::Unit& u) const { const int L = u.z, l = L >> 6, b = (L >> 4) & 3, h = (L >> 2) & 3;
        return kv + (((size_t)l * 1024 + b * 256) * 2048 + 1024 + h * 256) * 2; }
};
struct OrdMoE {
    const GAS char* A; const GAS char* B; size_t a_tile, b_exp, b_tile; int nunits; const LAS int* pad_end; int G, c; const GAS int* rowtab; GAS unsigned* pan; int bal;
    __device__ __forceinline__ bool next(int i, pg8::Unit& u) const {
        long L = (long)i * G + c;
        if (bal) {
            const int fr = nunits / G, rem = nunits - fr * G;
            if (i == fr - 1) { if (c >= G - rem) return false; }
            else if (i == fr) { if (c >= 2 * rem) return false; L = (long)fr * G - rem + c; }
            else if (i > fr) return false;
        }
        if (L >= nunits) return false;
        u.pm = (int)(L >> 2); u.pn = (int)(L & 3); int e = 0; const int r0 = u.pm * 256;
        const LAS int* pe = pad_end; asm volatile("" : "+v"(pe));
        for (int j = 0; j < NEXP; ++j) e += (pe[j] <= r0) ? 1 : 0;
        e = __builtin_amdgcn_readfirstlane(e);
        u.z = e < NEXP ? e : NEXP - 1; return true; }
    __device__ __forceinline__ const GAS char* a_ptr(const pg8::Unit& u) const { return A + (size_t)u.pm * a_tile; }
    __device__ __forceinline__ const GAS char* b_ptr(const pg8::Unit& u) const { return B + (size_t)u.z * b_exp + (size_t)u.pn * b_tile; }
    __device__ __forceinline__ int row_of(const pg8::Unit& u, int r) const { return rowtab[u.pm * 256 + r]; }
    __device__ __forceinline__ void done(const pg8::Unit& u) const {
        if (rowtab == nullptr) return;
        asm volatile("s_waitcnt vmcnt(0)" ::: "memory");
        if (lane_now() == 0) __hip_atomic_fetch_add(pan + 16 * u.pm, 1u, __ATOMIC_RELAXED, __HIP_MEMORY_SCOPE_AGENT);
    }
    __device__ __forceinline__ void a_ready(const pg8::Unit& u, int wid) const {
        if (rowtab != nullptr) return;
        if (wid == 0) { GAS unsigned* p = pan + 16 * u.pm; unsigned sp = 0;
            while (xb_ld(p) < 32u) { __builtin_amdgcn_s_sleep(1); if (++sp > XB_SPIN_CAP) break; }
            __builtin_amdgcn_fence(__ATOMIC_ACQUIRE, "agent"); asm volatile("s_waitcnt vmcnt(0)" ::: "memory"); }
        asm volatile("" ::: "memory"); __builtin_amdgcn_s_barrier(); asm volatile("" ::: "memory");
    }
};

typedef const f32x4 (&AccRef)[2][2][4][2];
__device__ __forceinline__ float row_rstd(const GAS float* ssq, int row) {
    const GAS f32x4* p = (const GAS f32x4*)(ssq + (size_t)row * 16);
    const f32x4 a = p[0], b = p[1], c = p[2], d = p[3];
    const float s = ((a.x + a.y) + (a.z + a.w)) + ((b.x + b.y) + (b.z + b.w)) + ((c.x + c.y) + (c.z + c.w)) + ((d.x + d.y) + (d.z + d.w));
    return rsqrtf(s * (1.0f / DM) + EPS);
}
__device__ __forceinline__ u32x4 pack8(f32x4 v0, f32x4 v1) {
    u32x4 w; w.x = pg8::cvt_pk_bf16(v0[0], v0[1]); w.y = pg8::cvt_pk_bf16(v0[2], v0[3]); w.z = pg8::cvt_pk_bf16(v1[0], v1[1]); w.w = pg8::cvt_pk_bf16(v1[2], v1[3]); return w; }

struct EpiBf {
    static constexpr bool PERM = true; GAS bf16_t* O; int ldc;
    __device__ __forceinline__ void operator()(AccRef acc, const pg8::Unit& u, int wr, int wc, int fr, int fq) const {
        { const int _l = lane_now(); fr = _l & 15; fq = _l >> 4; }
        const int row0 = u.pm * 256 + wr * 64 + fr, col0 = u.pn * 256 + wc * 32 + 8 * fq;
#pragma unroll
        for (int ai = 0; ai < 2; ++ai)
#pragma unroll
            for (int m = 0; m < 4; ++m) { asm volatile("" ::: "memory"); GAS bf16_t* rowp = O + (size_t)(row0 + ai * 128 + m * 16) * ldc + col0;
#pragma unroll
                for (int bj = 0; bj < 2; ++bj) *(GAS u32x4*)(rowp + bj * 128) = pack8(acc[ai][bj][m][0], acc[ai][bj][m][1]); }
    }
};
struct EpiProj {
    static constexpr bool PERM = true; GAS bf16_t* proj; GAS float* ab; const GAS float* ssq; GAS bf16_t* vta;
    __device__ __forceinline__ void operator()(AccRef acc, const pg8::Unit& u, int wr, int wc, int fr, int fq) const {
        { const int _l = lane_now(); fr = _l & 15; fq = _l >> 4; }
        if (u.pn == 2) {
            const int tok0 = u.pm * 256 + wc * 32 + 8 * fq;
#pragma unroll
            for (int bj = 0; bj < 2; ++bj) { float rs[8];
#pragma unroll
                for (int e = 0; e < 8; ++e) rs[e] = ssq[tok0 + bj * 128 + e];
                const int tk = tok0 + bj * 128; GAS bf16_t* vb = vta + ((size_t)(tk >> 6) * 128 + ((tk & 63) >> 3)) * 128 + fr * 8;
#pragma unroll
                for (int ai = 0; ai < 2; ++ai)
#pragma unroll
                    for (int m = 0; m < 4; ++m) { const f32x4 a0 = acc[ai][bj][m][0], a1 = acc[ai][bj][m][1];
                        const f32x4 s0 = (f32x4){a0[0] * rs[0], a0[1] * rs[1], a0[2] * rs[2], a0[3] * rs[3]}, s1 = (f32x4){a1[0] * rs[4], a1[1] * rs[5], a1[2] * rs[6], a1[3] * rs[7]};
                        *(GAS u32x4*)(vb + (size_t)(((2 * ai + wr) * 4 + m) * 8) * 128) = pack8(s0, s1); } }
            return; }
        const int row0 = u.pm * 256 + wr * 64 + fr;
        float rsv[2][4];
#pragma unroll
        for (int ai = 0; ai < 2; ++ai)
#pragma unroll
            for (int m = 0; m < 4; ++m) rsv[ai][m] = ssq[row0 + ai * 128 + m * 16];
#pragma unroll
        for (int ai = 0; ai < 2; ++ai)
#pragma unroll
            for (int m = 0; m < 4; ++m) { asm volatile("" ::: "memory"); const int row = row0 + ai * 128 + m * 16; const float rs = rsv[ai][m];
                const bool blk = (0xdb >> u.pn) & 1;
                GAS bf16_t* rowp = blk ? proj + ((size_t)u.pn * NTOK + (row & ~15)) * 256 + (wc * 4 + fq) * 128 + (row & 15) * 8
                                              : proj + ((size_t)u.pn * NTOK + row) * 256 + wc * 32 + 8 * fq;
                const int bjs = blk ? 16 * 128 : 128;
#pragma unroll
                for (int bj = 0; bj < 2; ++bj) *(GAS u32x4*)(rowp + bj * bjs) = pack8(acc[ai][bj][m][0] * rs, acc[ai][bj][m][1] * rs);
            }
    }
};
struct EpiResid {
    static constexpr bool PERM = true; GAS bf16_t* xb; GAS float* ssq;
    __device__ __forceinline__ void operator()(AccRef acc, const pg8::Unit& u, int wr, int wc, int fr, int fq) const {
        { const int _l = lane_now(); fr = _l & 15; fq = _l >> 4; }
        const int row0 = u.pm * 256 + wr * 64 + fr, col0 = u.pn * 256 + wc * 32 + 8 * fq;
#pragma unroll
        for (int ai = 0; ai < 2; ++ai) { asm volatile("" ::: "memory");
            u32x4 xo[4][2];
#pragma unroll
            for (int m = 0; m < 4; ++m)
#pragma unroll
                for (int bj = 0; bj < 2; ++bj) xo[m][bj] = *(const GAS u32x4*)(xb + (size_t)(row0 + ai * 128 + m * 16) * DM + col0 + bj * 128);
#pragma unroll
            for (int m = 0; m < 4; ++m) { const int row = row0 + ai * 128 + m * 16; float s = 0.f;
#pragma unroll
                for (int bj = 0; bj < 2; ++bj) { const size_t o = (size_t)row * DM + col0 + bj * 128; const u32x4 x = xo[m][bj];
                    const f32x4 v0 = acc[ai][bj][m][0] + (f32x4){bflo(x.x), bfhi(x.x), bflo(x.y), bfhi(x.y)}, v1 = acc[ai][bj][m][1] + (f32x4){bflo(x.z), bfhi(x.z), bflo(x.w), bfhi(x.w)};
                    const u32x4 w = pack8(v0, v1); *(GAS u32x4*)(xb + o) = w;
                    const float r0 = bflo(w.x), r1 = bfhi(w.x), r2 = bflo(w.y), r3 = bfhi(w.y), r4 = bflo(w.z), r5 = bfhi(w.z), r6 = bflo(w.w), r7 = bfhi(w.w);
                    s += (r0 * r0 + r1 * r1) + (r2 * r2 + r3 * r3) + (r4 * r4 + r5 * r5) + (r6 * r6 + r7 * r7); }
                s += shfl_xor_f(s, 16); s += shfl_xor_f(s, 32);
                if (fq == 0) ssq[(size_t)row * 16 + u.pn * 4 + wc] = s; } }
    }
};
struct EpiSoftmax {
    static constexpr bool PERM = true; GAS bf16_t* P; const GAS float* ssq; LAS float* ex;
    __device__ __forceinline__ void operator()(AccRef acc, const pg8::Unit& u, int wr, int wc, int fr, int fq) const {
        { const int _l = lane_now(); fr = _l & 15; fq = _l >> 4; }
        const int rl0 = wr * 64 + fr, col0 = u.pn * 256 + wc * 32 + 8 * fq;
        LAS float* exm = ex; LAS float* exs = ex + 1024; LAS float* exr = ex + 2048 + 256;
#pragma unroll
        for (int ai = 0; ai < 2; ++ai)
#pragma unroll
            for (int m = 0; m < 4; ++m) { const int rl = rl0 + ai * 128 + m * 16;
                float mx = -3.0e38f;
#pragma unroll
                for (int bj = 0; bj < 2; ++bj)
#pragma unroll
                    for (int n = 0; n < 2; ++n) { const f32x4 v = acc[ai][bj][m][n]; mx = fmaxf(mx, fmaxf(fmaxf(v[0], v[1]), fmaxf(v[2], v[3]))); }
                mx = fmaxf(mx, shfl_xor_f(mx, 16)); mx = fmaxf(mx, shfl_xor_f(mx, 32));
                if (fq == 0) exm[rl * 4 + wc] = mx; }
        if (wr == 0) { const int rl = wc * 64 + fq * 16 + fr; exr[rl] = row_rstd(ssq, u.pm * 256 + rl); }
        asm volatile("s_waitcnt lgkmcnt(0)" ::: "memory"); __builtin_amdgcn_s_barrier(); asm volatile("" ::: "memory");
#pragma unroll
        for (int ai = 0; ai < 2; ++ai)
#pragma unroll
            for (int m = 0; m < 4; ++m) { asm volatile("" ::: "memory"); const int rl = rl0 + ai * 128 + m * 16; const f32x4 q = *(const LAS f32x4*)(exm + rl * 4); const float rs = exr[rl];
                const float mx = fmaxf(fmaxf(q[0], q[1]), fmaxf(q[2], q[3])) * rs; float s = 0.f;
#pragma unroll
                for (int bj = 0; bj < 2; ++bj)
#pragma unroll
                    for (int n = 0; n < 2; ++n) { const f32x4 v = acc[ai][bj][m][n] * rs - mx; s += (__expf(v[0]) + __expf(v[1])) + (__expf(v[2]) + __expf(v[3])); }
                s += shfl_xor_f(s, 16); s += shfl_xor_f(s, 32);
                if (fq == 0) exs[rl * 4 + wc] = s; }
        asm volatile("s_waitcnt lgkmcnt(0)" ::: "memory"); __builtin_amdgcn_s_barrier(); asm volatile("" ::: "memory");
#pragma unroll
        for (int ai = 0; ai < 2; ++ai)
#pragma unroll
            for (int m = 0; m < 4; ++m) { asm volatile("" ::: "memory"); const int rl = rl0 + ai * 128 + m * 16; const f32x4 q = *(const LAS f32x4*)(exs + rl * 4), qm = *(const LAS f32x4*)(exm + rl * 4);
                const float rs = exr[rl];
                const float inv = 1.0f / ((q[0] + q[1]) + (q[2] + q[3])); const float mx = fmaxf(fmaxf(qm[0], qm[1]), fmaxf(qm[2], qm[3])) * rs;
                GAS bf16_t* rowp = P + (size_t)(u.pm * 256 + (rl & ~15)) * DM + (col0 >> 3) * 128 + (rl & 15) * 8;
#pragma unroll
                for (int bj = 0; bj < 2; ++bj) { f32x4 v0 = acc[ai][bj][m][0] * rs - mx, v1 = acc[ai][bj][m][1] * rs - mx;
#pragma unroll
                    for (int j = 0; j < 4; ++j) { v0[j] = __expf(v0[j]) * inv; v1[j] = __expf(v1[j]) * inv; }
                    *(GAS u32x4*)(rowp + bj * 2048) = pack8(v0, v1); } }
        asm volatile("s_waitcnt lgkmcnt(0)" ::: "memory");
    }
};
struct EpiGateUp {
    static constexpr bool PERM = true; GAS bf16_t* hmid; const GAS float* slot_rstd;
    __device__ __forceinline__ void operator()(AccRef acc, const pg8::Unit& u, int wr, int wc, int fr, int fq) const {
        { const int _l = lane_now(); fr = _l & 15; fq = _l >> 4; }
        const int row0 = u.pm * 256 + wr * 64 + fr, col0 = u.pn * 128 + wc * 16 + 4 * fq;
        float rsv[2][4];
#pragma unroll
        for (int ai = 0; ai < 2; ++ai)
#pragma unroll
            for (int m = 0; m < 4; ++m) rsv[ai][m] = slot_rstd[row0 + ai * 128 + m * 16];
#pragma unroll
        for (int ai = 0; ai < 2; ++ai)
#pragma unroll
            for (int m = 0; m < 4; ++m) { const int row = row0 + ai * 128 + m * 16; const float rs = rsv[ai][m];
#pragma unroll
                for (int bj = 0; bj < 2; ++bj) { const f32x4 v0 = acc[ai][bj][m][0] * rs, v1 = acc[ai][bj][m][1] * rs;
                    u32x2 w; w.x = pg8::cvt_pk_bf16(silu_f(v0[0]) * v0[1], silu_f(v0[2]) * v0[3]); w.y = pg8::cvt_pk_bf16(silu_f(v1[0]) * v1[1], silu_f(v1[2]) * v1[3]);
                    __hip_atomic_store((GAS unsigned long long*)(hmid + (size_t)(row & ~15) * DEXP + ((col0 >> 3) + bj * 8) * 128 + (row & 15) * 8 + (col0 & 4)), (unsigned long long)w.x | ((unsigned long long)w.y << 32), __ATOMIC_RELAXED, __HIP_MEMORY_SCOPE_AGENT); } }
    }
};
struct EpiDown {
    static constexpr bool PERM = true; GAS bf16_t* Y; const GAS float* slot_w;
    __device__ __forceinline__ void operator()(AccRef acc, const pg8::Unit& u, int wr, int wc, int fr, int fq) const {
        { const int _l = lane_now(); fr = _l & 15; fq = _l >> 4; }
        const int row0 = u.pm * 256 + wr * 64 + fr, col0 = u.pn * 256 + wc * 32 + 8 * fq;
        float gwv[2][4];
#pragma unroll
        for (int ai = 0; ai < 2; ++ai)
#pragma unroll
            for (int m = 0; m < 4; ++m) gwv[ai][m] = slot_w[row0 + ai * 128 + m * 16];
#pragma unroll
        for (int ai = 0; ai < 2; ++ai)
#pragma unroll
            for (int m = 0; m < 4; ++m) { const int row = row0 + ai * 128 + m * 16; const float gw = gwv[ai][m]; GAS bf16_t* rowp = Y + (size_t)row * DM + col0;
#pragma unroll
                for (int bj = 0; bj < 2; ++bj) *(GAS u32x4*)(rowp + bj * 128) = pack8(acc[ai][bj][m][0] * gw, acc[ai][bj][m][1] * gw); }
    }
};

#define CAS __attribute__((address_space(4)))
#if defined(__HIP_DEVICE_COMPILE__)
#define ASSUME_GLOBAL(p) do { __builtin_assume(!__builtin_amdgcn_is_shared((const __attribute__((address_space(0))) GAS void*)(p))); __builtin_assume(!__builtin_amdgcn_is_private((const __attribute__((address_space(0))) GAS void*)(p))); } while (0)
#else
#define ASSUME_GLOBAL(p) do { } while (0)
#endif
struct Frame {
    LAS unsigned char* lds; int tid, lane, wave, G, gw, ngw;
    const CAS unsigned char* ka; GAS float* out; GAS unsigned char* ws;
    __device__ __forceinline__ const GAS float* inp(int i) const { const CAS unsigned char* p = ka; asm volatile("" : "+s"(p)); const GAS float* r = (const GAS float*)(((const float* const CAS*)p)[i]); return r; }
};
enum { I_X = 0, I_MEM, I_MIXG, I_WIN, I_RPB, I_RETG, I_POOLW, I_POOLS, I_CONVW, I_ALOG, I_DTB, I_GDNG, I_WOUT, I_MQG, I_MKVG, I_WQ, I_WK, I_WV, I_WO, I_FFNG, I_WGRP, I_BGRP, I_WRT, I_BRT, I_WGATE, I_WUP, I_WDOWN, I_FING };

__device__ __forceinline__ void tr_item(const GAS float* W, int ldw, int nvalid, const GAS float* gain, float scale, GAS bf16_t* WT, int ldt, int row_off, int row_mul,
                                        LAS float* scr, int kb, int nb, int lane) {
    const int k0 = 64 * kb, n0 = 32 * nb, n4 = (lane & 7) * 4, kr = lane >> 3;
    f32x4 v[8];
    const bool full = (n0 + n4 + 3 < nvalid);
#pragma unroll
    for (int i = 0; i < 8; ++i) { const int kk = 8 * i + kr; const GAS float* p = W + (size_t)(k0 + kk) * ldw + n0 + n4;
        if (full) v[i] = *(const GAS f32x4*)p;
        else { v[i] = (f32x4){0.f, 0.f, 0.f, 0.f};
#pragma unroll
            for (int j = 0; j < 4; ++j) if (n0 + n4 + j < nvalid) v[i][j] = p[j]; } }
#pragma unroll
    for (int i = 0; i < 8; ++i) { const int kk = 8 * i + kr; const float sc = gain ? gain[k0 + kk] * scale : scale;
#pragma unroll
        for (int j = 0; j < 4; ++j) scr[kk * 33 + n4 + j] = v[i][j] * sc; }
    LDS_WAIT(); asm volatile("" ::: "memory");
    const int c = lane & 7;
#pragma unroll
    for (int j = 0; j < 4; ++j) { const int n = (lane >> 3) + 8 * j; const LAS float* s = scr + (8 * c) * 33 + n;
        u32x4 o; o.x = pk2(s[0 * 33], s[1 * 33]); o.y = pk2(s[2 * 33], s[3 * 33]); o.z = pk2(s[4 * 33], s[5 * 33]); o.w = pk2(s[6 * 33], s[7 * 33]);
        *(GAS u32x4*)(WT + (size_t)(row_off + (n0 + n) * row_mul) * ldt + k0 + 8 * c) = o; }
    LDS_WAIT(); asm volatile("" ::: "memory");
}

__device__ __forceinline__ float row_to_bf16(const GAS float* xrow, GAS bf16_t* orow, const GAS float* gain, bool norm, int lane) {
    const GAS f32x4* xr = (const GAS f32x4*)xrow + lane;
    f32x4 v[4]; float s = 0.f;
#pragma unroll
    for (int j = 0; j < 4; ++j) { v[j] = xr[64 * j]; s += (v[j].x * v[j].x + v[j].y * v[j].y) + (v[j].z * v[j].z + v[j].w * v[j].w); }
    s = wave_sum(s);
    if (norm) { const float rs = rsqrtf(s * (1.0f / DM) + EPS);
#pragma unroll
        for (int j = 0; j < 4; ++j) { const f32x4 g = ((const GAS f32x4*)gain)[lane + 64 * j]; v[j] = v[j] * rs * g; } }
    GAS u32x2* o8 = (GAS u32x2*)orow + lane;
#pragma unroll
    for (int j = 0; j < 4; ++j) { u32x2 w; w.x = pk2(v[j].x, v[j].y); w.y = pk2(v[j].z, v[j].w); o8[64 * j] = w; }
    return s;
}

__device__ __forceinline__ void p0_prologue(Frame& F) {
    GAS unsigned char* ws = F.ws;
    LAS float* scr = (LAS float*)(F.lds + F.wave * 16384);
    constexpr int I_IN = 16 * 96, I_SQ = 16 * 32;
    constexpr int PER_L = I_IN + 4 * I_SQ;
    for (int it = F.gw; it < 2 * PER_L; it += F.ngw) {
        const int l = it / PER_L; int r = it % PER_L;
        if (r < I_IN) { tr_item(F.inp(I_WIN) + (size_t)l * DM * 3088, 3088, 3088, F.inp(I_MIXG) + l * DM, 1.f, (GAS bf16_t*)(ws + WS_WIN) + (size_t)l * PINP * DM, DM, 0, 1, scr, r / 96, r % 96, F.lane); continue; }
        r -= I_IN;
        if (r < I_SQ) { tr_item(F.inp(I_WOUT) + (size_t)l * DM * DM, DM, DM, nullptr, 1.f, (GAS bf16_t*)(ws + WS_WOUT) + (size_t)l * DM * DM, DM, 0, 1, scr, r / 32, r % 32, F.lane); continue; }
        r -= I_SQ;
        if (r < I_SQ) { tr_item(F.inp(I_WK) + (size_t)l * DM * DM, DM, DM, nullptr, 1.f, (GAS bf16_t*)(ws + WS_WKV) + (size_t)l * 2048 * DM, DM, 0, 1, scr, r / 32, r % 32, F.lane); continue; }
        r -= I_SQ;
        if (r < I_SQ) { tr_item(F.inp(I_WV) + (size_t)l * DM * DM, DM, DM, nullptr, 1.f, (GAS bf16_t*)(ws + WS_WKV) + (size_t)l * 2048 * DM, DM, 1024, 1, scr, r / 32, r % 32, F.lane); continue; }
        r -= I_SQ;
        tr_item(F.inp(I_WO) + (size_t)l * DM * DM, DM, DM, nullptr, 1.f, (GAS bf16_t*)(ws + WS_WOT) + (size_t)l * DM * DM, DM, 0, 1, scr, r / 32, r % 32, F.lane);
    }
    {   const GAS float* X = F.inp(I_X); GAS bf16_t* xbp = (GAS bf16_t*)(ws + WS_XB); GAS float* ssqp = (GAS float*)(ws + WS_SSQ);
        for (int m0 = F.gw * 4; m0 < NTOK; m0 += F.ngw * 4) {
            f32x4 v[4][4];
#pragma unroll
            for (int k = 0; k < 4; ++k)
#pragma unroll
                for (int j = 0; j < 4; ++j) v[k][j] = ((const GAS f32x4*)(X + (size_t)(m0 + k) * DM))[F.lane + 64 * j];
#pragma unroll
            for (int k = 0; k < 4; ++k) { float sq = 0.f; GAS u32x2* o8 = (GAS u32x2*)(xbp + (size_t)(m0 + k) * DM) + F.lane;
#pragma unroll
                for (int j = 0; j < 4; ++j) { sq += (v[k][j].x * v[k][j].x + v[k][j].y * v[k][j].y) + (v[k][j].z * v[k][j].z + v[k][j].w * v[k][j].w);
                    u32x2 w; w.x = pk2(v[k][j].x, v[k][j].y); w.y = pk2(v[k][j].z, v[k][j].w); o8[64 * j] = w; }
                sq = wave_sum(sq);
                if (F.lane < 16) ssqp[(size_t)(m0 + k) * 16 + F.lane] = (F.lane == 0) ? sq : 0.f;
                if (F.lane == 0) ((GAS float*)(ws + WS_TAB + TAB_RSTD))[m0 + k] = rsqrtf(sq * (1.0f / DM) + EPS); } }
        for (int r = F.gw; r < 2048; r += F.ngw) { const int l = r >> 10;
            row_to_bf16(F.inp(I_MEM) + (size_t)(r & 1023) * DM, (GAS bf16_t*)(ws + WS_MEMN) + (size_t)r * DM, F.inp(I_MKVG) + l * DM, true, F.lane); }
    }
    const size_t gt = (size_t)blockIdx.x * NTHREADS + F.tid, ngt = (size_t)F.G * NTHREADS;
    {
        GAS bf16_t* o = (GAS bf16_t*)(ws + WS_WQB);
        for (size_t i = gt; i < (size_t)2 * DM * DM / 4; i += ngt) { const size_t e = i * 4; const int l = (int)(e >> 20), k = (int)((e >> 10) & 1023);
            const f32x4 w = *(const GAS f32x4*)(F.inp(I_WQ) + e); const float g = F.inp(I_MQG)[l * DM + k] * 0.0625f;
            u32x2 p; p.x = pk2(w.x * g, w.y * g); p.y = pk2(w.z * g, w.w * g); *(GAS u32x2*)(o + e) = p; }
    }
    {
        GAS float* tab = (GAS float*)(ws + WS_TAB + TAB_ROPE);
        for (size_t i = gt; i < (size_t)SEQ * 32; i += ngt) { const int pos = (int)(i >> 5), j = (int)(i & 31);
            const float inv = exp2f(-(float)j * (13.287712379549449f / 32.0f)); const float ang = (float)pos * inv;
            const double rev = (double)ang * 0.15915494309189535; const float fr = (float)(rev - floor(rev));
            tab[i * 2] = __builtin_amdgcn_cosf(fr); tab[i * 2 + 1] = __builtin_amdgcn_sinf(fr); }
    }
    {
        GAS bf16_t* fr = (GAS bf16_t*)(ws + WS_TAB + TAB_RFR);
        for (size_t i = gt; i < (size_t)2 * 49152; i += ngt) { const int l = (int)(i / 49152), r = (int)(i % 49152), j = r & 7, ln = (r >> 3) & 63, ct = (r >> 9) % 3, ks = r / 1536;
            const int k = 32 * ks + 8 * (ln >> 4) + j, o = 16 * ct + (ln & 15);
            float w = 0.f; if (o < 32) w = F.inp(I_WRT)[(size_t)l * DM * 32 + (size_t)k * 32 + o]; else if (o < 36) w = F.inp(I_WGRP)[(size_t)l * DM * 4 + (size_t)k * 4 + (o - 32)];
            w *= F.inp(I_FFNG)[l * DM + k];
            const unsigned hi = f2bf(w); const float lo = w - __builtin_bit_cast(float, hi << 16);
            fr[(size_t)l * 98304 + r] = (bf16_t)hi; fr[(size_t)l * 98304 + 49152 + r] = (bf16_t)f2bf(lo); }
    }
    {
        GAS bf16_t* fr = (GAS bf16_t*)(ws + WS_TAB + TAB_ABF);
        for (size_t i = gt; i < (size_t)2 * 16384; i += ngt) { const int l = (int)(i >> 14), r = (int)(i & 16383), j = r & 7, ln = (r >> 3) & 63, ks = r >> 9;
            const int k = 32 * ks + 8 * (ln >> 4) + j, o = ln & 15;
            fr[i] = (bf16_t)f2bf(F.inp(I_WIN)[(size_t)l * DM * 3088 + (size_t)k * 3088 + 3072 + o] * F.inp(I_MIXG)[l * DM + k]); }
    }
    {
        GAS bf16_t* pt = (GAS bf16_t*)(ws + WS_TAB + TAB_POOL);
        for (size_t i = gt; i < (size_t)2 * 4 * 64 * 64; i += ngt) { const int c = (int)(i & 63), e = (int)((i >> 6) & 63), gi = (int)((i >> 12) & 3), l = (int)(i >> 14);
            pt[(i & ~(size_t)4095) + ((e >> 4) * 8 + (c >> 3)) * 128 + (e & 15) * 8 + (c & 7)] = (bf16_t)f2bf(F.inp(I_POOLW)[(((size_t)l * 4 + gi) * 64 + c) * 64 + e] * F.inp(I_POOLS)[l * 256 + gi * 64 + e]); }
    }
}

__device__ __forceinline__ void convert_experts_queue(Frame& F, int l) {
    GAS unsigned char* ws = F.ws;
    LAS float* scr = (LAS float*)(F.lds + F.wave * 16384);
    constexpr int IG = 16 * 16, ID = 8 * 32, PER_E = 2 * IG + ID;
    GAS unsigned* q = (GAS unsigned*)(ws + WS_CTL) + CW_CQ + l * 64;
    const GAS float* wg = F.inp(I_WGATE); const GAS float* wu = F.inp(I_WUP); const GAS float* wd = F.inp(I_WDOWN); const GAS float* gn = F.inp(I_FFNG) + l * DM;
    LAS unsigned* qs = (LAS unsigned*)(F.lds + LDS_MISC + 2048);
    for (;;) {
        __syncthreads();
        if (F.tid == 0) *qs = __hip_atomic_fetch_add(q, 64u, __ATOMIC_RELAXED, __HIP_MEMORY_SCOPE_AGENT);
        __syncthreads();
        const unsigned qb = *qs;
        if (qb >= (unsigned)(NEXP * PER_E)) break;
    for (int it = (int)qb + F.wave; it < (int)qb + 64 && it < NEXP * PER_E; it += NWAVES) {
        const int e = (int)it / PER_E; int r = (int)it % PER_E; const size_t le = (size_t)l * NEXP + e;
        if (r < IG) { tr_item(wg + le * DM * DEXP, DEXP, DEXP, gn, 1.f, (GAS bf16_t*)(ws + WS_WGU) + (size_t)e * 1024 * DM, DM, 0, 2, scr, r / 16, r % 16, F.lane); continue; }
        r -= IG;
        if (r < IG) { tr_item(wu + le * DM * DEXP, DEXP, DEXP, gn, 1.f, (GAS bf16_t*)(ws + WS_WGU) + (size_t)e * 1024 * DM, DM, 1, 2, scr, r / 16, r % 16, F.lane); continue; }
        r -= IG;
        tr_item(wd + le * DEXP * DM, DM, DM, nullptr, 1.f, (GAS bf16_t*)(ws + WS_WD) + (size_t)e * DM * DEXP, DEXP, 0, 1, scr, r / 32, r % 32, F.lane);
    }
    }
}

__device__ __forceinline__ size_t PJ(size_t t, int c) { return ((size_t)(c >> 8) * NTOK + t) * 256 + (c & 255); }
#define MFMA16(a, b, c) __builtin_amdgcn_mfma_f32_16x16x32_bf16((a), (b), (c), 0, 0, 0)

__device__ __forceinline__ void pool_item(Frame& F, const GAS bf16_t* proj, const GAS bf16_t* pt, GAS bf16_t* ycat, int item) {
    int lane = F.lane; asm volatile("" : "+v"(lane));
    const int g = lane >> 4, t = item * 16 + (lane & 15), s = t & (SEQ - 1);
    const GAS bf16_t* base = proj + ((size_t)7 * NTOK + (t - s)) * 256;
#pragma unroll
    for (int gi = 0; gi < 4; ++gi) {
        const int half = 1 << gi; const int lo = max(s - half, 0), hi = min(s + half, SEQ); const float inv = 1.0f / (float)(hi - lo);
        f32x4 acc[4];
#pragma unroll
        for (int et = 0; et < 4; ++et) acc[et] = (f32x4){0.f, 0.f, 0.f, 0.f};
        bf16x8 wf[8];
#pragma unroll
        for (int ks = 0; ks < 2; ++ks)
#pragma unroll
            for (int et = 0; et < 4; ++et) wf[ks * 4 + et] = *(const GAS bf16x8*)(pt + (size_t)gi * 4096 + (et * 8 + ks * 4 + g) * 128 + (lane & 15) * 8);
#pragma unroll
        for (int ks = 0; ks < 2; ++ks) {
            const int cb = (gi * 8 + ks * 4 + g) * 128;
            float sum[8];
#pragma unroll
            for (int j = 0; j < 8; ++j) sum[j] = 0.f;
#pragma unroll
            for (int w2 = 0; w2 < 2 * half; ++w2) { const int s2 = s - half + w2; const bool ok = (s2 >= 0) && (s2 < SEQ);
                u32x4 v = (u32x4){0u, 0u, 0u, 0u}; if (ok) v = *(const GAS u32x4*)((const GAS char*)base + (unsigned)((s2 & ~15) * 512 + cb * 2 + (s2 & 15) * 16));
                sum[0] += bflo(v.x); sum[1] += bfhi(v.x); sum[2] += bflo(v.y); sum[3] += bfhi(v.y); sum[4] += bflo(v.z); sum[5] += bfhi(v.z); sum[6] += bflo(v.w); sum[7] += bfhi(v.w); }
            const u32x4 c = *(const GAS u32x4*)((const GAS char*)base + (unsigned)((s & ~15) * 512 + cb * 2 + (s & 15) * 16));
            u32x4 dd; dd.x = pk2(sum[0] * inv - bflo(c.x), sum[1] * inv - bfhi(c.x)); dd.y = pk2(sum[2] * inv - bflo(c.y), sum[3] * inv - bfhi(c.y));
            dd.z = pk2(sum[4] * inv - bflo(c.z), sum[5] * inv - bfhi(c.z)); dd.w = pk2(sum[6] * inv - bflo(c.w), sum[7] * inv - bfhi(c.w));
            const bf16x8 bfrag = __builtin_bit_cast(bf16x8, dd);
            if (ks == 0) asm volatile("" : "+v"(wf[0]), "+v"(wf[1]), "+v"(wf[2]), "+v"(wf[3]), "+v"(wf[4]), "+v"(wf[5]), "+v"(wf[6]), "+v"(wf[7]));
#pragma unroll
            for (int et = 0; et < 4; ++et) acc[et] = MFMA16(wf[ks * 4 + et], bfrag, acc[et]);
        }
#pragma unroll
        for (int et = 0; et < 4; ++et) { u32x2 w; w.x = pk2(acc[et][0], acc[et][1]); w.y = pk2(acc[et][2], acc[et][3]);
            *(GAS u32x2*)(ycat + (size_t)t * DM + 512 + gi * 64 + et * 16 + g * 4) = w; }
    }
}

__device__ __forceinline__ void na_item(Frame& F, const GAS bf16_t* proj, const GAS bf16_t* vta, const LAS float* rpbs, GAS bf16_t* ycat, int item) {
    const int lane = F.lane, g = lane >> 4, ql = lane & 15;
    const int n = item & 3, r = (item >> 2) & 127, h = (item >> 9) & 3, b = item >> 11; const size_t tb = (size_t)b * SEQ;
    const int kr0 = min(max(r - 4, 0), 120), band = min(max(n * 16 - 8, 0), 32), qc = n * 16 + ql, win = min(max(qc - 8, 0), 48);
    const GAS bf16_t* qrow = proj + (tb + r * 64 + n * 16) * 256 + (h * 8 + g) * 128 + ql * 8;
    const bf16x8 q0 = *(const GAS bf16x8*)qrow, q1 = *(const GAS bf16x8*)(qrow + 4 * 128);
    f32x4 S[16];
    const int kcl = band + 8 * (ql >> 2) + (ql & 3);
#pragma unroll
    for (int tb8 = 0; tb8 < 2; ++tb8) { bf16x8 kf[16];
#pragma unroll
        for (int tt = 0; tt < 8; ++tt) { const int t = tb8 * 8 + tt, i = t >> 1, hf = t & 1; const int kc = kcl + 4 * hf;
            const GAS bf16_t* krow = proj + ((size_t)NTOK + tb + (size_t)(kr0 + i) * 64 + (kc & ~15)) * 256 + (h * 8 + g) * 128 + (kc & 15) * 8;
            kf[2 * tt] = *(const GAS bf16x8*)krow; kf[2 * tt + 1] = *(const GAS bf16x8*)(krow + 4 * 128); }
        asm volatile("" : "+v"(kf[0]), "+v"(kf[1]), "+v"(kf[2]), "+v"(kf[3]), "+v"(kf[4]), "+v"(kf[5]), "+v"(kf[6]), "+v"(kf[7]), "+v"(kf[8]), "+v"(kf[9]), "+v"(kf[10]), "+v"(kf[11]), "+v"(kf[12]), "+v"(kf[13]), "+v"(kf[14]), "+v"(kf[15]));
#pragma unroll
        for (int tt = 0; tt < 8; ++tt) { f32x4 a = (f32x4){0.f, 0.f, 0.f, 0.f}; a = MFMA16(kf[2 * tt], q0, a); a = MFMA16(kf[2 * tt + 1], q1, a); S[tb8 * 8 + tt] = a; } }
    float mx = -3.0e38f;
#pragma unroll
    for (int t = 0; t < 16; ++t) { const int i = t >> 1, hf = t & 1; const LAS float* rp = rpbs + h * 465 + (kr0 + i - r + 7) * 31;
#pragma unroll
        for (int jj = 0; jj < 4; ++jj) { const int kc = band + g * 8 + hf * 4 + jj; const bool ok = (kc >= win) && (kc < win + 16);
            const float sc = ok ? S[t][jj] * 0.125f + rp[ok ? kc - qc + 15 : 0] : -3.0e38f; S[t][jj] = sc; mx = fmaxf(mx, sc); } }
    mx = fmaxf(mx, shfl_xor_f(mx, 16)); mx = fmaxf(mx, shfl_xor_f(mx, 32));
    float sum = 0.f;
#pragma unroll
    for (int t = 0; t < 16; ++t)
#pragma unroll
        for (int jj = 0; jj < 4; ++jj) { const float p = __expf(S[t][jj] - mx); S[t][jj] = p; sum += p; }
    sum += shfl_xor_f(sum, 16); sum += shfl_xor_f(sum, 32);
    const float inv = 1.0f / sum;
    f32x4 O[4];
#pragma unroll
    for (int dt = 0; dt < 4; ++dt) O[dt] = (f32x4){0.f, 0.f, 0.f, 0.f};
#pragma unroll
    for (int vb4 = 0; vb4 < 2; ++vb4) { bf16x8 vl[16];
#pragma unroll
        for (int ii = 0; ii < 4; ++ii) { const int i = vb4 * 4 + ii;
            const GAS bf16_t* vb = vta + ((((size_t)(b * 128 + kr0 + i) * 4 + h) * 4) * 8 + (band >> 3) + g) * 128 + ql * 8;
#pragma unroll
            for (int dt = 0; dt < 4; ++dt) vl[ii * 4 + dt] = *(const GAS bf16x8*)(vb + (size_t)dt * 8 * 128); }
        asm volatile("" : "+v"(vl[0]), "+v"(vl[1]), "+v"(vl[2]), "+v"(vl[3]), "+v"(vl[4]), "+v"(vl[5]), "+v"(vl[6]), "+v"(vl[7]), "+v"(vl[8]), "+v"(vl[9]), "+v"(vl[10]), "+v"(vl[11]), "+v"(vl[12]), "+v"(vl[13]), "+v"(vl[14]), "+v"(vl[15]));
#pragma unroll
        for (int ii = 0; ii < 4; ++ii) { const int i = vb4 * 4 + ii;
            u32x4 pw; pw.x = pk2(S[2 * i][0], S[2 * i][1]); pw.y = pk2(S[2 * i][2], S[2 * i][3]); pw.z = pk2(S[2 * i + 1][0], S[2 * i + 1][1]); pw.w = pk2(S[2 * i + 1][2], S[2 * i + 1][3]);
            const bf16x8 pf = __builtin_bit_cast(bf16x8, pw);
#pragma unroll
            for (int dt = 0; dt < 4; ++dt) O[dt] = MFMA16(pf, vl[ii * 4 + dt], O[dt]); } }
#pragma unroll
    for (int jj = 0; jj < 4; ++jj) { const float iq = shfl_f(inv, g * 4 + jj); GAS bf16_t* orow = ycat + (tb + r * 64 + n * 16 + g * 4 + jj) * DM + h * 64 + ql;
#pragma unroll
        for (int dt = 0; dt < 4; ++dt) orow[dt * 16] = (bf16_t)f2bf(O[dt][jj] * iq); }
}

constexpr int RT_LD = 136;
__device__ __forceinline__ void ret_r1_item(Frame& F, GAS bf16_t* proj, const GAS float* rope, GAS bf16_t* KVT, int item) {
    int tid = F.tid; asm volatile("" : "+v"(tid));
    const int lane = tid & 63, g = lane >> 4, ql = lane & 15;
    const int c = item & 63, h = (item >> 6) & 3, b = item >> 8;
    const float lgf = log2f(1.0f - exp2f(-5.0f - (float)h)), lgb = log2f(1.0f - exp2f(-5.0f - (float)(3 - h)));
    LAS bf16_t* KT = (LAS bf16_t*)F.lds; LAS bf16_t* VTF = KT + 64 * RT_LD; LAS bf16_t* VTB = VTF + 64 * RT_LD;
    {
        constexpr size_t TS = (size_t)NTOK * 256;
        const int i = (tid >> 6) * 16 + (tid & 15), p = (tid >> 4) & 3, s = c * 128 + i; const size_t t = (size_t)b * SEQ + s;
        GAS bf16_t* row = proj + ((size_t)3 * NTOK + (t & ~(size_t)15)) * 256 + (h * 8 + p) * 128 + (i & 15) * 8;
        const u32x4 q1 = *(const GAS u32x4*)(row), q2 = *(const GAS u32x4*)(row + 512), k1 = *(const GAS u32x4*)(row + TS), k2 = *(const GAS u32x4*)(row + TS + 512);
        const GAS f32x4* cs = (const GAS f32x4*)(rope + ((size_t)s * 32 + 8 * p) * 2);
        float qa[8], qb[8], ka[8], kb[8];
        qa[0] = bflo(q1.x); qa[1] = bfhi(q1.x); qa[2] = bflo(q1.y); qa[3] = bfhi(q1.y); qa[4] = bflo(q1.z); qa[5] = bfhi(q1.z); qa[6] = bflo(q1.w); qa[7] = bfhi(q1.w);
        qb[0] = bflo(q2.x); qb[1] = bfhi(q2.x); qb[2] = bflo(q2.y); qb[3] = bfhi(q2.y); qb[4] = bflo(q2.z); qb[5] = bfhi(q2.z); qb[6] = bflo(q2.w); qb[7] = bfhi(q2.w);
        ka[0] = bflo(k1.x); ka[1] = bfhi(k1.x); ka[2] = bflo(k1.y); ka[3] = bfhi(k1.y); ka[4] = bflo(k1.z); ka[5] = bfhi(k1.z); ka[6] = bflo(k1.w); ka[7] = bfhi(k1.w);
        kb[0] = bflo(k2.x); kb[1] = bfhi(k2.x); kb[2] = bflo(k2.y); kb[3] = bfhi(k2.y); kb[4] = bflo(k2.z); kb[5] = bfhi(k2.z); kb[6] = bflo(k2.w); kb[7] = bfhi(k2.w);
        float qo1[8], qo2[8], ko1[8], ko2[8];
#pragma unroll
        for (int m = 0; m < 4; ++m) { const f32x4 w = cs[m];
            { const int j = 2 * m; const float cc = w.x, sn = w.y; qo1[j] = qa[j] * cc - qb[j] * sn; qo2[j] = qa[j] * sn + qb[j] * cc; ko1[j] = (ka[j] * cc - kb[j] * sn) * 0.125f; ko2[j] = (ka[j] * sn + kb[j] * cc) * 0.125f; }
            { const int j = 2 * m + 1; const float cc = w.z, sn = w.w; qo1[j] = qa[j] * cc - qb[j] * sn; qo2[j] = qa[j] * sn + qb[j] * cc; ko1[j] = (ka[j] * cc - kb[j] * sn) * 0.125f; ko2[j] = (ka[j] * sn + kb[j] * cc) * 0.125f; } }
        u32x4 o;
        o.x = pk2(qo1[0], qo1[1]); o.y = pk2(qo1[2], qo1[3]); o.z = pk2(qo1[4], qo1[5]); o.w = pk2(qo1[6], qo1[7]); *(GAS u32x4*)(row) = o;
        o.x = pk2(qo2[0], qo2[1]); o.y = pk2(qo2[2], qo2[3]); o.z = pk2(qo2[4], qo2[5]); o.w = pk2(qo2[6], qo2[7]); *(GAS u32x4*)(row + 512) = o;
        u32x4 ok1, ok2;
        ok1.x = pk2(ko1[0], ko1[1]); ok1.y = pk2(ko1[2], ko1[3]); ok1.z = pk2(ko1[4], ko1[5]); ok1.w = pk2(ko1[6], ko1[7]); *(GAS u32x4*)(row + TS) = ok1;
        ok2.x = pk2(ko2[0], ko2[1]); ok2.y = pk2(ko2[2], ko2[3]); ok2.z = pk2(ko2[4], ko2[5]); ok2.w = pk2(ko2[6], ko2[7]); *(GAS u32x4*)(row + TS + 512) = ok2;
        const unsigned kw1[4] = {ok1.x, ok1.y, ok1.z, ok1.w}, kw2[4] = {ok2.x, ok2.y, ok2.z, ok2.w};
#pragma unroll
        for (int j = 0; j < 8; ++j) { KT[(8 * p + j) * RT_LD + i] = (bf16_t)((kw1[j >> 1] >> ((j & 1) * 16)) & 0xffffu); KT[(32 + 8 * p + j) * RT_LD + i] = (bf16_t)((kw2[j >> 1] >> ((j & 1) * 16)) & 0xffffu); }
    }
    {   const int i = tid >> 2, p = tid & 3; const GAS bf16_t* vrow = proj + PJ((size_t)b * SEQ + c * 128 + i, 1280 + h * 64 + 16 * p);
        const u32x4 va = *(const GAS u32x4*)(vrow), vb = *(const GAS u32x4*)(vrow + 8);
        const unsigned vw[8] = {va.x, va.y, va.z, va.w, vb.x, vb.y, vb.z, vb.w};
        const float wf = exp2f((float)(127 - i) * lgf), wb = exp2f((float)i * lgb);
#pragma unroll
        for (int j = 0; j < 16; ++j) { const float v = (j & 1) ? bfhi(vw[j >> 1]) : bflo(vw[j >> 1]);
            VTF[(16 * p + j) * RT_LD + i] = (bf16_t)f2bf(v * wf); VTB[(16 * p + j) * RT_LD + i] = (bf16_t)f2bf(v * wb); }
    }
    __syncthreads();
    {
        const int dir = F.wave >> 2, et = F.wave & 3; const LAS bf16_t* VT = dir ? VTB : VTF;
        f32x4 acc[4];
#pragma unroll
        for (int dt = 0; dt < 4; ++dt) acc[dt] = (f32x4){0.f, 0.f, 0.f, 0.f};
#pragma unroll
        for (int ks = 0; ks < 4; ++ks) { const bf16x8 a = *(const LAS bf16x8*)(VT + (et * 16 + ql) * RT_LD + ks * 32 + g * 8);
#pragma unroll
            for (int dt = 0; dt < 4; ++dt) { const bf16x8 bb = *(const LAS bf16x8*)(KT + (dt * 16 + ql) * RT_LD + ks * 32 + g * 8); acc[dt] = MFMA16(a, bb, acc[dt]); } }
        GAS bf16_t* out = KVT + ((size_t)item * 2 + dir) * 4096;
#pragma unroll
        for (int dt = 0; dt < 4; ++dt)
#pragma unroll
            for (int jj = 0; jj < 4; ++jj) out[et * 1024 + (dt * 2 + (ql >> 3)) * 128 + (g * 4 + jj) * 8 + (ql & 7)] = (bf16_t)f2bf(acc[dt][jj]);
    }
    __syncthreads();
}
__device__ __forceinline__ void ret_r2_scan(Frame& F, const GAS bf16_t* KVT, GAS bf16_t* ST, size_t gt, size_t ngt) {
    for (size_t idx = gt; idx < (size_t)32 * 4096; idx += ngt) {
        const int chain = (int)(idx >> 12), el = (int)(idx & 4095), bh = chain >> 1, dir = chain & 1, h = bh & 3, hh = dir ? 3 - h : h;
        const float gC = exp2f(128.0f * log2f(1.0f - exp2f(-5.0f - (float)hh)));
        float S = 0.f;
        const size_t o0 = ((size_t)(bh * 64) * 2 + dir) * 4096 + el;
#pragma unroll
        for (int half = 0; half < 4; ++half) { bf16_t kv[16];
#pragma unroll
            for (int cc = 0; cc < 16; ++cc) { const int c = dir ? 63 - (half * 16 + cc) : half * 16 + cc; kv[cc] = KVT[o0 + (size_t)c * 8192]; }
#pragma unroll
            for (int cc = 0; cc < 16; ++cc) { const int c = dir ? 63 - (half * 16 + cc) : half * 16 + cc; ST[o0 + (size_t)c * 8192] = (bf16_t)f2bf(S); S = S * gC + bf2f(kv[cc]); } }
    }
}
__device__ __forceinline__ void ret_r3_item(Frame& F, const GAS bf16_t* proj, const GAS bf16_t* ST, const GAS float* retg, GAS bf16_t* ycat, int item) {
    int tid = F.tid; asm volatile("" : "+v"(tid));
    const int lane = tid & 63, g = lane >> 4, ql = lane & 15;
    const int c = item & 63, h = (item >> 6) & 3, b = item >> 8;
    const float lgf = log2f(1.0f - exp2f(-5.0f - (float)h)), lgb = log2f(1.0f - exp2f(-5.0f - (float)(3 - h)));
    LAS bf16_t* VT = (LAS bf16_t*)F.lds;
    const size_t t0 = (size_t)b * SEQ + c * 128;
    {   const int i = tid >> 2, p = tid & 3; const GAS bf16_t* row = proj + PJ(t0 + i, 1280 + h * 64 + 16 * p);
        const u32x4 va = *(const GAS u32x4*)(row), vb = *(const GAS u32x4*)(row + 8);
        const unsigned vw[8] = {va.x, va.y, va.z, va.w, vb.x, vb.y, vb.z, vb.w};
#pragma unroll
        for (int j = 0; j < 16; ++j) VT[(16 * p + j) * RT_LD + i] = (bf16_t)((vw[j >> 1] >> ((j & 1) * 16)) & 0xffffu); }
    __syncthreads();
    {
        const int qi = F.wave * 16 + ql; const size_t tq = t0 + qi;
        const GAS bf16_t* qrow = proj + ((size_t)3 * NTOK + t0 + F.wave * 16) * 256 + (h * 8 + g) * 128 + ql * 8;
        bf16x8 qf[2]; qf[0] = *(const GAS bf16x8*)(qrow); qf[1] = *(const GAS bf16x8*)(qrow + 512);
        f32x4 st[8];
        {   bf16x8 kf[16];
#pragma unroll
            for (int kt = 0; kt < 8; ++kt) { const GAS bf16_t* krow = proj + ((size_t)4 * NTOK + t0 + kt * 16) * 256 + (h * 8 + g) * 128 + ql * 8; kf[2 * kt] = *(const GAS bf16x8*)(krow); kf[2 * kt + 1] = *(const GAS bf16x8*)(krow + 512); }
            asm volatile("" : "+v"(kf[0]), "+v"(kf[1]), "+v"(kf[2]), "+v"(kf[3]), "+v"(kf[4]), "+v"(kf[5]), "+v"(kf[6]), "+v"(kf[7]), "+v"(kf[8]), "+v"(kf[9]), "+v"(kf[10]), "+v"(kf[11]), "+v"(kf[12]), "+v"(kf[13]), "+v"(kf[14]), "+v"(kf[15]));
#pragma unroll
            for (int kt = 0; kt < 8; ++kt) { f32x4 a = (f32x4){0.f, 0.f, 0.f, 0.f}; a = MFMA16(kf[2 * kt], qf[0], a); a = MFMA16(kf[2 * kt + 1], qf[1], a);
#pragma unroll
                for (int jj = 0; jj < 4; ++jj) { const int df = qi - (kt * 16 + g * 4 + jj); a[jj] *= (df >= 0) ? exp2f((float)df * lgf) : exp2f((float)(-df) * lgb); }
                st[kt] = a; } }
        f32x4 oi[4], of[4], ob[4];
#pragma unroll
        for (int et = 0; et < 4; ++et) { oi[et] = (f32x4){0.f, 0.f, 0.f, 0.f}; of[et] = oi[et]; ob[et] = oi[et]; }
#pragma unroll
        for (int kp = 0; kp < 4; ++kp) { u32x4 pw; pw.x = pk2(st[2 * kp][0], st[2 * kp][1]); pw.y = pk2(st[2 * kp][2], st[2 * kp][3]); pw.z = pk2(st[2 * kp + 1][0], st[2 * kp + 1][1]); pw.w = pk2(st[2 * kp + 1][2], st[2 * kp + 1][3]);
            const bf16x8 pf = __builtin_bit_cast(bf16x8, pw);
#pragma unroll
            for (int et = 0; et < 4; ++et) { const LAS bf16_t* vr = VT + (et * 16 + ql) * RT_LD + kp * 32 + g * 4;
                const u32x2 lo = *(const LAS u32x2*)(vr), hi = *(const LAS u32x2*)(vr + 16); u32x4 aw; aw.x = lo.x; aw.y = lo.y; aw.z = hi.x; aw.w = hi.y;
                oi[et] = MFMA16(__builtin_bit_cast(bf16x8, aw), pf, oi[et]); } }
        const GAS bf16_t* sf = ST + ((size_t)item * 2) * 4096; const GAS bf16_t* sb = sf + 4096;
        {   bf16x8 sfr[8], sbr[8];
#pragma unroll
            for (int et = 0; et < 4; ++et)
#pragma unroll
                for (int ks = 0; ks < 2; ++ks) { const int o = et * 1024 + (ks * 4 + g) * 128 + ql * 8; sfr[et * 2 + ks] = *(const GAS bf16x8*)(sf + o); sbr[et * 2 + ks] = *(const GAS bf16x8*)(sb + o); }
            asm volatile("" : "+v"(sfr[0]), "+v"(sfr[1]), "+v"(sfr[2]), "+v"(sfr[3]), "+v"(sfr[4]), "+v"(sfr[5]), "+v"(sfr[6]), "+v"(sfr[7]), "+v"(sbr[0]), "+v"(sbr[1]), "+v"(sbr[2]), "+v"(sbr[3]), "+v"(sbr[4]), "+v"(sbr[5]), "+v"(sbr[6]), "+v"(sbr[7]));
#pragma unroll
            for (int et = 0; et < 4; ++et)
#pragma unroll
                for (int ks = 0; ks < 2; ++ks) { of[et] = MFMA16(sfr[et * 2 + ks], qf[ks], of[et]); ob[et] = MFMA16(sbr[et * 2 + ks], qf[ks], ob[et]); } }
        const float af = exp2f((float)(qi + 1) * lgf), abw = exp2f((float)(128 - qi) * lgb);
        float sum = 0.f;
#pragma unroll
        for (int et = 0; et < 4; ++et) { oi[et] = oi[et] + of[et] * af + ob[et] * abw; sum += (oi[et][0] + oi[et][1]) + (oi[et][2] + oi[et][3]); }
        sum += shfl_xor_f(sum, 16); sum += shfl_xor_f(sum, 32);
        const float mu = sum * (1.0f / 64.0f); float vs = 0.f;
#pragma unroll
        for (int et = 0; et < 4; ++et) { oi[et] = oi[et] - mu; vs += (oi[et][0] * oi[et][0] + oi[et][1] * oi[et][1]) + (oi[et][2] * oi[et][2] + oi[et][3] * oi[et][3]); }
        vs += shfl_xor_f(vs, 16); vs += shfl_xor_f(vs, 32);
        const float rs = rsqrtf(vs * (1.0f / 64.0f) + EPS);
#pragma unroll
        for (int et = 0; et < 4; ++et) { const int e = et * 16 + g * 4;
            const u32x2 gt = *(const GAS u32x2*)(proj + ((size_t)6 * NTOK + t0 + F.wave * 16) * 256 + (h * 8 + et * 2 + (g >> 1)) * 128 + ql * 8 + (g & 1) * 4); const f32x4 gn = *(const GAS f32x4*)(retg + h * 64 + e);
            u32x2 w; w.x = pk2(oi[et][0] * rs * gn[0] * silu_f(bflo(gt.x)), oi[et][1] * rs * gn[1] * silu_f(bfhi(gt.x)));
            w.y = pk2(oi[et][2] * rs * gn[2] * silu_f(bflo(gt.y)), oi[et][3] * rs * gn[3] * silu_f(bfhi(gt.y)));
            *(GAS u32x2*)(ycat + tq * DM + 256 + h * 64 + e) = w; }
    }
    __syncthreads();
}

constexpr int G_LD = 72;
constexpr int G_K = 0, G_Q = 9216, G_KST = 18432, G_ATT = 39168, G_LD4 = 57600, G_LZ = 65792, G_UT = 84224, G_RB1 = 125696, G_GC = 133888, G_BETA = 134400;
#define PRW(r) ((r) + ((r) >> 3))
constexpr size_t GOP_BYTES = 32768;
__device__ __forceinline__ int natidx(int dir, int i) { return dir ? 63 - i : i; }

constexpr int G_TI = G_RB1;
__device__ __forceinline__ void gdn_tinv(LAS unsigned char* lds, int tid) {
    const int dir = tid >> 6, blk = (tid >> 4) & 3, col = tid & 15;
    const LAS float* ld = (const LAS float*)(lds + G_LD4) + (dir * 4 + blk) * 256;
    float sol[16];
#pragma unroll
    for (int r = 0; r < 16; ++r) sol[r] = (r == col) ? 1.f : 0.f;
#pragma unroll
    for (int r = 1; r < 16; ++r) {
#pragma unroll
        for (int j4 = 0; j4 < (r + 3) / 4; ++j4) { const f32x4 lv = *(const LAS f32x4*)(ld + r * 16 + j4 * 4);
#pragma unroll
            for (int jj = 0; jj < 4; ++jj) if (j4 * 4 + jj < r) sol[r] -= lv[jj] * sol[j4 * 4 + jj]; } }
    LAS bf16_t* ti = (LAS bf16_t*)(lds + G_TI) + (dir * 4 + blk) * 256 + col;
#pragma unroll
    for (int r = 0; r < 16; ++r) ti[r * 16] = (bf16_t)f2bf(sol[r]);
}
template <int BLK>
__device__ __forceinline__ void gdn_solve_blk(const LAS bf16_t* lzb, const LAS bf16_t* tib, LAS bf16_t* utr, int g) {
    constexpr int NKS = (BLK * 16 + 31) / 32;
    f32x4 acc = (f32x4){0.f, 0.f, 0.f, 0.f};
#pragma unroll
    for (int ks = 0; ks < (BLK > 0 ? NKS : 0); ++ks) acc = MFMA16(*(const LAS bf16x8*)(lzb + BLK * 16 * G_LD + ks * 32), *(const LAS bf16x8*)(utr + ks * 32 + g * 8), acc);
    const u32x2 rw = *(const LAS u32x2*)(utr + BLK * 16 + g * 4);
    const u32x2 tw = *(const LAS u32x2*)(tib + BLK * 256);
    u32x4 bx; bx.x = pk2(bflo(rw.x) - acc[0], bfhi(rw.x) - acc[1]); bx.y = pk2(bflo(rw.y) - acc[2], bfhi(rw.y) - acc[3]); bx.z = 0u; bx.w = 0u;
    u32x4 at; at.x = tw.x; at.y = tw.y; at.z = 0u; at.w = 0u;
    const f32x4 so = MFMA16(__builtin_bit_cast(bf16x8, at), __builtin_bit_cast(bf16x8, bx), ((f32x4){0.f, 0.f, 0.f, 0.f}));
    u32x2 w; w.x = pk2(so[0], so[1]); w.y = pk2(so[2], so[3]);
    *(LAS u32x2*)(utr + BLK * 16 + g * 4) = w;
    asm volatile("" ::: "memory");
}
__device__ __forceinline__ void gdn_solve_wave(LAS unsigned char* lds, int wave, int lane) {
    const int dir = wave >> 2, q = wave & 3, g = lane >> 4, ql = lane & 15;
    const LAS bf16_t* lzb = (const LAS bf16_t*)(lds + G_LZ) + (dir * 64 + ql) * G_LD + g * 8;
    const LAS bf16_t* tib = (const LAS bf16_t*)(lds + G_TI) + dir * 4 * 256 + ql * 16 + g * 4;
#pragma unroll
    for (int cc = 0; cc < 2; ++cc) { const int ct = q * 2 + cc;
        LAS bf16_t* utr = (LAS bf16_t*)(lds + G_UT) + (dir * 144 + ct * 18 + PRW(ql)) * G_LD;
        gdn_solve_blk<0>(lzb, tib, utr, g); gdn_solve_blk<1>(lzb, tib, utr, g); gdn_solve_blk<2>(lzb, tib, utr, g); gdn_solve_blk<3>(lzb, tib, utr, g); }
}

__device__ __forceinline__ void gdn_g1_item(Frame& F, const GAS bf16_t* proj, const GAS float* ab, const GAS float* convw, const GAS float* alog, const GAS float* dtb, GAS unsigned char* gop, int item) {
    int tid = F.tid; asm volatile("" : "+v"(tid));
    const int lane = tid & 63, g = lane >> 4, ql = lane & 15, wave = F.wave;
    const int n = item & 127, h = (item >> 7) & 3, b = item >> 9; const size_t tb = (size_t)b * SEQ; const int s0 = n * 64;
    LAS bf16_t* Ks = (LAS bf16_t*)(F.lds + G_K); LAS bf16_t* Qs = (LAS bf16_t*)(F.lds + G_Q);
    LAS float* GC = (LAS float*)(F.lds + G_GC); LAS float* BETA = (LAS float*)(F.lds + G_BETA);
    u32x4 xin[4][3];
    {   const int i = tid >> 3, p = tid & 7, s = s0 + i;
#pragma unroll
        for (int tap = 0; tap < 4; ++tap) { const int s2 = s + tap - 2; const bool ok = (s2 >= 0 && s2 < SEQ);
#pragma unroll
            for (int part = 0; part < 3; ++part) { xin[tap][part] = (u32x4){0u, 0u, 0u, 0u}; if (ok) xin[tap][part] = *(const GAS u32x4*)(proj + PJ(tb + s2, 2048 + part * 256 + h * 64 + 8 * p)); } } }
    if (tid < 128) { const int dir = tid >> 6, i = tid & 63; const size_t t = tb + s0 + i;
        const float a = ab[t * 16 + dir * 4 + h], bb = ab[t * 16 + 8 + dir * 4 + h];
        float v = -__expf(alog[dir * 4 + h]) * softplus_f(a + dtb[dir * 4 + h]);
#pragma unroll
        for (int off = 1; off < 64; off <<= 1) { const int srcl = dir ? lane + off : lane - off;
            const float o = __builtin_bit_cast(float, __builtin_amdgcn_ds_bpermute((srcl & 63) << 2, __builtin_bit_cast(int, v))); if (srcl >= 0 && srcl < 64) v += o; }
        GC[dir * 64 + i] = v; BETA[dir * 64 + i] = sigmoid_f(bb); }
    {   const int i = tid >> 3, p = tid & 7;
        float u[3][8];
#pragma unroll
        for (int part = 0; part < 3; ++part)
#pragma unroll
            for (int j = 0; j < 8; ++j) u[part][j] = 0.f;
#pragma unroll
        for (int tap = 0; tap < 4; ++tap) {
#pragma unroll
            for (int part = 0; part < 3; ++part) { const u32x4 x = xin[tap][part];
                const GAS float* wp = convw + tap * 768 + part * 256 + h * 64 + 8 * p; const f32x4 w0 = *(const GAS f32x4*)wp, w1 = *(const GAS f32x4*)(wp + 4);
                u[part][0] += w0[0] * bflo(x.x); u[part][1] += w0[1] * bfhi(x.x); u[part][2] += w0[2] * bflo(x.y); u[part][3] += w0[3] * bfhi(x.y);
                u[part][4] += w1[0] * bflo(x.z); u[part][5] += w1[1] * bfhi(x.z); u[part][6] += w1[2] * bflo(x.w); u[part][7] += w1[3] * bfhi(x.w); } }
        float ssq[2] = {0.f, 0.f};
#pragma unroll
        for (int part = 0; part < 3; ++part)
#pragma unroll
            for (int j = 0; j < 8; ++j) { u[part][j] = silu_f(u[part][j]); if (part < 2) ssq[part] += u[part][j] * u[part][j]; }
#pragma unroll
        for (int part = 0; part < 2; ++part) { float q = ssq[part];
#pragma unroll
            for (int m = 1; m < 8; m <<= 1) q += __builtin_bit_cast(float, __builtin_amdgcn_ds_bpermute((lane ^ m) << 2, __builtin_bit_cast(int, q)));
            ssq[part] = rsqrtf(q + EPS); }
        const float qs = ssq[0] * 0.125f, ks = ssq[1];
        __syncthreads();
        u32x4 o;
        o.x = pk2(u[0][0] * qs, u[0][1] * qs); o.y = pk2(u[0][2] * qs, u[0][3] * qs); o.z = pk2(u[0][4] * qs, u[0][5] * qs); o.w = pk2(u[0][6] * qs, u[0][7] * qs); *(LAS u32x4*)(Qs + i * G_LD + 8 * p) = o;
        o.x = pk2(u[1][0] * ks, u[1][1] * ks); o.y = pk2(u[1][2] * ks, u[1][3] * ks); o.z = pk2(u[1][4] * ks, u[1][5] * ks); o.w = pk2(u[1][6] * ks, u[1][7] * ks); *(LAS u32x4*)(Ks + i * G_LD + 8 * p) = o;
#pragma unroll
        for (int dir = 0; dir < 2; ++dir) { const float gci = GC[dir * 64 + i], bi = BETA[dir * 64 + i];
            const float sc = ks * __expf(GC[dir * 64 + (dir ? 0 : 63)] - gci), sw = ks * bi * __expf(gci); const int ip = natidx(dir, i);
            LAS bf16_t* kst = (LAS bf16_t*)(F.lds + G_KST) + dir * 72 * G_LD; LAS bf16_t* ut = (LAS bf16_t*)(F.lds + G_UT) + dir * 144 * G_LD;
#pragma unroll
            for (int j = 0; j < 8; ++j) { kst[(9 * p + j) * G_LD + ip] = (bf16_t)f2bf(u[1][j] * sc); ut[(9 * p + j) * G_LD + ip] = (bf16_t)f2bf(u[2][j] * bi); ut[(72 + 9 * p + j) * G_LD + ip] = (bf16_t)f2bf(u[1][j] * sw); } }
    }
    __syncthreads();
    {   const int dir = wave >> 2, it = wave & 3;
        const LAS float* gc = GC + dir * 64; const LAS float* be = BETA + dir * 64;
        LAS float* Ld = (LAS float*)(F.lds + G_LD4) + (dir * 4 + it) * 256; LAS bf16_t* Lz = (LAS bf16_t*)(F.lds + G_LZ) + dir * 64 * G_LD; LAS bf16_t* At = (LAS bf16_t*)(F.lds + G_ATT) + dir * 64 * G_LD;
        const int ra = natidx(dir, it * 16 + ql);
        bf16x8 ka[2], qa[2];
#pragma unroll
        for (int ks = 0; ks < 2; ++ks) { ka[ks] = *(const LAS bf16x8*)(Ks + ra * G_LD + ks * 32 + g * 8); qa[ks] = *(const LAS bf16x8*)(Qs + ra * G_LD + ks * 32 + g * 8); }
#pragma unroll
        for (int jt = 0; jt < 4; ++jt) { const int rb = natidx(dir, jt * 16 + ql);
            f32x4 kk = (f32x4){0.f, 0.f, 0.f, 0.f}, qk = kk;
#pragma unroll
            for (int ks = 0; ks < 2; ++ks) { const bf16x8 kb = *(const LAS bf16x8*)(Ks + rb * G_LD + ks * 32 + g * 8); kk = MFMA16(ka[ks], kb, kk); qk = MFMA16(qa[ks], kb, qk); }
            const int jp = jt * 16 + ql; const float gj = gc[natidx(dir, jp)];
#pragma unroll
            for (int jj = 0; jj < 4; ++jj) { const int ip = it * 16 + g * 4 + jj, ni = natidx(dir, ip); const float dec = (ip >= jp) ? __expf(gc[ni] - gj) : 0.f;
                const float lval = (ip > jp) ? be[ni] * kk[jj] * dec : 0.f;
                if (jt == it) Ld[(g * 4 + jj) * 16 + ql] = lval;
                Lz[ip * G_LD + jp] = (bf16_t)((jt < it) ? f2bf(lval) : 0u);
                At[ip * G_LD + jp] = (bf16_t)f2bf(qk[jj] * dec); } }
    }
    __syncthreads();
    if (tid < 128) gdn_tinv(F.lds, tid);
    __syncthreads();
    gdn_solve_wave(F.lds, wave, lane);
    __syncthreads();
    {   const int dir = wave >> 2, prod = wave & 3;
        const LAS float* gc = GC + dir * 64;
        const LAS bf16_t* At = (const LAS bf16_t*)(F.lds + G_ATT) + dir * 64 * G_LD; const LAS bf16_t* kst = (const LAS bf16_t*)(F.lds + G_KST) + dir * 72 * G_LD;
        const LAS bf16_t* UT = (const LAS bf16_t*)(F.lds + G_UT) + dir * 144 * G_LD; const LAS bf16_t* WT = UT + 72 * G_LD;
        const int arow = PRW(ql), brow = (prod >= 2) ? PRW(ql) : ql, bstep = (prod >= 2) ? 18 : 16;
        GAS unsigned char* outp = gop + ((size_t)item * 2 + dir) * GOP_BYTES;
        const LAS bf16_t* Am = (prod == 0) ? UT : (prod == 3) ? kst : WT;
        const LAS bf16_t* Bm = (prod == 3) ? UT : (prod == 2) ? kst : At;
        f32x4 acc[4][4];
#pragma unroll
        for (int x = 0; x < 4; ++x)
#pragma unroll
            for (int y = 0; y < 4; ++y) acc[x][y] = (f32x4){0.f, 0.f, 0.f, 0.f};
#pragma unroll
        for (int ks = 0; ks < 2; ++ks) { bf16x8 bf[4];
#pragma unroll
            for (int y = 0; y < 4; ++y) bf[y] = *(const LAS bf16x8*)(Bm + (y * bstep + brow) * G_LD + ks * 32 + g * 8);
#pragma unroll
            for (int x = 0; x < 4; ++x) { const bf16x8 af = *(const LAS bf16x8*)(Am + (x * 18 + arow) * G_LD + ks * 32 + g * 8);
#pragma unroll
                for (int y = 0; y < 4; ++y) acc[x][y] = MFMA16(af, bf[y], acc[x][y]); } }
        if (prod == 0 || prod == 3) {
            GAS unsigned char* o = outp + (prod == 0 ? 16384 : 24576);
#pragma unroll
            for (int x = 0; x < 4; ++x)
#pragma unroll
                for (int y = 0; y < 4; ++y) { u32x2 w; w.x = pk2(acc[x][y][0], acc[x][y][1]); w.y = pk2(acc[x][y][2], acc[x][y][3]); *(GAS u32x2*)(o + ((size_t)(((prod == 0) ? (x * 4 + y) : (y * 4 + x)) * 64 + lane)) * 8) = w; }
        } else {
            const float a_last = __expf(gc[dir ? 0 : 63]);
#pragma unroll
            for (int y = 0; y < 4; ++y) { float val[4][4];
                const int col = y * 16 + ql;
#pragma unroll
                for (int x = 0; x < 4; ++x) {
                    if (prod == 1) { const int ni = natidx(dir, col); const float eg = __expf(gc[ni]); const u32x2 qv = *(const LAS u32x2*)(Qs + ni * G_LD + x * 16 + g * 4);
                        val[x][0] = bflo(qv.x) * eg - acc[x][y][0]; val[x][1] = bfhi(qv.x) * eg - acc[x][y][1]; val[x][2] = bflo(qv.y) * eg - acc[x][y][2]; val[x][3] = bfhi(qv.y) * eg - acc[x][y][3]; }
                    else {
#pragma unroll
                        for (int jj = 0; jj < 4; ++jj) val[x][jj] = ((x * 16 + g * 4 + jj == col) ? a_last : 0.f) - acc[x][y][jj]; } }
#pragma unroll
                for (int ks = 0; ks < 2; ++ks) { u32x4 w; w.x = pk2(val[2 * ks][0], val[2 * ks][1]); w.y = pk2(val[2 * ks][2], val[2 * ks][3]); w.z = pk2(val[2 * ks + 1][0], val[2 * ks + 1][1]); w.w = pk2(val[2 * ks + 1][2], val[2 * ks + 1][3]);
                    *(GAS u32x4*)(outp + (prod == 1 ? 0 : 8192) + ((size_t)((y * 2 + ks) * 64 + lane)) * 16) = w; } }
        }
    }
    __syncthreads();
}

constexpr int GS_SLOT = 20480, GS_NSLOT = 6;
struct GdnStage { u32x4 a[5]; };
__device__ __forceinline__ const GAS unsigned char* gdn_src_piece(const GAS unsigned char* src, int sl, int p) {
    const int off = p * 16;
    return src + (off < 16384 ? off : (off < 18432 ? off + sl * 2048 : 24576 + sl * 2048 + (off - 18432)));
}
__device__ __forceinline__ void gdn_ld_stage(GdnStage& R, const GAS unsigned char* src, int sl, int lw, int lane) {
#pragma unroll
    for (int j = 0; j < 5; ++j) R.a[j] = *(const GAS u32x4*)gdn_src_piece(src, sl, lw * 320 + j * 64 + lane);
}
__device__ __forceinline__ void gdn_st_stage(const GdnStage& R, LAS unsigned char* slot, int lw, int lane) {
#pragma unroll
    for (int j = 0; j < 5; ++j) *(LAS u32x4*)(slot + (lw * 320 + j * 64 + lane) * 16) = R.a[j];
}
__device__ __forceinline__ void gdn_compute(const LAS unsigned char* slot, f32x4 (&S)[4], GAS bf16_t* orow0, int dir, int ql, int lane) {
    bf16x8 qf[8]; u32x2 o0[4], b0[4];
#pragma unroll
    for (int i = 0; i < 8; ++i) qf[i] = *(const LAS bf16x8*)(slot + (i * 64 + lane) * 16);
#pragma unroll
    for (int x = 0; x < 4; ++x) { o0[x] = *(const LAS u32x2*)(slot + 16384 + (x * 64 + lane) * 8); b0[x] = *(const LAS u32x2*)(slot + 18432 + (x * 64 + lane) * 8); }
    bf16x8 sf[2];
#pragma unroll
    for (int ks = 0; ks < 2; ++ks) { u32x4 w; w.x = pk2(S[2 * ks][0], S[2 * ks][1]); w.y = pk2(S[2 * ks][2], S[2 * ks][3]); w.z = pk2(S[2 * ks + 1][0], S[2 * ks + 1][1]); w.w = pk2(S[2 * ks + 1][2], S[2 * ks + 1][3]); sf[ks] = __builtin_bit_cast(bf16x8, w); }
    asm volatile("s_waitcnt lgkmcnt(0)" : "+v"(qf[0]), "+v"(qf[1]), "+v"(qf[2]), "+v"(qf[3]), "+v"(qf[4]), "+v"(qf[5]), "+v"(qf[6]), "+v"(qf[7]), "+v"(o0[0]), "+v"(o0[1]), "+v"(o0[2]), "+v"(o0[3]), "+v"(b0[0]), "+v"(b0[1]), "+v"(b0[2]), "+v"(b0[3]));
    bf16x8 mf[8];
#pragma unroll
    for (int i = 0; i < 8; ++i) mf[i] = *(const LAS bf16x8*)(slot + 8192 + (i * 64 + lane) * 16);
#pragma unroll
    for (int x = 0; x < 4; ++x) { f32x4 o = (f32x4){bflo(o0[x].x), bfhi(o0[x].x), bflo(o0[x].y), bfhi(o0[x].y)};
        o = MFMA16(sf[0], qf[x * 2], o); o = MFMA16(sf[1], qf[x * 2 + 1], o);
        u32x2 w; w.x = pk2(o[0], o[1]); w.y = pk2(o[2], o[3]); *(GAS u32x2*)(orow0 + (size_t)natidx(dir, x * 16 + ql) * 256) = w; }
    asm volatile("s_waitcnt lgkmcnt(0)" : "+v"(mf[0]), "+v"(mf[1]), "+v"(mf[2]), "+v"(mf[3]), "+v"(mf[4]), "+v"(mf[5]), "+v"(mf[6]), "+v"(mf[7]));
#pragma unroll
    for (int x = 0; x < 4; ++x) { f32x4 n = (f32x4){bflo(b0[x].x), bfhi(b0[x].x), bflo(b0[x].y), bfhi(b0[x].y)};
        n = MFMA16(mf[x * 2], sf[0], n); n = MFMA16(mf[x * 2 + 1], sf[1], n); S[x] = n; }
}
__device__ __forceinline__ void gdn_scan_block(Frame& F, const GAS unsigned char* gop, GAS bf16_t* Og, int chain) {
    const int lane = F.lane, g = lane >> 4, ql = lane & 15, wave = F.wave, sl = chain & 3, dir = (chain >> 2) & 1, bh = chain >> 3, h = bh & 3, b = bh >> 2;
    const bool loader = (wave >= 1 && wave <= 4), comp = (wave == 0); const int lw = wave - 1;
    f32x4 S[4];
#pragma unroll
    for (int x = 0; x < 4; ++x) S[x] = (f32x4){0.f, 0.f, 0.f, 0.f};
    const GAS unsigned char* base = gop + ((size_t)bh * 128 * 2 + dir) * GOP_BYTES;
    GAS bf16_t* obase = Og + ((size_t)dir * NTOK + (size_t)b * SEQ) * 256 + h * 64 + sl * 16 + g * 4;
    LAS unsigned char* ring = F.lds;
#define GDN_BAR() do { asm volatile("s_waitcnt lgkmcnt(0)" ::: "memory"); __builtin_amdgcn_s_barrier(); asm volatile("" ::: "memory"); } while (0)
#define GDN_SRC(st) (base + (size_t)(dir ? 127 - (st) : (st)) * 2 * GOP_BYTES)
    if (loader) {
        GdnStage R0, R1, R2, R3, R4, R5, R6, R7;
        gdn_ld_stage(R0, GDN_SRC(0), sl, lw, lane); gdn_ld_stage(R1, GDN_SRC(1), sl, lw, lane); gdn_ld_stage(R2, GDN_SRC(2), sl, lw, lane); gdn_ld_stage(R3, GDN_SRC(3), sl, lw, lane);
        gdn_st_stage(R0, ring + 0 * GS_SLOT, lw, lane); gdn_st_stage(R1, ring + 1 * GS_SLOT, lw, lane); gdn_st_stage(R2, ring + 2 * GS_SLOT, lw, lane); gdn_st_stage(R3, ring + 3 * GS_SLOT, lw, lane);
        gdn_ld_stage(R0, GDN_SRC(4), sl, lw, lane); gdn_ld_stage(R1, GDN_SRC(5), sl, lw, lane); gdn_ld_stage(R2, GDN_SRC(6), sl, lw, lane); gdn_ld_stage(R3, GDN_SRC(7), sl, lw, lane);
        gdn_ld_stage(R4, GDN_SRC(8), sl, lw, lane); gdn_ld_stage(R5, GDN_SRC(9), sl, lw, lane); gdn_ld_stage(R6, GDN_SRC(10), sl, lw, lane); gdn_ld_stage(R7, GDN_SRC(11), sl, lw, lane);
        GDN_BAR();
        int sw = 4;
#define GDN_STEP(stv, RN) do { const int _st = (stv); gdn_st_stage(RN, ring + sw * GS_SLOT, lw, lane); gdn_ld_stage(RN, GDN_SRC(min(_st + 12, 127)), sl, lw, lane); \
        GDN_BAR(); sw = (sw == GS_NSLOT - 1) ? 0 : sw + 1; } while (0)
        GDN_STEP(0, R0); GDN_STEP(1, R1); GDN_STEP(2, R2); GDN_STEP(3, R3); GDN_STEP(4, R4); GDN_STEP(5, R5); GDN_STEP(6, R6); GDN_STEP(7, R7);
        for (int st = 8; st < 128; st += 8) { GDN_STEP(st, R0); GDN_STEP(st + 1, R1); GDN_STEP(st + 2, R2); GDN_STEP(st + 3, R3); GDN_STEP(st + 4, R4); GDN_STEP(st + 5, R5); GDN_STEP(st + 6, R6); GDN_STEP(st + 7, R7); }
    } else if (comp) {
        GDN_BAR();
        int s0 = 0;
        for (int st = 0; st < 128; ++st) { gdn_compute(ring + s0 * GS_SLOT, S, obase + (size_t)(dir ? 127 - st : st) * 64 * 256, dir, ql, lane); GDN_BAR(); s0 = (s0 == GS_NSLOT - 1) ? 0 : s0 + 1; }
    } else {
        GDN_BAR();
        for (int st = 0; st < 128; ++st) GDN_BAR();
    }
#undef GDN_STEP
#undef GDN_SRC
#undef GDN_BAR
}

__device__ __forceinline__ void gdn_finalize(Frame& F, const GAS bf16_t* proj, const GAS bf16_t* Og, const GAS float* gdng, GAS bf16_t* ycat, int gw, int ngw) {
    const int lane = F.lane, sub = lane >> 4, e4 = (lane & 15) * 4;
    const f32x4 gn = *(const GAS f32x4*)(gdng + e4);
    for (int base = gw * 16; base < NTOK * 4; base += ngw * 16) {
#pragma unroll
        for (int u = 0; u < 4; ++u) { const int pair = base + u * 4 + sub, t = pair >> 2, h = pair & 3; const size_t o = (size_t)t * 256 + h * 64 + e4;
            const u32x2 a = *(const GAS u32x2*)(Og + o), b = *(const GAS u32x2*)(Og + (size_t)NTOK * 256 + o), gt = *(const GAS u32x2*)(proj + PJ((size_t)t, 2816 + h * 64 + e4));
            const float x0 = bflo(a.x) + bflo(b.x), x1 = bfhi(a.x) + bfhi(b.x), x2 = bflo(a.y) + bflo(b.y), x3 = bfhi(a.y) + bfhi(b.y);
            float ms = (x0 * x0 + x1 * x1) + (x2 * x2 + x3 * x3);
            ms += shfl_xor_f(ms, 1); ms += shfl_xor_f(ms, 2); ms += shfl_xor_f(ms, 4); ms += shfl_xor_f(ms, 8);
            const float rs = rsqrtf(ms * (1.0f / 64.0f) + EPS);
            u32x2 w; w.x = pk2(x0 * rs * gn[0] * silu_f(bflo(gt.x)), x1 * rs * gn[1] * silu_f(bfhi(gt.x))); w.y = pk2(x2 * rs * gn[2] * silu_f(bflo(gt.y)), x3 * rs * gn[3] * silu_f(bfhi(gt.y)));
            *(GAS u32x2*)(ycat + (size_t)t * DM + 768 + h * 64 + e4) = w; }
    }
}

__device__ __forceinline__ void router_phase(Frame& F, int l) {
    GAS unsigned char* ws = F.ws; const int lane = F.lane, g = lane >> 4;
    const GAS bf16_t* X = (const GAS bf16_t*)(ws + WS_XB); const GAS float* ssq = (const GAS float*)(ws + WS_SSQ);
    const GAS bf16x8* fh = (const GAS bf16x8*)(ws + WS_TAB + TAB_RFR + (size_t)l * 196608); const GAS bf16x8* fl = fh + 6144;
    GAS int* toke = (GAS int*)(ws + WS_TAB + TAB_TOKE); GAS float* tokw = (GAS float*)(ws + WS_TAB + TAB_TOKW);
    LAS float* lg = (LAS float*)(F.lds + F.wave * 4096);
    LAS int* hist = (LAS int*)(F.lds + LDS_MISC + 256);
    if (F.tid < NEXP) hist[F.tid] = 0;
    __syncthreads();
    const GAS float* bg = F.inp(I_BGRP) + l * 4; const GAS float* br = F.inp(I_BRT) + l * 32;
    for (int tile = F.gw; tile < NTOK / 16; tile += F.ngw) {
        const int t0 = tile * 16; const GAS bf16_t* xr = X + (size_t)(t0 + (lane & 15)) * DM + g * 8;
        f32x4 acc[3];
#pragma unroll
        for (int ct = 0; ct < 3; ++ct) acc[ct] = (f32x4){0.f, 0.f, 0.f, 0.f};
#pragma unroll 1
        for (int kb = 0; kb < 8; ++kb) {
            bf16x8 xa[4]; bf16x8 wh[4][3], wl[4][3];
#pragma unroll
            for (int i = 0; i < 4; ++i) { const int ks = kb * 4 + i; xa[i] = *(const GAS bf16x8*)(xr + ks * 32);
#pragma unroll
                for (int ct = 0; ct < 3; ++ct) { wh[i][ct] = fh[(ks * 3 + ct) * 64 + lane]; wl[i][ct] = fl[(ks * 3 + ct) * 64 + lane]; } }
            asm volatile("" : "+v"(xa[0]), "+v"(xa[1]), "+v"(xa[2]), "+v"(xa[3]),
                              "+v"(wh[0][0]), "+v"(wh[0][1]), "+v"(wh[0][2]), "+v"(wh[1][0]), "+v"(wh[1][1]), "+v"(wh[1][2]), "+v"(wh[2][0]), "+v"(wh[2][1]), "+v"(wh[2][2]), "+v"(wh[3][0]), "+v"(wh[3][1]), "+v"(wh[3][2]));
#pragma unroll
            for (int i = 0; i < 4; ++i)
#pragma unroll
                for (int ct = 0; ct < 3; ++ct) { acc[ct] = MFMA16(wh[i][ct], xa[i], acc[ct]); acc[ct] = MFMA16(wl[i][ct], xa[i], acc[ct]); }
        }
#pragma unroll
        for (int ct = 0; ct < 3; ++ct)
#pragma unroll
            for (int j = 0; j < 4; ++j) lg[(lane & 15) * 48 + ct * 16 + g * 4 + j] = acc[ct][j];
        LDS_WAIT(); asm volatile("" ::: "memory");
        if (lane < 16) {
            const int t = t0 + lane; const float rs = row_rstd(ssq, t); const LAS float* L = lg + lane * 48;
            int gi = 0; float gm = L[32] * rs + bg[0];
            float gl[4]; gl[0] = gm;
#pragma unroll
            for (int j = 1; j < 4; ++j) { gl[j] = L[32 + j] * rs + bg[j]; if (gl[j] > gm) { gm = gl[j]; gi = j; } }
            float gs = 0.f;
#pragma unroll
            for (int j = 0; j < 4; ++j) gs += __expf(gl[j] - gm);
            const float gp = 1.0f / gs;
            int e1 = 0, e2 = 0; float l1 = -3.0e38f, l2 = -3.0e38f;
            for (int j = 0; j < 8; ++j) { const float v = L[gi * 8 + j] * rs + br[gi * 8 + j];
                if (v > l1) { l2 = l1; e2 = e1; l1 = v; e1 = j; } else if (v > l2) { l2 = v; e2 = j; } }
            const float p2 = __expf(l2 - l1), w1 = gp / (1.0f + p2), w2 = gp * p2 / (1.0f + p2);
            const int x1 = gi * 8 + e1, x2 = gi * 8 + e2;
            toke[t * 2] = x1; toke[t * 2 + 1] = x2; tokw[t * 2] = w1; tokw[t * 2 + 1] = w2;
            __hip_atomic_fetch_add(hist + x1, 1, __ATOMIC_RELAXED, __HIP_MEMORY_SCOPE_WORKGROUP); __hip_atomic_fetch_add(hist + x2, 1, __ATOMIC_RELAXED, __HIP_MEMORY_SCOPE_WORKGROUP);
        }
        LDS_WAIT(); asm volatile("" ::: "memory");
    }
    __syncthreads();
    if (F.tid < NEXP) __hip_atomic_fetch_add((GAS unsigned*)(ws + WS_CTL) + CW_CNT + l * 32 + F.tid, (unsigned)hist[F.tid], __ATOMIC_RELAXED, __HIP_MEMORY_SCOPE_AGENT);
}

__device__ __forceinline__ int moe_pad_table(Frame& F, int l, LAS int* pad_end) {
    if (F.tid == 0) { const GAS unsigned* cnt = (const GAS unsigned*)(F.ws + WS_CTL) + CW_CNT + l * 32; int acc = 0;
        for (int e = 0; e < NEXP; ++e) { const unsigned c = __hip_atomic_load(cnt + e, __ATOMIC_RELAXED, __HIP_MEMORY_SCOPE_AGENT); acc += (int)((c + 255u) & ~255u); pad_end[e] = acc; } }
    __syncthreads();
    return pad_end[NEXP - 1];
}

__device__ __forceinline__ void assign_gather_phase(Frame& F, int l) {
    GAS unsigned char* ws = F.ws;
    LAS int* pad_end = (LAS int*)(F.lds + LDS_MISC + 64);
    LAS int* lhist = (LAS int*)(F.lds + LDS_MISC + 256);
    LAS int* lbase = (LAS int*)(F.lds + LDS_MISC + 512);
    LAS int* aslot = (LAS int*)(F.lds);
    LAS int* atok = (LAS int*)(F.lds + 1024);
    moe_pad_table(F, l, pad_end);
    if ((int)blockIdx.x < NEXP) {
        const int e = blockIdx.x; const unsigned cnt = __hip_atomic_load((const GAS unsigned*)(ws + WS_CTL) + CW_CNT + l * 32 + e, __ATOMIC_RELAXED, __HIP_MEMORY_SCOPE_AGENT);
        const int p0 = (e ? pad_end[e - 1] : 0) + (int)cnt, p1 = pad_end[e];
        for (int sl = p0 + F.tid; sl < p1; sl += NTHREADS) { ((GAS int*)(ws + WS_SLOT + SL_TOK))[sl] = 0; ((GAS float*)(ws + WS_SLOT + SL_W))[sl] = 0.f; ((GAS float*)(ws + WS_SLOT + SL_RSTD))[sl] = 0.f; } }
    const GAS int* toke = (const GAS int*)(ws + WS_TAB + TAB_TOKE); const GAS float* tokw = (const GAS float*)(ws + WS_TAB + TAB_TOKW);
    GAS int* slot_tok = (GAS int*)(ws + WS_SLOT + SL_TOK); GAS float* slot_w = (GAS float*)(ws + WS_SLOT + SL_W); GAS float* slot_rstd = (GAS float*)(ws + WS_SLOT + SL_RSTD); GAS int* tok_slot = (GAS int*)(ws + WS_SLOT + SL_TSLOT);
    const GAS float* ssq = (const GAS float*)(ws + WS_SSQ);
    const GAS bf16_t* xb = (const GAS bf16_t*)(ws + WS_XB); GAS bf16_t* sa = (GAS bf16_t*)(ws + WS_SORTA);
    GAS unsigned* cur = (GAS unsigned*)(ws + WS_CTL) + CW_CUR + l * 32;
    for (int ch = blockIdx.x; ch < NTOK / 128; ch += F.G) {
        if (F.tid < NEXP) lhist[F.tid] = 0;
        __syncthreads();
        int e = 0, pos = 0, t = 0;
        if (F.tid < 256) { t = ch * 128 + (F.tid >> 1); e = toke[t * 2 + (F.tid & 1)]; pos = __hip_atomic_fetch_add(lhist + e, 1, __ATOMIC_RELAXED, __HIP_MEMORY_SCOPE_WORKGROUP); }
        __syncthreads();
        if (F.tid < NEXP) lbase[F.tid] = (int)__hip_atomic_fetch_add(cur + F.tid, (unsigned)lhist[F.tid], __ATOMIC_RELAXED, __HIP_MEMORY_SCOPE_AGENT);
        __syncthreads();
        if (F.tid < 256) { const int slot = (e ? pad_end[e - 1] : 0) + lbase[e] + pos;
            slot_tok[slot] = t; slot_w[slot] = tokw[t * 2 + (F.tid & 1)]; slot_rstd[slot] = row_rstd(ssq, t); tok_slot[t * 2 + (F.tid & 1)] = slot;
            aslot[F.tid] = slot; atok[F.tid] = t; }
        __syncthreads();
        __syncthreads();
    }
}

__device__ __forceinline__ void combine_phase(Frame& F, int l) {
    GAS unsigned char* ws = F.ws; const int lane = F.lane;
    const GAS int* tok_slot = (const GAS int*)(ws + WS_SLOT + SL_TSLOT); const GAS bf16_t* Y = (const GAS bf16_t*)(ws + WS_SORTA);
    GAS bf16_t* xb = (GAS bf16_t*)(ws + WS_XB); GAS float* ssq = (GAS float*)(ws + WS_SSQ);
    const GAS f32x4* fing = (const GAS f32x4*)F.inp(I_FING);
    for (int t0 = F.gw * 4; t0 < NTOK; t0 += F.ngw * 4) {
        int sl0[4], sl1[4];
#pragma unroll
        for (int k = 0; k < 4; ++k) { sl0[k] = tok_slot[(t0 + k) * 2]; sl1[k] = tok_slot[(t0 + k) * 2 + 1]; }
        f32x4 v[4][4]; u32x2 xa[4][4], ya[4][4], yb[4][4];
#pragma unroll
        for (int k = 0; k < 4; ++k) { const GAS u32x2* xr = (const GAS u32x2*)(xb + (size_t)(t0 + k) * DM) + lane;
            const GAS u32x2* y0 = (const GAS u32x2*)(Y + (size_t)sl0[k] * DM) + lane; const GAS u32x2* y1 = (const GAS u32x2*)(Y + (size_t)sl1[k] * DM) + lane;
#pragma unroll
            for (int j = 0; j < 4; ++j) { xa[k][j] = xr[64 * j]; ya[k][j] = y0[64 * j]; yb[k][j] = y1[64 * j]; } }
#pragma unroll
        for (int k = 0; k < 4; ++k) { const int t = t0 + k; float s = 0.f; u32x2 w[4];
#pragma unroll
            for (int j = 0; j < 4; ++j) { const u32x2 x = xa[k][j], a = ya[k][j], b = yb[k][j];
                v[k][j].x = bflo(x.x) + bflo(a.x) + bflo(b.x); v[k][j].y = bfhi(x.x) + bfhi(a.x) + bfhi(b.x); v[k][j].z = bflo(x.y) + bflo(a.y) + bflo(b.y); v[k][j].w = bfhi(x.y) + bfhi(a.y) + bfhi(b.y);
                if (l == DEPTH - 1) s += (v[k][j].x * v[k][j].x + v[k][j].y * v[k][j].y) + (v[k][j].z * v[k][j].z + v[k][j].w * v[k][j].w);
                else { w[j].x = pk2(v[k][j].x, v[k][j].y); w[j].y = pk2(v[k][j].z, v[k][j].w); const float r0 = bflo(w[j].x), r1 = bfhi(w[j].x), r2 = bflo(w[j].y), r3 = bfhi(w[j].y); s += (r0 * r0 + r1 * r1) + (r2 * r2 + r3 * r3); } }
            s = wave_sum(s);
            if (l == DEPTH - 1) { const float rs = rsqrtf(s * (1.0f / DM) + EPS); GAS f32x4* orow = (GAS f32x4*)(F.out + (size_t)t * DM) + lane;
#pragma unroll
                for (int j = 0; j < 4; ++j) orow[64 * j] = v[k][j] * rs * fing[lane + 64 * j];
            } else {
                GAS u32x2* o8 = (GAS u32x2*)(xb + (size_t)t * DM) + lane;
#pragma unroll
                for (int j = 0; j < 4; ++j) o8[64 * j] = w[j];
                if (lane < 16) ssq[(size_t)t * 16 + lane] = (lane == 0) ? s : 0.f;
                if (lane == 0) ((GAS float*)(ws + WS_TAB + TAB_RSTD))[t] = rsqrtf(s * (1.0f / DM) + EPS);
            } }
    }
}

__device__ __forceinline__ void ab_phase(Frame& F, int l) {
    const int lane = lane_now(), g = lane >> 4, ql = lane & 15;
    const GAS bf16_t* xb = (const GAS bf16_t*)(F.ws + WS_XB); const GAS float* ssq = (const GAS float*)(F.ws + WS_SSQ); GAS float* ab = (GAS float*)(F.ws + WS_AB);
    const GAS bf16x8* fr = (const GAS bf16x8*)(F.ws + WS_TAB + TAB_ABF) + (size_t)l * 2048;
    for (int tile = F.gw; tile < NTOK / 16; tile += F.ngw) {
        const int t = tile * 16 + ql; const GAS bf16_t* xr = xb + (size_t)t * DM + g * 8;
        f32x4 acc = (f32x4){0.f, 0.f, 0.f, 0.f};
#pragma unroll
        for (int kb = 0; kb < 2; ++kb) { bf16x8 a[16], x[16];
#pragma unroll
            for (int i = 0; i < 16; ++i) { a[i] = fr[(kb * 16 + i) * 64 + lane]; x[i] = *(const GAS bf16x8*)(xr + (kb * 16 + i) * 32); }
            asm volatile("" : "+v"(x[0]), "+v"(x[1]), "+v"(x[2]), "+v"(x[3]), "+v"(x[4]), "+v"(x[5]), "+v"(x[6]), "+v"(x[7]), "+v"(x[8]), "+v"(x[9]), "+v"(x[10]), "+v"(x[11]), "+v"(x[12]), "+v"(x[13]), "+v"(x[14]), "+v"(x[15]),
                              "+v"(a[0]), "+v"(a[2]), "+v"(a[4]), "+v"(a[6]), "+v"(a[8]), "+v"(a[10]), "+v"(a[12]), "+v"(a[14]));
#pragma unroll
            for (int i = 0; i < 16; ++i) acc = MFMA16(a[i], x[i], acc); }
        const float rs = ((const GAS float*)(F.ws + WS_TAB + TAB_RSTD))[t];
        *(GAS f32x4*)(ab + (size_t)t * 16 + g * 4) = acc * rs;
    }
}

constexpr int PH_PRO = 0, PH_KV = 1, PH_FOLD = 2, PH_L0 = 3, PPL = 12, NPH = PH_L0 + DEPTH * PPL;
enum { LP_INPROJ = 0, LP_MIX, LP_MIX2, LP_FIN, LP_OUTPROJ, LP_SCORES, LP_PV, LP_ROUTER, LP_ASSIGN, LP_GATEUP, LP_DOWN, LP_COMBINE };

struct Args { const float* in[28]; float* out; unsigned char* ws; int ph_lo, ph_hi, mode, pad; };

__global__ void __launch_bounds__(NTHREADS, 2) fwd_kernel(Args args) {
    extern __shared__ __attribute__((aligned(16))) unsigned char lds_raw[];
    Frame F;
    F.lds = (LAS unsigned char*)lds_raw;
    F.tid = threadIdx.x; F.lane = F.tid & 63; F.wave = __builtin_amdgcn_readfirstlane(F.tid >> 6);
    F.G = gridDim.x; F.gw = blockIdx.x * NWAVES + F.wave; F.ngw = F.G * NWAVES;
    F.ka = (const CAS unsigned char*)__builtin_amdgcn_kernarg_segment_ptr();
    F.out = (GAS float*)args.out; F.ws = (GAS unsigned char*)args.ws;
    GAS unsigned char* ws0 = (GAS unsigned char*)args.ws;
    for (int u = F.tid; u < (LDS_BYTES - LDS_MISC) / 4; u += NTHREADS) ((LAS unsigned*)(F.lds + LDS_MISC))[u] = 0u;
    __syncthreads();
    const int lo = args.ph_lo, hi = args.ph_hi;
    XcdBarrier bar; bar.bar = (GAS unsigned*)(ws0 + WS_CTL) + CW_BAR; bar.x = 0; bar.st = (volatile LAS unsigned*)(F.lds + LDS_MISC);
    if (hi - lo > 1) bar = xcd_barrier_post((GAS unsigned*)(ws0 + WS_CTL) + CW_BAR, (volatile LAS unsigned*)(F.lds + LDS_MISC), F.tid == 0);
#ifndef LPMASK
#define LPMASK 0xfff
#endif
#ifndef PMASK
#define PMASK 7
#endif
#define IN(k) (lo <= (k) && (k) < hi)
#define INP(k) (((PMASK >> (k)) & 1) && IN(k))
#define INL(k) (((LPMASK >> (k)) & 1) && IN(pb + (k)))
#define SEAM(k) do { if (IN(k) && IN((k) + 1)) { unsigned _z = 0u; asm volatile("" : "+v"(_z));   \
        xcd_barrier(bar, F.wave == 0 && __builtin_amdgcn_mbcnt_hi(~0u, __builtin_amdgcn_mbcnt_lo(~0u, _z)) == 0u); } } while (0)
#define PH_ENTER() int c_id; GAS unsigned char* ws; do { unsigned _z0 = 0u; asm volatile("" : "+v"(_z0)); int _t = F.wave * 64 + (int)__builtin_amdgcn_mbcnt_hi(~0u, __builtin_amdgcn_mbcnt_lo(~0u, _z0)); asm volatile("" : "+v"(_t)); F.tid = _t; F.lane = _t & 63; GAS unsigned char* _w = (GAS unsigned char*)args.ws; asm volatile("" : "+s"(_w)); F.ws = _w; ws = _w; \
        GAS float* _o = (GAS float*)args.out; asm volatile("" : "+s"(_o)); F.out = _o;     int _c = blockIdx.x; asm volatile("" : "+s"(_c)); c_id = _c; F.gw = _c * NWAVES + F.wave; } while (0)

    if (INP(PH_PRO)) { PH_ENTER(); (void)c_id; (void)ws; p0_prologue(F); }
    SEAM(PH_PRO);

    for (int l = 0; l < DEPTH; ++l) {
        const int pb = PH_L0 + l * PPL;
        if (INL(LP_INPROJ)) { PH_ENTER();
            OrdInProj S{(const GAS char*)(ws + WS_XB), (const GAS char*)(ws + WS_WIN) + (size_t)l * PINP * DM * 2, (size_t)256 * DM * 2, NTOK / 256, PINP / 256, F.G, c_id};
            EpiProj E{(GAS bf16_t*)(ws + WS_PROJ), (GAS float*)(ws + WS_AB), (const GAS float*)(ws + WS_TAB + TAB_RSTD), (GAS bf16_t*)(ws + WS_VTA)};
            pg8::gemm_phase<EpiProj, OrdInProj>(F.lds, F.tid, pg8::Gemm{DM, DM, DM}, S, E);
            ab_phase(F, l);
            if (l == 0) { PH_ENTER();
                OrdKV S{(const GAS char*)(ws + WS_MEMN), (const GAS char*)(ws + WS_WKV), F.G, c_id};
                EpiBf E{(GAS bf16_t*)(ws + WS_KV), 2048};
                pg8::gemm_phase<EpiBf, OrdKV>(F.lds, F.tid, pg8::Gemm{DM, DM, DM}, S, E); }
        }
        SEAM(pb + LP_INPROJ);
        if (INL(LP_MIX) && l == 0) {
            { PH_ENTER(); OrdKq S{(const GAS char*)(ws + WS_KV), (const GAS char*)(ws + WS_WQB), F.G, c_id}; EpiBf E{(GAS bf16_t*)(ws + WS_KQT), DM};
              int kf = 256; asm volatile("" : "+s"(kf)); pg8::gemm_phase<EpiBf, OrdKq>(F.lds, F.tid, pg8::Gemm{2048, DM, kf}, S, E); }
            { PH_ENTER(); OrdVo S{(const GAS char*)(ws + WS_KV), (const GAS char*)(ws + WS_WOT), F.G, (c_id + 128) % F.G}; EpiBf E{(GAS bf16_t*)(ws + WS_VOT), DM};
              int kf = 256; asm volatile("" : "+s"(kf)); pg8::gemm_phase<EpiBf, OrdVo>(F.lds, F.tid, pg8::Gemm{DM, 2048, kf}, S, E); }
        }
        if (INL(LP_MIX)) { PH_ENTER();
            GAS bf16_t* proj = (GAS bf16_t*)(ws + WS_PROJ); GAS bf16_t* ycat = (GAS bf16_t*)(ws + WS_YCAT);
            const GAS float* rope = (const GAS float*)(ws + WS_TAB + TAB_ROPE);
            if (args.mode != 2 && args.mode != 4) {   const GAS bf16_t* pt = (const GAS bf16_t*)(ws + WS_TAB + TAB_POOL) + (size_t)l * 4 * 64 * 64;
                const GAS float* rpb = F.inp(I_RPB) + (size_t)l * 4 * 15 * 31;
                LAS float* rpbs = (LAS float*)(F.lds);
                for (int i = F.tid; i < 4 * 465; i += NTHREADS) rpbs[i] = rpb[i];
                __syncthreads();
                const int gws = ((F.G & 7) == 0 ? (c_id & 7) * (F.G >> 3) + (c_id >> 3) : c_id) * NWAVES + F.wave;
                for (int it = gws; it < 8192 + NTOK / 16; it += F.ngw) {
                    if (it < 8192) { if (args.mode != 3) na_item(F, proj, (const GAS bf16_t*)(ws + WS_VTA), rpbs, ycat, it); } else if (args.mode != 1) pool_item(F, proj, pt, ycat, it - 8192);
                }
                __syncthreads(); }
            if (args.mode == 0) for (int item = blockIdx.x; item < 1024; item += F.G) ret_r1_item(F, proj, rope, (GAS bf16_t*)(ws + WS_RET), item);
            const GAS float* convw = F.inp(I_CONVW) + (size_t)l * 4 * 768; const GAS float* alog = F.inp(I_ALOG) + l * 8; const GAS float* dtb = F.inp(I_DTB) + l * 8;
            if (args.mode != 1 && args.mode != 3 && args.mode != 4) for (int item = blockIdx.x; item < 2048; item += F.G) gdn_g1_item(F, proj, (const GAS float*)(ws + WS_AB), convw, alog, dtb, ws + WS_MIXS, item);
        }
        SEAM(pb + LP_MIX);
        if (INL(LP_MIX2)) { PH_ENTER(); (void)c_id;
            const int nsc = (F.G >= 256) ? 128 : 0;
            if (nsc == 0) { for (int ch = blockIdx.x; ch < 128; ch += F.G) gdn_scan_block(F, ws + WS_MIXS, (GAS bf16_t*)((GAS unsigned char*)F.out + 16 * MiB), ch);
                ret_r2_scan(F, (const GAS bf16_t*)(ws + WS_RET), (GAS bf16_t*)F.out, (size_t)blockIdx.x * NTHREADS + F.tid, (size_t)F.G * NTHREADS); }
            else if ((int)blockIdx.x < nsc) { const int cb = blockIdx.x, chain = (((cb & 7) * 4 + (cb >> 5)) * 4) + ((cb >> 3) & 3);
                gdn_scan_block(F, ws + WS_MIXS, (GAS bf16_t*)((GAS unsigned char*)F.out + 16 * MiB), chain); __syncthreads(); }
            else { const int wb = (int)blockIdx.x - nsc, nwb = F.G - nsc;
                ret_r2_scan(F, (const GAS bf16_t*)(ws + WS_RET), (GAS bf16_t*)F.out, (size_t)wb * NTHREADS + F.tid, (size_t)nwb * NTHREADS); }
            convert_experts_queue(F, l);
        }
        SEAM(pb + LP_MIX2);
        if (INL(LP_FIN)) { PH_ENTER(); (void)c_id;
            const GAS float* retg = F.inp(I_RETG) + l * 256; const GAS float* gdng = F.inp(I_GDNG) + l * 64;
            for (int item = blockIdx.x; item < 1024; item += F.G) ret_r3_item(F, (const GAS bf16_t*)(ws + WS_PROJ), (const GAS bf16_t*)F.out, retg, (GAS bf16_t*)(ws + WS_YCAT), item);
            gdn_finalize(F, (const GAS bf16_t*)(ws + WS_PROJ), (const GAS bf16_t*)((GAS unsigned char*)F.out + 16 * MiB), gdng, (GAS bf16_t*)(ws + WS_YCAT), F.gw, F.ngw);
        }
        SEAM(pb + LP_FIN);
        if (INL(LP_OUTPROJ)) { PH_ENTER();
            OrdStd S{(const GAS char*)(ws + WS_YCAT), (const GAS char*)(ws + WS_WOUT) + (size_t)l * DM * DM * 2, (size_t)256 * DM * 2, (size_t)256 * DM * 2, 0, NTOK / 256, 4, F.G, c_id};
            EpiResid E{(GAS bf16_t*)(ws + WS_XB), (GAS float*)(ws + WS_SSQ)};
            pg8::gemm_phase<EpiResid, OrdStd>(F.lds, F.tid, pg8::Gemm{DM, DM, DM}, S, E);
        }
        SEAM(pb + LP_OUTPROJ);
        if (INL(LP_SCORES)) { PH_ENTER();
            OrdStd S{(const GAS char*)(ws + WS_XB), (const GAS char*)(ws + WS_KQT) + (size_t)l * 4 * DM * DM * 2, (size_t)256 * DM * 2, (size_t)256 * DM * 2, (size_t)DM * DM * 2, NTOK / 256, 4, F.G, c_id};
            EpiSoftmax E{(GAS bf16_t*)(ws + WS_P), (const GAS float*)(ws + WS_SSQ), (LAS float*)(F.lds + LDS_EX)};
            pg8::gemm_phase<EpiSoftmax, OrdStd>(F.lds, F.tid, pg8::Gemm{DM, DM, DM}, S, E);
        }
        SEAM(pb + LP_SCORES);
        if (INL(LP_PV)) { PH_ENTER();
            OrdStd S{(const GAS char*)(ws + WS_P), (const GAS char*)(ws + WS_VOT) + (size_t)l * 4 * DM * DM * 2, (size_t)256 * DM * 2, (size_t)256 * DM * 2, (size_t)DM * DM * 2, NTOK / 256, 4, F.G, c_id};
            EpiResid E{(GAS bf16_t*)(ws + WS_XB), (GAS float*)(ws + WS_SSQ)};
            pg8::gemm_phase<EpiResid, OrdStd, false, true>(F.lds, F.tid, pg8::Gemm{DM, DM, DM}, S, E);
        }
        SEAM(pb + LP_PV);
        if (INL(LP_ROUTER)) { PH_ENTER(); (void)c_id; (void)ws; router_phase(F, l); }
        SEAM(pb + LP_ROUTER);
        if (INL(LP_ASSIGN)) { PH_ENTER(); (void)c_id; (void)ws; assign_gather_phase(F, l); }
        SEAM(pb + LP_ASSIGN);
        if (INL(LP_GATEUP)) { PH_ENTER();
            LAS int* pad_end = (LAS int*)(F.lds + LDS_MISC + 64);
            const int total = moe_pad_table(F, l, pad_end);
            int cs = ((F.G & 7) == 0) ? (c_id & 7) * (F.G >> 3) + (c_id >> 3) : c_id; asm volatile("" : "+s"(cs));
            OrdMoE S{(const GAS char*)(ws + WS_XB), (const GAS char*)(ws + WS_WGU), (size_t)0, (size_t)1024 * DM * 2, (size_t)256 * DM * 2, (total / 256) * 4, pad_end, F.G, cs, (const GAS int*)(ws + WS_SLOT + SL_TOK), (GAS unsigned*)(ws + WS_CTL) + CW_PAN + l * 320 * 16, 0};
            EpiGateUp E{(GAS bf16_t*)(ws + WS_HMID), (const GAS float*)(ws + WS_SLOT + SL_RSTD)};
            pg8::gemm_phase<EpiGateUp, OrdMoE, true, false, true>(F.lds, F.tid, pg8::Gemm{DM, DM, DM}, S, E);
        }
        if (INL(LP_DOWN)) { PH_ENTER();
            LAS int* pad_end = (LAS int*)(F.lds + LDS_MISC + 64);
            const int total = moe_pad_table(F, l, pad_end);
            int cs = ((F.G & 7) == 0) ? (c_id & 7) * (F.G >> 3) + (c_id >> 3) : c_id; const int nu = (total / 256) * 4, rem = nu % F.G; cs -= rem; if (cs < 0) cs += F.G; cs = __builtin_amdgcn_readfirstlane(cs); const int bal = __builtin_amdgcn_readfirstlane((3 * rem <= F.G && nu >= 2 * F.G) ? 1 : 0);
            OrdMoE S{(const GAS char*)(ws + WS_HMID), (const GAS char*)(ws + WS_WD), (size_t)256 * DEXP * 2, (size_t)1024 * DEXP * 2, (size_t)256 * DEXP * 2, (total / 256) * 4, pad_end, F.G, cs, nullptr, (GAS unsigned*)(ws + WS_CTL) + CW_PAN + l * 320 * 16, bal};
            EpiDown E{(GAS bf16_t*)(ws + WS_SORTA), (const GAS float*)(ws + WS_SLOT + SL_W)};
            pg8::gemm_phase<EpiDown, OrdMoE, false, true, true>(F.lds, F.tid, pg8::Gemm{DEXP, DEXP, DEXP}, S, E);
        }
        SEAM(pb + LP_DOWN);
        if (INL(LP_COMBINE)) { PH_ENTER(); (void)c_id; (void)ws; combine_phase(F, l); }
        SEAM(pb + LP_COMBINE);
    }
#undef IN
#undef SEAM
}

extern "C" void kernel_launch(void* const* d_in, const int* in_sizes, int n_in, void* d_out, int out_size, void* d_ws, size_t ws_size, hipStream_t stream) {
    static int grid = 0;
    if (grid == 0) {
        if (n_in != 28 || out_size != NTOK * DM || ws_size < WS_END) { fprintf(stderr, "kernel_launch: unexpected shapes (n_in %d out %d ws %zu need %zu)\n", n_in, out_size, ws_size, (size_t)WS_END); grid = -1; return; }
        int dev = 0, cus = 0;
        if (hipGetDevice(&dev) != hipSuccess || hipDeviceGetAttribute(&cus, hipDeviceAttributeMultiprocessorCount, dev) != hipSuccess) { grid = -1; return; }
        if (hipFuncSetAttribute((const void*)fwd_kernel, hipFuncAttributeMaxDynamicSharedMemorySize, LDS_BYTES) != hipSuccess) { grid = -1; return; }
        int per_cu = 0;
        if (hipOccupancyMaxActiveBlocksPerMultiprocessor(&per_cu, (const void*)fwd_kernel, NTHREADS, LDS_BYTES) != hipSuccess || per_cu < 1) { fprintf(stderr, "occupancy query: %d\n", per_cu); }
        (void)hipGetLastError();
        grid = cus;
    }
    if (grid < 0) return;
    (void)hipMemsetAsync((char*)d_ws + WS_CTL, 0, CTL_ZERO_BYTES, stream);
    Args a{};
    for (int i = 0; i < 28; ++i) a.in[i] = (const float*)d_in[i];
    a.out = (float*)d_out; a.ws = (unsigned char*)d_ws;
#if MK_ONE_LAUNCH
    a.ph_lo = 0; a.ph_hi = NPH;
    hipLaunchKernelGGL(fwd_kernel, dim3(grid), dim3(NTHREADS), LDS_BYTES, stream, a);
#else
#ifndef PROBE_PH
#define PROBE_PH -1
#endif
#ifndef PROBE_REPS
#define PROBE_REPS 1
#endif
    for (int p = 0; p < NPH; ++p) { a.ph_lo = p; a.ph_hi = p + 1; const int reps = (PROBE_PH >= 0 && (p == PROBE_PH || p == PROBE_PH + PPL)) ? 1 + PROBE_REPS : 1;
#ifndef PROBE_MODE
#define PROBE_MODE 0
#endif
        for (int r = 0; r < reps; ++r) { a.mode = (r > 0) ? PROBE_MODE : 0; hipLaunchKernelGGL(fwd_kernel, dim3(grid), dim3(NTHREADS), LDS_BYTES, stream, a); } a.mode = 0; }
#endif
}
```

```cpp
#include <hip/hip_runtime.h>
#include <stdint.h>
#include <stdio.h>

#define LAS __attribute__((address_space(3)))
#define GAS __attribute__((address_space(1)))
typedef unsigned short bf16_t;
typedef short bf16x8 __attribute__((ext_vector_type(8)));
typedef float f32x4 __attribute__((ext_vector_type(4)));
typedef float f32x2 __attribute__((ext_vector_type(2)));
typedef unsigned u32x4 __attribute__((ext_vector_type(4)));
typedef unsigned u32x2 __attribute__((ext_vector_type(2)));

#ifndef MK_ONE_LAUNCH
#define MK_ONE_LAUNCH 1
#endif

constexpr int NB = 4, SEQ = 8192, DM = 1024, NTOK = NB * SEQ, NMEM = 256, DEPTH = 2;
constexpr int PINP = 3072;
constexpr int NEXP = 32, DEXP = 512;
constexpr int CAP = NTOK * 2 + NEXP * 256;
constexpr float EPS = 1e-6f;
constexpr int NWAVES = 8, NTHREADS = 512;

constexpr size_t MiB = 1u << 20;
constexpr size_t WS_CTL   = 0;
constexpr size_t WS_WIN   = 1 * MiB;
constexpr size_t WS_WOUT  = 14 * MiB;
constexpr size_t WS_WQB   = 18 * MiB;
constexpr size_t WS_WKV   = 22 * MiB;
constexpr size_t WS_WOT   = 30 * MiB;
constexpr size_t WS_MEMN  = 34 * MiB;
constexpr size_t WS_KV    = 38 * MiB;
constexpr size_t WS_KQT   = 46 * MiB;
constexpr size_t WS_VOT   = 62 * MiB;
constexpr size_t WS_SSQ   = 78 * MiB;
constexpr size_t WS_TAB   = 80 * MiB;
constexpr size_t WS_XB    = 84 * MiB;
constexpr size_t WS_STAGE = 148 * MiB;
constexpr size_t WS_PROJ  = WS_STAGE;
constexpr size_t WS_VTA   = WS_PROJ + 32 * MiB;
constexpr size_t WS_WD    = WS_PROJ;
constexpr size_t WS_P     = WS_PROJ + 48 * MiB;
constexpr size_t WS_WGU   = WS_PROJ + 112 * MiB;
constexpr size_t WS_AB    = WS_PROJ + 192 * MiB;
constexpr size_t WS_YCAT  = WS_AB + 2 * MiB;
constexpr size_t WS_MIXS  = WS_YCAT + 64 * MiB;
constexpr size_t WS_RET   = WS_MIXS + 128 * MiB;
constexpr size_t WS_MIX_END = WS_RET + 16 * MiB;
constexpr size_t WS_SORTA = WS_AB;
constexpr size_t WS_HMID  = WS_SORTA + 144 * MiB;
constexpr size_t WS_SLOT  = WS_HMID + 72 * MiB;
constexpr size_t WS_MOE_END = WS_SLOT + 2 * MiB;
constexpr size_t WS_END = WS_MIX_END > WS_MOE_END ? WS_MIX_END : WS_MOE_END;
static_assert(WS_END <= 580 * MiB, "workspace budget");
constexpr size_t TAB_ROPE = 0;
constexpr size_t TAB_RFR  = 2 * MiB;
constexpr size_t TAB_POOL = 3 * MiB;
constexpr size_t SL_TOK = 0, SL_W = 512 * 1024, SL_RSTD = 1024 * 1024, SL_TSLOT = 1536 * 1024;
constexpr size_t TAB_TOKE = 3 * MiB + 256 * 1024;
constexpr size_t TAB_TOKW = 3 * MiB + 512 * 1024;
constexpr size_t TAB_RSTD = 3 * MiB + 832 * 1024;
constexpr size_t TAB_ABF  = 3 * MiB + 768 * 1024;
constexpr int CW_BAR = 4096;
constexpr int CW_CNT = 16384;
constexpr int CW_CUR = 16384 + 64;
constexpr int CW_PAN = 16384 + 1024;
constexpr int CW_CQ = 16384 + 256;
constexpr size_t CTL_ZERO_BYTES = 1 * MiB;

constexpr int LDS_RING = 0, LDS_RING_BYTES = 131072;
constexpr int LDS_EX = 131072;
constexpr int LDS_MISC = 131072 + 8192;
constexpr int LDS_BYTES = 147456;

typedef __bf16 bf16v2_t __attribute__((ext_vector_type(2)));
__device__ __forceinline__ unsigned pk2(float lo, float hi) { const f32x2 v = (f32x2){lo, hi}; const bf16v2_t r = __builtin_convertvector(v, bf16v2_t); return __builtin_bit_cast(unsigned, r); }
__device__ __forceinline__ unsigned f2bf(float f) { return pk2(f, f) & 0xffffu; }
__device__ __forceinline__ float bflo(unsigned w) { return __builtin_bit_cast(float, w << 16); }
__device__ __forceinline__ float bfhi(unsigned w) { return __builtin_bit_cast(float, w & 0xffff0000u); }
__device__ __forceinline__ float bf2f(bf16_t b) { return __builtin_bit_cast(float, ((unsigned)b) << 16); }
__device__ __forceinline__ int lane_now() { unsigned z = 0u; asm volatile("" : "+v"(z)); return (int)__builtin_amdgcn_mbcnt_hi(~0u, __builtin_amdgcn_mbcnt_lo(~0u, z)); }
__device__ __forceinline__ float shfl_xor_f(float v, int m) { return __builtin_bit_cast(float, __builtin_amdgcn_ds_bpermute((lane_now() ^ m) << 2, __builtin_bit_cast(int, v))); }
__device__ __forceinline__ float shfl_f(float v, int src) { return __builtin_bit_cast(float, __builtin_amdgcn_ds_bpermute(src << 2, __builtin_bit_cast(int, v))); }
__device__ __forceinline__ float wave_sum(float v) {
#pragma unroll
    for (int o = 1; o < 64; o <<= 1) v += shfl_xor_f(v, o);
    return v;
}
__device__ __forceinline__ float wave_max(float v) {
#pragma unroll
    for (int o = 1; o < 64; o <<= 1) v = fmaxf(v, shfl_xor_f(v, o));
    return v;
}
__device__ __forceinline__ float silu_f(float x) { return x * __builtin_amdgcn_rcpf(1.f + __expf(-x)); }
__device__ __forceinline__ float sigmoid_f(float x) { return __builtin_amdgcn_rcpf(1.f + __expf(-x)); }
__device__ __forceinline__ float softplus_f(float x) { const float e = __expf(x); return x > 15.f ? x : (x < -15.f ? e : __logf(1.0f + e)); }
#define LDS_WAIT() asm volatile("s_waitcnt lgkmcnt(0)" ::: "memory")
#define VM_WAIT() asm volatile("s_waitcnt vmcnt(0)" ::: "memory")

#define XB_TMO      128
#define XB_XCNT(j)  (256  + 64 * (j))
#define XB_XSUB(j)  (1280 + 64 * (j))
#define XB_XGEN(j)  (2304 + 64 * (j))
#define XB_TOP      3328
#define XB_TOPGEN   3392
#define XCD_BAR_WORDS 3456
#define XB_SPIN_CAP (1u << 22)

__device__ __forceinline__ unsigned xb_ld(GAS unsigned* p)              { return __hip_atomic_load(p, __ATOMIC_RELAXED, __HIP_MEMORY_SCOPE_AGENT); }
__device__ __forceinline__ unsigned xb_add(GAS unsigned* p, unsigned v) { return __hip_atomic_fetch_add(p, v, __ATOMIC_RELAXED, __HIP_MEMORY_SCOPE_AGENT); }
__device__ __forceinline__ unsigned xb_xcc_id() { return (unsigned)__builtin_amdgcn_s_getreg((3 << 11) | 20) & 0xFu; }
#define XB_SPIN(cond, bar) do { unsigned _sp = 0; while (cond) { __builtin_amdgcn_s_sleep(1); \
    if ((++_sp & 255u) == 0u) { if (xb_ld(&(bar)[XB_TMO])) break; if (_sp > XB_SPIN_CAP) { xb_add(&(bar)[XB_TMO], 1u); break; } } } } while (0)

struct XcdBarrier { GAS unsigned* bar; unsigned x; volatile LAS unsigned* st; };

__device__ __forceinline__ XcdBarrier xcd_barrier_post(GAS unsigned* bar, volatile LAS unsigned* st, const bool leader) {
    XcdBarrier b; b.bar = bar; b.x = xb_xcc_id(); b.st = st;
    if (leader) (void)xb_add(&bar[XB_XCNT(b.x)], 1u);
    return b;
}
__device__ __forceinline__ void xcd_barrier_complete(GAS unsigned* bar, unsigned x, unsigned& nloc, unsigned& nx) {
    const unsigned G = gridDim.x * gridDim.y * gridDim.z;
    unsigned sum, cnt, mine, sp = 0u;
    for (;;) {
        sum = 0u; cnt = 0u; mine = 0u;
#pragma unroll
        for (unsigned j = 0; j < 16; ++j) { const unsigned c = xb_ld(&bar[XB_XCNT(j)]); sum += c; cnt += (c > 0u) ? 1u : 0u; mine = (j == x) ? c : mine; }
        if (sum == G) break;
        __builtin_amdgcn_s_sleep(1);
        if ((++sp & 255u) == 0u) { if (xb_ld(&bar[XB_TMO])) break; if (sp > XB_SPIN_CAP) { xb_add(&bar[XB_TMO], 1u); break; } }
    }
    nloc = mine > 0u ? mine : 1u; nx = cnt > 0u ? cnt : 1u;
}
__device__ __forceinline__ void xcd_barrier(const XcdBarrier& b, const bool leader) {
    asm volatile("s_waitcnt vmcnt(0)" ::: "memory");
    __syncthreads();
    if (leader) {
        GAS unsigned* bar = b.bar;
        __builtin_amdgcn_s_waitcnt(0);
        unsigned nloc = b.st[0], nx = b.st[1];
        if (nloc == 0u) { xcd_barrier_complete(bar, b.x, nloc, nx); b.st[0] = nloc; b.st[1] = nx; }
        const unsigned old = xb_add(&bar[XB_XSUB(b.x)], 1u);
        const unsigned gen = old / nloc;
        if (old + 1u == (gen + 1u) * nloc) {
            __builtin_amdgcn_fence(__ATOMIC_RELEASE, "agent");
            asm volatile("s_waitcnt vmcnt(0)" ::: "memory");
            const unsigned og = xb_add(&bar[XB_TOP], 1u);
            const unsigned tg = og / nx;
            if (og + 1u == (tg + 1u) * nx) xb_add(&bar[XB_TOPGEN], 1u);
            else XB_SPIN(xb_ld(&bar[XB_TOPGEN]) == tg, bar);
            __builtin_amdgcn_fence(__ATOMIC_ACQUIRE, "agent");
            xb_add(&bar[XB_XGEN(b.x)], 1u);
            asm volatile("s_waitcnt vmcnt(0)" ::: "memory");
        } else {
            XB_SPIN(xb_ld(&bar[XB_XGEN(b.x)]) == gen, bar);
            __builtin_amdgcn_fence(__ATOMIC_ACQUIRE, "agent");
            asm volatile("s_waitcnt vmcnt(0)" ::: "memory");
        }
    }
    __syncthreads();
}

namespace pg8 {
constexpr int BM = 256, BK = 64, HALF = 128, HTB = HALF * BK * 2, STAGE_BYTES = 8 * HTB, NXCD = 8, WGM = 8;
__host__ __device__ __forceinline__ int lds_byte(int r, int c) { const int st = (r >> 4) * 2 + (c >> 5), rr = r & 15, cc = c & 31, ob = rr * 64 + cc * 2; return st * 1024 + (ob ^ (((ob >> 9) & 1) << 5)); }
__host__ __device__ __forceinline__ void stage_rc(int b, int& R, int& C) { const int st = b / 1024, sb = b % 1024, swz = sb ^ (((sb >> 9) & 1) << 5); R = (st >> 1) * 16 + swz / 64; C = (st & 1) * 32 + (swz % 64) / 2; }
__host__ __device__ __forceinline__ int perm32(int rho) { const int n = rho >> 4, i = rho & 15; return 8 * (i >> 2) + 4 * n + (i & 3); }

struct Unit { int pm, pn, z; };
struct Gemm { int lda, ldb, K; };

__device__ __forceinline__ void static_map(int wgid, int nM, int nN, int& pm, int& pn) {
    const int nwg = nM * nN;
    { const int q = nwg / NXCD, r = nwg % NXCD, xcd = wgid % NXCD, off = wgid / NXCD; wgid = (xcd < r ? xcd * (q + 1) : r * (q + 1) + (xcd - r) * q) + off; }
    const int nig = WGM * nN, gid = wgid / nig, fm = gid * WGM, gsz = (nM - fm) < WGM ? (nM - fm) : WGM;
    pm = fm + ((wgid % nig) % gsz); pn = (wgid % nig) / gsz;
}

__device__ __forceinline__ unsigned cvt_pk_bf16(float lo, float hi) { unsigned r; asm volatile("v_cvt_pk_bf16_f32 %0, %1, %2" : "=v"(r) : "v"(lo), "v"(hi)); return r; }

template <class Epi, class Sched, bool GATHER = false, bool ABLK = false, bool HOOKS = false>
__device__ __forceinline__ void gemm_phase(LAS unsigned char* lds, const int tid, const Gemm g, const Sched& S, const Epi& E) {
    const int wid = __builtin_amdgcn_readfirstlane(tid >> 6), lane = tid & 63, wr = wid >> 2, wc = wid & 3, fr = lane & 15, fq = lane >> 4;
    const int K = g.K, nt = K / BK;
    unsigned voffA[2], voffB[2];
#pragma unroll
    for (int i = 0; i < 2; ++i) { int R, C; stage_rc(tid * 16 + i * 8192, R, C); const int Rb = Epi::PERM ? ((R & ~31) + perm32(R & 31)) : R;
        voffA[i] = ABLK ? (unsigned)((R >> 4) * 16 * g.lda) * 2u + (unsigned)(((C >> 5) * 4 + (lane >> 4)) * 256 + (lane & 15) * 16) : (unsigned)(R * g.lda + C) * 2u; voffB[i] = (unsigned)(Rb * g.ldb + C) * 2u; }
    unsigned voA[2][2]; int gr[2][2];
#define PG8_GROWS(u) do { _Pragma("unroll") for (int _h = 0; _h < 2; ++_h) _Pragma("unroll") for (int _i = 0; _i < 2; ++_i) { int _R, _C; stage_rc(tid * 16 + _i * 8192, _R, _C); gr[_h][_i] = S.row_of((u), _h * HALF + _R); } } while (0)
#define PG8_GOFFS(dst) do { _Pragma("unroll") for (int _h = 0; _h < 2; ++_h) _Pragma("unroll") for (int _i = 0; _i < 2; ++_i) { int _R, _C; stage_rc(tid * 16 + _i * 8192, _R, _C); (dst)[_h][_i] = (unsigned)(gr[_h][_i] * g.lda + _C) * 2u; } } while (0)
    const size_t kstep = (size_t)(BK * 2), kstepA = ABLK ? (size_t)2048 : kstep;
    const size_t hstepA = (size_t)HALF * g.lda * 2, hstepB = (size_t)HALF * g.ldb * 2;
    const unsigned ldsw = (unsigned)wid * 1024u;
    const int aoff = ABLK ? wr * 8192 + fq * 256 + fr * 16 : lds_byte(wr * 64 + fr, fq * 8), boff = lds_byte(wc * 32 + fr, fq * 8);
#define PG8_SA(b, h) (((b) * 2 + (h)) * HTB)
#define PG8_SB(b, h) ((4 + (b) * 2 + (h)) * HTB)
#define PG8_STAGE(bufoff, gbase, voff) do { _Pragma("unroll") for (int _i = 0; _i < 2; ++_i) \
        __builtin_amdgcn_global_load_lds((const GAS unsigned*)((const GAS char*)(gbase) + (voff)[_i]), (LAS unsigned*)(lds + (bufoff) + ldsw + _i * 8192), 16, 0, 0); } while (0)
#define PG8_LDA(dst, b, h) do { _Pragma("unroll") for (int m = 0; m < 4; ++m) _Pragma("unroll") for (int k = 0; k < 2; ++k) dst[m][k] = *(const LAS bf16x8*)(lds + PG8_SA(b, h) + aoff + m * 2048 + k * 1024); } while (0)
#define PG8_LDB(dst, b, h) do { _Pragma("unroll") for (int n = 0; n < 2; ++n) _Pragma("unroll") for (int k = 0; k < 2; ++k) dst[n][k] = *(const LAS bf16x8*)(lds + PG8_SB(b, h) + boff + n * 2048 + k * 1024); } while (0)
#define PG8_MMA(ai, bj, At, Bt) do { __builtin_amdgcn_s_setprio(1); _Pragma("unroll") for (int m = 0; m < 4; ++m) _Pragma("unroll") for (int n = 0; n < 2; ++n) _Pragma("unroll") for (int k = 0; k < 2; ++k) \
        acc[ai][bj][m][n] = __builtin_amdgcn_mfma_f32_16x16x32_bf16(Bt[n][k], At[m][k], acc[ai][bj][m][n], 0, 0, 0); __builtin_amdgcn_s_setprio(0); } while (0)
#define PG8_WAIT_V(n) asm volatile("s_waitcnt vmcnt(" #n ")" ::: "memory")
#define PG8_WAIT_L(n) asm volatile("s_waitcnt lgkmcnt(" #n ")" ::: "memory")
#define PG8_BAR __builtin_amdgcn_s_barrier()
#define PG8_SCHED __builtin_amdgcn_sched_barrier(0)
    Unit cur, nxt; int ui = 0;
    if (!S.next(0, cur)) return;
    if constexpr (HOOKS) S.a_ready(cur, wid);
    f32x4 acc[2][2][4][2];
#pragma unroll
    for (int a = 0; a < 2; ++a)
#pragma unroll
        for (int b = 0; b < 2; ++b)
#pragma unroll
            for (int m = 0; m < 4; ++m)
#pragma unroll
                for (int n = 0; n < 2; ++n) acc[a][b][m][n] = (f32x4){0.f, 0.f, 0.f, 0.f};
    bf16x8 At[4][2], B0[2][2], B1[2][2];
    const GAS char* cA = S.a_ptr(cur); const GAS char* cB = S.b_ptr(cur);
    {
        if constexpr (GATHER) { PG8_GROWS(cur); PG8_GOFFS(voA); }
        else { _Pragma("unroll") for (int _i = 0; _i < 2; ++_i) { voA[0][_i] = voffA[_i]; voA[1][_i] = voffA[_i] + (unsigned)hstepA; } }
        PG8_STAGE(PG8_SB(0, 0), cB, voffB); PG8_STAGE(PG8_SB(0, 1), cB + hstepB, voffB); PG8_STAGE(PG8_SA(0, 0), cA, voA[0]); PG8_STAGE(PG8_SA(0, 1), cA, voA[1]);
        if (wr == 1) PG8_BAR;
        PG8_WAIT_V(2); PG8_BAR;
        PG8_STAGE(PG8_SB(1, 0), cB + kstep, voffB); PG8_STAGE(PG8_SA(1, 0), cA + kstepA, voA[0]); PG8_STAGE(PG8_SB(1, 1), cB + hstepB + kstep, voffB);
        PG8_WAIT_V(6); PG8_BAR;
    }
    for (;;) {
        const bool has_next = S.next(ui + 1, nxt);
        const GAS char* nA = has_next ? S.a_ptr(nxt) : cA; const GAS char* nB = has_next ? S.b_ptr(nxt) : cB;
        if constexpr (HOOKS) { if (has_next) S.a_ready(nxt, wid); }
        if constexpr (GATHER) { if (has_next) PG8_GROWS(nxt); }
        for (int t = 0; t < nt; t += 2) {
            const bool last = (t == nt - 2);
            const GAS char* a1 = cA + (size_t)(t + 1) * kstepA;
            const GAS char* a2 = last ? nA : cA + (size_t)(t + 2) * kstepA; const GAS char* b2 = last ? nB : cB + (size_t)(t + 2) * kstep;
            const GAS char* a3 = a2 + kstepA; const GAS char* b3 = b2 + kstep;
            PG8_LDB(B0, 0, 0); PG8_LDB(B1, 0, 1); PG8_SCHED; PG8_LDA(At, 0, 0); PG8_STAGE(PG8_SA(1, 1), a1, voA[1]);
            if constexpr (GATHER) { if (last && has_next) { asm volatile("" : "+v"(gr[0][0]), "+v"(gr[0][1]), "+v"(gr[1][0]), "+v"(gr[1][1])); PG8_GOFFS(voA); } }
            PG8_WAIT_V(8); PG8_WAIT_L(0); PG8_BAR; PG8_MMA(0, 0, At, B0); PG8_MMA(0, 1, At, B1); PG8_BAR; PG8_SCHED;
            PG8_LDA(At, 0, 1); PG8_STAGE(PG8_SB(0, 0), b2, voffB); PG8_STAGE(PG8_SB(0, 1), b2 + hstepB, voffB); PG8_STAGE(PG8_SA(0, 0), a2, voA[0]);
            PG8_WAIT_V(8); PG8_WAIT_L(0); PG8_BAR; PG8_MMA(1, 0, At, B0); PG8_MMA(1, 1, At, B1); PG8_BAR; PG8_SCHED;
            PG8_LDB(B0, 1, 0); PG8_LDB(B1, 1, 1); PG8_SCHED; PG8_LDA(At, 1, 0); PG8_STAGE(PG8_SA(0, 1), a2, voA[1]);
            PG8_WAIT_V(8); PG8_WAIT_L(0); PG8_BAR; PG8_MMA(0, 0, At, B0); PG8_MMA(0, 1, At, B1); PG8_BAR; PG8_SCHED;
            PG8_LDA(At, 1, 1); PG8_STAGE(PG8_SB(1, 0), b3, voffB); PG8_STAGE(PG8_SB(1, 1), b3 + hstepB, voffB); PG8_STAGE(PG8_SA(1, 0), a3, voA[0]);
            PG8_WAIT_V(8); PG8_WAIT_L(0); PG8_BAR; PG8_MMA(1, 0, At, B0); PG8_MMA(1, 1, At, B1); PG8_BAR; PG8_SCHED;
        }
        if (wr == 0) PG8_BAR;
        E(acc, cur, wr, wc, fr, fq);
        if constexpr (HOOKS) S.done(cur);
        if (!has_next) break;
#pragma unroll
        for (int a = 0; a < 2; ++a)
#pragma unroll
            for (int b = 0; b < 2; ++b)
#pragma unroll
                for (int m = 0; m < 4; ++m)
#pragma unroll
                    for (int n = 0; n < 2; ++n) acc[a][b][m][n] = (f32x4){0.f, 0.f, 0.f, 0.f};
        cur = nxt; cA = nA; cB = nB; ++ui;
        if (wr == 1) PG8_BAR;
    }
    PG8_WAIT_V(0);
    PG8_BAR;
#undef PG8_GROWS
#undef PG8_GOFFS
#undef PG8_SA
#undef PG8_SB
#undef PG8_STAGE
#undef PG8_LDA
#undef PG8_LDB
#undef PG8_MMA
#undef PG8_WAIT_V
#undef PG8_WAIT_L
#undef PG8_BAR
#undef PG8_SCHED
}
}

struct OrdStd {
    const GAS char* A; const GAS char* B; size_t a_tile, b_tile, b_batch; int nM, nN, G, c;
    __device__ __forceinline__ bool next(int i, pg8::Unit& u) const {
        const long L = (long)i * G + c; if (L >= (long)nM * nN) return false;
        pg8::static_map((int)L, nM, nN, u.pm, u.pn); u.z = 0; return true; }
    __device__ __forceinline__ const GAS char* a_ptr(const pg8::Unit& u) const { return A + (size_t)u.pm * a_tile; }
    __device__ __forceinline__ const GAS char* b_ptr(const pg8::Unit& u) const { return B + (size_t)(u.pm >> 5) * b_batch + (size_t)u.pn * b_tile; }
};
struct OrdInProj {
    const GAS char* A; const GAS char* B; size_t tile; int nM, nN, G, c;
    __device__ __forceinline__ bool next(int i, pg8::Unit& u) const {
        const long L = (long)i * G + c; if (L >= (long)nM * nN) return false;
        pg8::static_map((int)L, nM, nN, u.pm, u.pn); u.z = 0; return true; }
    __device__ __forceinline__ const GAS char* a_ptr(const pg8::Unit& u) const { return u.pn == 2 ? B + (size_t)u.pn * tile : A + (size_t)u.pm * tile; }
    __device__ __forceinline__ const GAS char* b_ptr(const pg8::Unit& u) const { return u.pn == 2 ? A + (size_t)u.pm * tile : B + (size_t)u.pn * tile; }
};
struct OrdKV {
    const GAS char* memn; const GAS char* wkv; int G, c;
    __device__ __forceinline__ bool next(int i, pg8::Unit& u) const { const int L = i * G + c; if (L >= 64) return false; u.pm = L >> 3; u.pn = L & 7; u.z = 0; return true; }
    __device__ __forceinline__ const GAS char* a_ptr(const pg8::Unit& u) const { return memn + (size_t)u.pm * 256 * 1024 * 2; }
    __device__ __forceinline__ const GAS char* b_ptr(const pg8::Unit& u) const { return wkv + ((size_t)(u.pm >> 2) * 2048 + (size_t)u.pn * 256) * 1024 * 2; }
};
struct OrdKq {
    const GAS char* kv; const GAS char* wqb; int G, c;
    __device__ __forceinline__ bool next(int i, pg8::Unit& u) const { const int L = i * G + c; if (L >= 128) return false;
        const int l = L >> 6, b = (L >> 4) & 3, h = (L >> 2) & 3, q = L & 3; u.pm = (l * 4 + b) * 4 + h; u.pn = q; u.z = L; return true; }
    __device__ __forceinline__ const GAS char* a_ptr(const pg8::Unit& u) const { const int L = u.z, l = L >> 6, b = (L >> 4) & 3, h = (L >> 2) & 3;
        return kv + (((size_t)l * 1024 + b * 256) * 2048 + h * 256) * 2; }
    __device__ __forceinline__ const GAS char* b_ptr(const pg8::Unit& u) const { const int L = u.z, l = L >> 6, h = (L >> 2) & 3, q = L & 3;
        return wqb + ((size_t)l * 1048576 + (size_t)q * 256 * 1024 + h * 256) * 2; }
};
struct OrdVo {
    const GAS char* kv; const GAS char* wot; int G, c;
    __device__ __forceinline__ bool next(int i, pg8::Unit& u) const { const int L = i * G + c; if (L >= 128) return false;
        const int l = L >> 6, b = (L >> 4) & 3, h = (L >> 2) & 3, q = L & 3; u.pm = (l * 4 + b) * 4 + q; u.pn = h; u.z = L; return true; }
    __device__ __forceinline__ const GAS char* a_ptr(const pg8::Unit& u) const { const int L = u.z, l = L >> 6, h = (L >> 2) & 3, q = L & 3;
        return wot + ((size_t)l * 1048576 + (size_t)q * 256 * 1024 + h * 256) * 2; }
    __device__ __forceinline__ const GAS char* b_ptr(const pg8::Unit& u) const { const int L = u.z, l = L >> 6, b = (L >> 4) & 3, h = (L >> 2) & 3;
        return kv + (((size_t)l * 1024 + b * 256) * 2048 + 1024 + h * 256) * 2; }
};
struct OrdMoE {
    const GAS char* A; const GAS char* B; size_t a_tile, b_exp, b_tile; int nunits; const LAS int* pad_end; int G, c; const GAS int* rowtab; GAS unsigned* pan; int bal;
    __device__ __forceinline__ bool next(int i, pg8::Unit& u) const {
        long L = (long)i * G + c;
        if (bal) {
            const int fr = nunits / G, rem = nunits - fr * G;
            if (i == fr - 1) { if (c >= G - rem) return false; }
            else if (i == fr) { if (c >= 2 * rem) return false; L = (long)fr * G - rem + c; }
            else if (i > fr) return false;
        }
        if (L >= nunits) return false;
        u.pm = (int)(L >> 2); u.pn = (int)(L & 3); int e = 0; const int r0 = u.pm * 256;
        const LAS int* pe = pad_end; asm volatile("" : "+v"(pe));
        for (int j = 0; j < NEXP; ++j) e += (pe[j] <= r0) ? 1 : 0;
        e = __builtin_amdgcn_readfirstlane(e);
        u.z = e < NEXP ? e : NEXP - 1; return true; }
    __device__ __forceinline__ const GAS char* a_ptr(const pg8::Unit& u) const { return A + (size_t)u.pm * a_tile; }
    __device__ __forceinline__ const GAS char* b_ptr(const pg8::Unit& u) const { return B + (size_t)u.z * b_exp + (size_t)u.pn * b_tile; }
    __device__ __forceinline__ int row_of(const pg8::Unit& u, int r) const { return rowtab[u.pm * 256 + r]; }
    __device__ __forceinline__ void done(const pg8::Unit& u) const {
        if (rowtab == nullptr) return;
        asm volatile("s_waitcnt vmcnt(0)" ::: "memory");
        if (lane_now() == 0) __hip_atomic_fetch_add(pan + 16 * u.pm, 1u, __ATOMIC_RELAXED, __HIP_MEMORY_SCOPE_AGENT);
    }
    __device__ __forceinline__ void a_ready(const pg8::Unit& u, int wid) const {
        if (rowtab != nullptr) return;
        if (wid == 0) { GAS unsigned* p = pan + 16 * u.pm; unsigned sp = 0;
            while (xb_ld(p) < 32u) { __builtin_amdgcn_s_sleep(1); if (++sp > XB_SPIN_CAP) break; }
            __builtin_amdgcn_fence(__ATOMIC_ACQUIRE, "agent"); asm volatile("s_waitcnt vmcnt(0)" ::: "memory"); }
        asm volatile("" ::: "memory"); __builtin_amdgcn_s_barrier(); asm volatile("" ::: "memory");
    }
};

typedef const f32x4 (&AccRef)[2][2][4][2];
__device__ __forceinline__ float row_rstd(const GAS float* ssq, int row) {
    const GAS f32x4* p = (const GAS f32x4*)(ssq + (size_t)row * 16);
    const f32x4 a = p[0], b = p[1], c = p[2], d = p[3];
    const float s = ((a.x + a.y) + (a.z + a.w)) + ((b.x + b.y) + (b.z + b.w)) + ((c.x + c.y) + (c.z + c.w)) + ((d.x + d.y) + (d.z + d.w));
    return rsqrtf(s * (1.0f / DM) + EPS);
}
__device__ __forceinline__ u32x4 pack8(f32x4 v0, f32x4 v1) {
    u32x4 w; w.x = pg8::cvt_pk_bf16(v0[0], v0[1]); w.y = pg8::cvt_pk_bf16(v0[2], v0[3]); w.z = pg8::cvt_pk_bf16(v1[0], v1[1]); w.w = pg8::cvt_pk_bf16(v1[2], v1[3]); return w; }

struct EpiBf {
    static constexpr bool PERM = true; GAS bf16_t* O; int ldc;
    __device__ __forceinline__ void operator()(AccRef acc, const pg8::Unit& u, int wr, int wc, int fr, int fq) const {
        { const int _l = lane_now(); fr = _l & 15; fq = _l >> 4; }
        const int row0 = u.pm * 256 + wr * 64 + fr, col0 = u.pn * 256 + wc * 32 + 8 * fq;
#pragma unroll
        for (int ai = 0; ai < 2; ++ai)
#pragma unroll
            for (int m = 0; m < 4; ++m) { asm volatile("" ::: "memory"); GAS bf16_t* rowp = O + (size_t)(row0 + ai * 128 + m * 16) * ldc + col0;
#pragma unroll
                for (int bj = 0; bj < 2; ++bj) *(GAS u32x4*)(rowp + bj * 128) = pack8(acc[ai][bj][m][0], acc[ai][bj][m][1]); }
    }
};
struct EpiProj {
    static constexpr bool PERM = true; GAS bf16_t* proj; GAS float* ab; const GAS float* ssq; GAS bf16_t* vta;
    __device__ __forceinline__ void operator()(AccRef acc, const pg8::Unit& u, int wr, int wc, int fr, int fq) const {
        { const int _l = lane_now(); fr = _l & 15; fq = _l >> 4; }
        if (u.pn == 2) {
            const int tok0 = u.pm * 256 + wc * 32 + 8 * fq;
#pragma unroll
            for (int bj = 0; bj < 2; ++bj) { float rs[8];
#pragma unroll
                for (int e = 0; e < 8; ++e) rs[e] = ssq[tok0 + bj * 128 + e];
                const int tk = tok0 + bj * 128; GAS bf16_t* vb = vta + ((size_t)(tk >> 6) * 128 + ((tk & 63) >> 3)) * 128 + fr * 8;
#pragma unroll
                for (int ai = 0; ai < 2; ++ai)
#pragma unroll
                    for (int m = 0; m < 4; ++m) { const f32x4 a0 = acc[ai][bj][m][0], a1 = acc[ai][bj][m][1];
                        const f32x4 s0 = (f32x4){a0[0] * rs[0], a0[1] * rs[1], a0[2] * rs[2], a0[3] * rs[3]}, s1 = (f32x4){a1[0] * rs[4], a1[1] * rs[5], a1[2] * rs[6], a1[3] * rs[7]};
                        *(GAS u32x4*)(vb + (size_t)(((2 * ai + wr) * 4 + m) * 8) * 128) = pack8(s0, s1); } }
            return; }
        const int row0 = u.pm * 256 + wr * 64 + fr;
        float rsv[2][4];
#pragma unroll
        for (int ai = 0; ai < 2; ++ai)
#pragma unroll
            for (int m = 0; m < 4; ++m) rsv[ai][m] = ssq[row0 + ai * 128 + m * 16];
#pragma unroll
        for (int ai = 0; ai < 2; ++ai)
#pragma unroll
            for (int m = 0; m < 4; ++m) { asm volatile("" ::: "memory"); const int row = row0 + ai * 128 + m * 16; const float rs = rsv[ai][m];
                const bool blk = (0xdb >> u.pn) & 1;
                GAS bf16_t* rowp = blk ? proj + ((size_t)u.pn * NTOK + (row & ~15)) * 256 + (wc * 4 + fq) * 128 + (row & 15) * 8
                                              : proj + ((size_t)u.pn * NTOK + row) * 256 + wc * 32 + 8 * fq;
                const int bjs = blk ? 16 * 128 : 128;
#pragma unroll
                for (int bj = 0; bj < 2; ++bj) *(GAS u32x4*)(rowp + bj * bjs) = pack8(acc[ai][bj][m][0] * rs, acc[ai][bj][m][1] * rs);
            }
    }
};
struct EpiResid {
    static constexpr bool PERM = true; GAS bf16_t* xb; GAS float* ssq;
    __device__ __forceinline__ void operator()(AccRef acc, const pg8::Unit& u, int wr, int wc, int fr, int fq) const {
        { const int _l = lane_now(); fr = _l & 15; fq = _l >> 4; }
        const int row0 = u.pm * 256 + wr * 64 + fr, col0 = u.pn * 256 + wc * 32 + 8 * fq;
#pragma unroll
        for (int ai = 0; ai < 2; ++ai) { asm volatile("" ::: "memory");
            u32x4 xo[4][2];
#pragma unroll
            for (int m = 0; m < 4; ++m)
#pragma unroll
                for (int bj = 0; bj < 2; ++bj) xo[m][bj] = *(const GAS u32x4*)(xb + (size_t)(row0 + ai * 128 + m * 16) * DM + col0 + bj * 128);
#pragma unroll
            for (int m = 0; m < 4; ++m) { const int row = row0 + ai * 128 + m * 16; float s = 0.f;
#pragma unroll
                for (int bj = 0; bj < 2; ++bj) { const size_t o = (size_t)row * DM + col0 + bj * 128; const u32x4 x = xo[m][bj];
                    const f32x4 v0 = acc[ai][bj][m][0] + (f32x4){bflo(x.x), bfhi(x.x), bflo(x.y), bfhi(x.y)}, v1 = acc[ai][bj][m][1] + (f32x4){bflo(x.z), bfhi(x.z), bflo(x.w), bfhi(x.w)};
                    const u32x4 w = pack8(v0, v1); *(GAS u32x4*)(xb + o) = w;
                    const float r0 = bflo(w.x), r1 = bfhi(w.x), r2 = bflo(w.y), r3 = bfhi(w.y), r4 = bflo(w.z), r5 = bfhi(w.z), r6 = bflo(w.w), r7 = bfhi(w.w);
                    s += (r0 * r0 + r1 * r1) + (r2 * r2 + r3 * r3) + (r4 * r4 + r5 * r5) + (r6 * r6 + r7 * r7); }
                s += shfl_xor_f(s, 16); s += shfl_xor_f(s, 32);
                if (fq == 0) ssq[(size_t)row * 16 + u.pn * 4 + wc] = s; } }
    }
};
struct EpiSoftmax {
    static constexpr bool PERM = true; GAS bf16_t* P; const GAS float* ssq; LAS float* ex;
    __device__ __forceinline__ void operator()(AccRef acc, const pg8::Unit& u, int wr, int wc, int fr, int fq) const {
        { const int _l = lane_now(); fr = _l & 15; fq = _l >> 4; }
        const int rl0 = wr * 64 + fr, col0 = u.pn * 256 + wc * 32 + 8 * fq;
        LAS float* exm = ex; LAS float* exs = ex + 1024; LAS float* exr = ex + 2048 + 256;
#pragma unroll
        for (int ai = 0; ai < 2; ++ai)
#pragma unroll
            for (int m = 0; m < 4; ++m) { const int rl = rl0 + ai * 128 + m * 16;
                float mx = -3.0e38f;
#pragma unroll
                for (int bj = 0; bj < 2; ++bj)
#pragma unroll
                    for (int n = 0; n < 2; ++n) { const f32x4 v = acc[ai][bj][m][n]; mx = fmaxf(mx, fmaxf(fmaxf(v[0], v[1]), fmaxf(v[2], v[3]))); }
                mx = fmaxf(mx, shfl_xor_f(mx, 16)); mx = fmaxf(mx, shfl_xor_f(mx, 32));
                if (fq == 0) exm[rl * 4 + wc] = mx; }
        if (wr == 0) { const int rl = wc * 64 + fq * 16 + fr; exr[rl] = row_rstd(ssq, u.pm * 256 + rl); }
        asm volatile("s_waitcnt lgkmcnt(0)" ::: "memory"); __builtin_amdgcn_s_barrier(); asm volatile("" ::: "memory");
#pragma unroll
        for (int ai = 0; ai < 2; ++ai)
#pragma unroll
            for (int m = 0; m < 4; ++m) { asm volatile("" ::: "memory"); const int rl = rl0 + ai * 128 + m * 16; const f32x4 q = *(const LAS f32x4*)(exm + rl * 4); const float rs = exr[rl];
                const float mx = fmaxf(fmaxf(q[0], q[1]), fmaxf(q[2], q[3])) * rs; float s = 0.f;
#pragma unroll
                for (int bj = 0; bj < 2; ++bj)
#pragma unroll
                    for (int n = 0; n < 2; ++n) { const f32x4 v = acc[ai][bj][m][n] * rs - mx; s += (__expf(v[0]) + __expf(v[1])) + (__expf(v[2]) + __expf(v[3])); }
                s += shfl_xor_f(s, 16); s += shfl_xor_f(s, 32);
                if (fq == 0) exs[rl * 4 + wc] = s; }
        asm volatile("s_waitcnt lgkmcnt(0)" ::: "memory"); __builtin_amdgcn_s_barrier(); asm volatile("" ::: "memory");
#pragma unroll
        for (int ai = 0; ai < 2; ++ai)
#pragma unroll
            for (int m = 0; m < 4; ++m) { asm volatile("" ::: "memory"); const int rl = rl0 + ai * 128 + m * 16; const f32x4 q = *(const LAS f32x4*)(exs + rl * 4), qm = *(const LAS f32x4*)(exm + rl * 4);
                const float rs = exr[rl];
                const float inv = 1.0f / ((q[0] + q[1]) + (q[2] + q[3])); const float mx = fmaxf(fmaxf(qm[0], qm[1]), fmaxf(qm[2], qm[3])) * rs;
                GAS bf16_t* rowp = P + (size_t)(u.pm * 256 + (rl & ~15)) * DM + (col0 >> 3) * 128 + (rl & 15) * 8;
#pragma unroll
                for (int bj = 0; bj < 2; ++bj) { f32x4 v0 = acc[ai][bj][m][0] * rs - mx, v1 = acc[ai][bj][m][1] * rs - mx;
#pragma unroll
                    for (int j = 0; j < 4; ++j) { v0[j] = __expf(v0[j]) * inv; v1[j] = __expf(v1[j]) * inv; }
                    *(GAS u32x4*)(rowp + bj * 2048) = pack8(v0, v1); } }
        asm volatile("s_waitcnt lgkmcnt(0)" ::: "memory");
    }
};
struct EpiGateUp {
    static constexpr bool PERM = true; GAS bf16_t* hmid; const GAS float* slot_rstd;
    __device__ __forceinline__ void operator()(AccRef acc, const pg8::Unit& u, int wr, int wc, int fr, int fq) const {
        { const int _l = lane_now(); fr = _l & 15; fq = _l >> 4; }
        const int row0 = u.pm * 256 + wr * 64 + fr, col0 = u.pn * 128 + wc * 16 + 4 * fq;
        float rsv[2][4];
#pragma unroll
        for (int ai = 0; ai < 2; ++ai)
#pragma unroll
            for (int m = 0; m < 4; ++m) rsv[ai][m] = slot_rstd[row0 + ai * 128 + m * 16];
#pragma unroll
        for (int ai = 0; ai < 2; ++ai)
#pragma unroll
            for (int m = 0; m < 4; ++m) { const int row = row0 + ai * 128 + m * 16; const float rs = rsv[ai][m];
#pragma unroll
                for (int bj = 0; bj < 2; ++bj) { const f32x4 v0 = acc[ai][bj][m][0] * rs, v1 = acc[ai][bj][m][1] * rs;
                    u32x2 w; w.x = pg8::cvt_pk_bf16(silu_f(v0[0]) * v0[1], silu_f(v0[2]) * v0[3]); w.y = pg8::cvt_pk_bf16(silu_f(v1[0]) * v1[1], silu_f(v1[2]) * v1[3]);
                    __hip_atomic_store((GAS unsigned long long*)(hmid + (size_t)(row & ~15) * DEXP + ((col0 >> 3) + bj * 8) * 128 + (row & 15) * 8 + (col0 & 4)), (unsigned long long)w.x | ((unsigned long long)w.y << 32), __ATOMIC_RELAXED, __HIP_MEMORY_SCOPE_AGENT); } }
    }
};
struct EpiDown {
    static constexpr bool PERM = true; GAS bf16_t* Y; const GAS float* slot_w;
    __device__ __forceinline__ void operator()(AccRef acc, const pg8::Unit& u, int wr, int wc, int fr, int fq) const {
        { const int _l = lane_now(); fr = _l & 15; fq = _l >> 4; }
        const int row0 = u.pm * 256 + wr * 64 + fr, col0 = u.pn * 256 + wc * 32 + 8 * fq;
        float gwv[2][4];
#pragma unroll
        for (int ai = 0; ai < 2; ++ai)
#pragma unroll
            for (int m = 0; m < 4; ++m) gwv[ai][m] = slot_w[row0 + ai * 128 + m * 16];
#pragma unroll
        for (int ai = 0; ai < 2; ++ai)
#pragma unroll
            for (int m = 0; m < 4; ++m) { const int row = row0 + ai * 128 + m * 16; const float gw = gwv[ai][m]; GAS bf16_t* rowp = Y + (size_t)row * DM + col0;
#pragma unroll
                for (int bj = 0; bj < 2; ++bj) *(GAS u32x4*)(rowp + bj * 128) = pack8(acc[ai][bj][m][0] * gw, acc[ai][bj][m][1] * gw); }
    }
};

#define CAS __attribute__((address_space(4)))
#if defined(__HIP_DEVICE_COMPILE__)
#define ASSUME_GLOBAL(p) do { __builtin_assume(!__builtin_amdgcn_is_shared((const __attribute__((address_space(0))) GAS void*)(p))); __builtin_assume(!__builtin_amdgcn_is_private((const __attribute__((address_space(0))) GAS void*)(p))); } while (0)
#else
#define ASSUME_GLOBAL(p) do { } while (0)
#endif
struct Frame {
    LAS unsigned char* lds; int tid, lane, wave, G, gw, ngw;
    const CAS unsigned char* ka; GAS float* out; GAS unsigned char* ws;
    __device__ __forceinline__ const GAS float* inp(int i) const { const CAS unsigned char* p = ka; asm volatile("" : "+s"(p)); const GAS float* r = (const GAS float*)(((const float* const CAS*)p)[i]); return r; }
};
enum { I_X = 0, I_MEM, I_MIXG, I_WIN, I_RPB, I_RETG, I_POOLW, I_POOLS, I_CONVW, I_ALOG, I_DTB, I_GDNG, I_WOUT, I_MQG, I_MKVG, I_WQ, I_WK, I_WV, I_WO, I_FFNG, I_WGRP, I_BGRP, I_WRT, I_BRT, I_WGATE, I_WUP, I_WDOWN, I_FING };

__device__ __forceinline__ void tr_item(const GAS float* W, int ldw, int nvalid, const GAS float* gain, float scale, GAS bf16_t* WT, int ldt, int row_off, int row_mul,
                                        LAS float* scr, int kb, int nb, int lane) {
    const int k0 = 64 * kb, n0 = 32 * nb, n4 = (lane & 7) * 4, kr = lane >> 3;
    f32x4 v[8];
    const bool full = (n0 + n4 + 3 < nvalid);
#pragma unroll
    for (int i = 0; i < 8; ++i) { const int kk = 8 * i + kr; const GAS float* p = W + (size_t)(k0 + kk) * ldw + n0 + n4;
        if (full) v[i] = *(const GAS f32x4*)p;
        else { v[i] = (f32x4){0.f, 0.f, 0.f, 0.f};
#pragma unroll
            for (int j = 0; j < 4; ++j) if (n0 + n4 + j < nvalid) v[i][j] = p[j]; } }
#pragma unroll
    for (int i = 0; i < 8; ++i) { const int kk = 8 * i + kr; const float sc = gain ? gain[k0 + kk] * scale : scale;
#pragma unroll
        for (int j = 0; j < 4; ++j) scr[kk * 33 + n4 + j] = v[i][j] * sc; }
    LDS_WAIT(); asm volatile("" ::: "memory");
    const int c = lane & 7;
#pragma unroll
    for (int j = 0; j < 4; ++j) { const int n = (lane >> 3) + 8 * j; const LAS float* s = scr + (8 * c) * 33 + n;
        u32x4 o; o.x = pk2(s[0 * 33], s[1 * 33]); o.y = pk2(s[2 * 33], s[3 * 33]); o.z = pk2(s[4 * 33], s[5 * 33]); o.w = pk2(s[6 * 33], s[7 * 33]);
        *(GAS u32x4*)(WT + (size_t)(row_off + (n0 + n) * row_mul) * ldt + k0 + 8 * c) = o; }
    LDS_WAIT(); asm volatile("" ::: "memory");
}

__device__ __forceinline__ float row_to_bf16(const GAS float* xrow, GAS bf16_t* orow, const GAS float* gain, bool norm, int lane) {
    const GAS f32x4* xr = (const GAS f32x4*)xrow + lane;
    f32x4 v[4]; float s = 0.f;
#pragma unroll
    for (int j = 0; j < 4; ++j) { v[j] = xr[64 * j]; s += (v[j].x * v[j].x + v[j].y * v[j].y) + (v[j].z * v[j].z + v[j].w * v[j].w); }
    s = wave_sum(s);
    if (norm) { const float rs = rsqrtf(s * (1.0f / DM) + EPS);
#pragma unroll
        for (int j = 0; j < 4; ++j) { const f32x4 g = ((const GAS f32x4*)gain)[lane + 64 * j]; v[j] = v[j] * rs * g; } }
    GAS u32x2* o8 = (GAS u32x2*)orow + lane;
#pragma unroll
    for (int j = 0; j < 4; ++j) { u32x2 w; w.x = pk2(v[j].x, v[j].y); w.y = pk2(v[j].z, v[j].w); o8[64 * j] = w; }
    return s;
}

__device__ __forceinline__ void p0_prologue(Frame& F) {
    GAS unsigned char* ws = F.ws;
    LAS float* scr = (LAS float*)(F.lds + F.wave * 16384);
    constexpr int I_IN = 16 * 96, I_SQ = 16 * 32;
    constexpr int PER_L = I_IN + 4 * I_SQ;
    for (int it = F.gw; it < 2 * PER_L; it += F.ngw) {
        const int l = it / PER_L; int r = it % PER_L;
        if (r < I_IN) { tr_item(F.inp(I_WIN) + (size_t)l * DM * 3088, 3088, 3088, F.inp(I_MIXG) + l * DM, 1.f, (GAS bf16_t*)(ws + WS_WIN) + (size_t)l * PINP * DM, DM, 0, 1, scr, r / 96, r % 96, F.lane); continue; }
        r -= I_IN;
        if (r < I_SQ) { tr_item(F.inp(I_WOUT) + (size_t)l * DM * DM, DM, DM, nullptr, 1.f, (GAS bf16_t*)(ws + WS_WOUT) + (size_t)l * DM * DM, DM, 0, 1, scr, r / 32, r % 32, F.lane); continue; }
        r -= I_SQ;
        if (r < I_SQ) { tr_item(F.inp(I_WK) + (size_t)l * DM * DM, DM, DM, nullptr, 1.f, (GAS bf16_t*)(ws + WS_WKV) + (size_t)l * 2048 * DM, DM, 0, 1, scr, r / 32, r % 32, F.lane); continue; }
        r -= I_SQ;
        if (r < I_SQ) { tr_item(F.inp(I_WV) + (size_t)l * DM * DM, DM, DM, nullptr, 1.f, (GAS bf16_t*)(ws + WS_WKV) + (size_t)l * 2048 * DM, DM, 1024, 1, scr, r / 32, r % 32, F.lane); continue; }
        r -= I_SQ;
        tr_item(F.inp(I_WO) + (size_t)l * DM * DM, DM, DM, nullptr, 1.f, (GAS bf16_t*)(ws + WS_WOT) + (size_t)l * DM * DM, DM, 0, 1, scr, r / 32, r % 32, F.lane);
    }
    {   const GAS float* X = F.inp(I_X); GAS bf16_t* xbp = (GAS bf16_t*)(ws + WS_XB); GAS float* ssqp = (GAS float*)(ws + WS_SSQ);
        for (int m0 = F.gw * 4; m0 < NTOK; m0 += F.ngw * 4) {
            f32x4 v[4][4];
#pragma unroll
            for (int k = 0; k < 4; ++k)
#pragma unroll
                for (int j = 0; j < 4; ++j) v[k][j] = ((const GAS f32x4*)(X + (size_t)(m0 + k) * DM))[F.lane + 64 * j];
#pragma unroll
            for (int k = 0; k < 4; ++k) { float sq = 0.f; GAS u32x2* o8 = (GAS u32x2*)(xbp + (size_t)(m0 + k) * DM) + F.lane;
#pragma unroll
                for (int j = 0; j < 4; ++j) { sq += (v[k][j].x * v[k][j].x + v[k][j].y * v[k][j].y) + (v[k][j].z * v[k][j].z + v[k][j].w * v[k][j].w);
                    u32x2 w; w.x = pk2(v[k][j].x, v[k][j].y); w.y = pk2(v[k][j].z, v[k][j].w); o8[64 * j] = w; }
                sq = wave_sum(sq);
                if (F.lane < 16) ssqp[(size_t)(m0 + k) * 16 + F.lane] = (F.lane == 0) ? sq : 0.f;
                if (F.lane == 0) ((GAS float*)(ws + WS_TAB + TAB_RSTD))[m0 + k] = rsqrtf(sq * (1.0f / DM) + EPS); } }
        for (int r = F.gw; r < 2048; r += F.ngw) { const int l = r >> 10;
            row_to_bf16(F.inp(I_MEM) + (size_t)(r & 1023) * DM, (GAS bf16_t*)(ws + WS_MEMN) + (size_t)r * DM, F.inp(I_MKVG) + l * DM, true, F.lane); }
    }
    const size_t gt = (size_t)blockIdx.x * NTHREADS + F.tid, ngt = (size_t)F.G * NTHREADS;
    {
        GAS bf16_t* o = (GAS bf16_t*)(ws + WS_WQB);
        for (size_t i = gt; i < (size_t)2 * DM * DM / 4; i += ngt) { const size_t e = i * 4; const int l = (int)(e >> 20), k = (int)((e >> 10) & 1023);
            const f32x4 w = *(const GAS f32x4*)(F.inp(I_WQ) + e); const float g = F.inp(I_MQG)[l * DM + k] * 0.0625f;
            u32x2 p; p.x = pk2(w.x * g, w.y * g); p.y = pk2(w.z * g, w.w * g); *(GAS u32x2*)(o + e) = p; }
    }
    {
        GAS float* tab = (GAS float*)(ws + WS_TAB + TAB_ROPE);
        for (size_t i = gt; i < (size_t)SEQ * 32; i += ngt) { const int pos = (int)(i >> 5), j = (int)(i & 31);
            const float inv = exp2f(-(float)j * (13.287712379549449f / 32.0f)); const float ang = (float)pos * inv;
            const double rev = (double)ang * 0.15915494309189535; const float fr = (float)(rev - floor(rev));
            tab[i * 2] = __builtin_amdgcn_cosf(fr); tab[i * 2 + 1] = __builtin_amdgcn_sinf(fr); }
    }
    {
        GAS bf16_t* fr = (GAS bf16_t*)(ws + WS_TAB + TAB_RFR);
        for (size_t i = gt; i < (size_t)2 * 49152; i += ngt) { const int l = (int)(i / 49152), r = (int)(i % 49152), j = r & 7, ln = (r >> 3) & 63, ct = (r >> 9) % 3, ks = r / 1536;
            const int k = 32 * ks + 8 * (ln >> 4) + j, o = 16 * ct + (ln & 15);
            float w = 0.f; if (o < 32) w = F.inp(I_WRT)[(size_t)l * DM * 32 + (size_t)k * 32 + o]; else if (o < 36) w = F.inp(I_WGRP)[(size_t)l * DM * 4 + (size_t)k * 4 + (o - 32)];
            w *= F.inp(I_FFNG)[l * DM + k];
            const unsigned hi = f2bf(w); const float lo = w - __builtin_bit_cast(float, hi << 16);
            fr[(size_t)l * 98304 + r] = (bf16_t)hi; fr[(size_t)l * 98304 + 49152 + r] = (bf16_t)f2bf(lo); }
    }
    {
        GAS bf16_t* fr = (GAS bf16_t*)(ws + WS_TAB + TAB_ABF);
        for (size_t i = gt; i < (size_t)2 * 16384; i += ngt) { const int l = (int)(i >> 14), r = (int)(i & 16383), j = r & 7, ln = (r >> 3) & 63, ks = r >> 9;
            const int k = 32 * ks + 8 * (ln >> 4) + j, o = ln & 15;
            fr[i] = (bf16_t)f2bf(F.inp(I_WIN)[(size_t)l * DM * 3088 + (size_t)k * 3088 + 3072 + o] * F.inp(I_MIXG)[l * DM + k]); }
    }
    {
        GAS bf16_t* pt = (GAS bf16_t*)(ws + WS_TAB + TAB_POOL);
        for (size_t i = gt; i < (size_t)2 * 4 * 64 * 64; i += ngt) { const int c = (int)(i & 63), e = (int)((i >> 6) & 63), gi = (int)((i >> 12) & 3), l = (int)(i >> 14);
            pt[(i & ~(size_t)4095) + ((e >> 4) * 8 + (c >> 3)) * 128 + (e & 15) * 8 + (c & 7)] = (bf16_t)f2bf(F.inp(I_POOLW)[(((size_t)l * 4 + gi) * 64 + c) * 64 + e] * F.inp(I_POOLS)[l * 256 + gi * 64 + e]); }
    }
}

__device__ __forceinline__ void convert_experts_queue(Frame& F, int l) {
    GAS unsigned char* ws = F.ws;
    LAS float* scr = (LAS float*)(F.lds + F.wave * 16384);
    constexpr int IG = 16 * 16, ID = 8 * 32, PER_E = 2 * IG + ID;
    GAS unsigned* q = (GAS unsigned*)(ws + WS_CTL) + CW_CQ + l * 64;
    const GAS float* wg = F.inp(I_WGATE); const GAS float* wu = F.inp(I_WUP); const GAS float* wd = F.inp(I_WDOWN); const GAS float* gn = F.inp(I_FFNG) + l * DM;
    LAS unsigned* qs = (LAS unsigned*)(F.lds + LDS_MISC + 2048);
    for (;;) {
        __syncthreads();
        if (F.tid == 0) *qs = __hip_atomic_fetch_add(q, 64u, __ATOMIC_RELAXED, __HIP_MEMORY_SCOPE_AGENT);
        __syncthreads();
        const unsigned qb = *qs;
        if (qb >= (unsigned)(NEXP * PER_E)) break;
    for (int it = (int)qb + F.wave; it < (int)qb + 64 && it < NEXP * PER_E; it += NWAVES) {
        const int e = (int)it / PER_E; int r = (int)it % PER_E; const size_t le = (size_t)l * NEXP + e;
        if (r < IG) { tr_item(wg + le * DM * DEXP, DEXP, DEXP, gn, 1.f, (GAS bf16_t*)(ws + WS_WGU) + (size_t)e * 1024 * DM, DM, 0, 2, scr, r / 16, r % 16, F.lane); continue; }
        r -= IG;
        if (r < IG) { tr_item(wu + le * DM * DEXP, DEXP, DEXP, gn, 1.f, (GAS bf16_t*)(ws + WS_WGU) + (size_t)e * 1024 * DM, DM, 1, 2, scr, r / 16, r % 16, F.lane); continue; }
        r -= IG;
        tr_item(wd + le * DEXP * DM, DM, DM, nullptr, 1.f, (GAS bf16_t*)(ws + WS_WD) + (size_t)e * DM * DEXP, DEXP, 0, 1, scr, r / 32, r % 32, F.lane);
    }
    }
}

__device__ __forceinline__ size_t PJ(size_t t, int c) { return ((size_t)(c >> 8) * NTOK + t) * 256 + (c & 255); }
#define MFMA16(a, b, c) __builtin_amdgcn_mfma_f32_16x16x32_bf16((a), (b), (c), 0, 0, 0)

__device__ __forceinline__ void pool_item(Frame& F, const GAS bf16_t* proj, const GAS bf16_t* pt, GAS bf16_t* ycat, int item) {
    int lane = F.lane; asm volatile("" : "+v"(lane));
    const int g = lane >> 4, t = item * 16 + (lane & 15), s = t & (SEQ - 1);
    const GAS bf16_t* base = proj + ((size_t)7 * NTOK + (t - s)) * 256;
#pragma unroll
    for (int gi = 0; gi < 4; ++gi) {
        const int half = 1 << gi; const int lo = max(s - half, 0), hi = min(s + half, SEQ); const float inv = 1.0f / (float)(hi - lo);
        f32x4 acc[4];
#pragma unroll
        for (int et = 0; et < 4; ++et) acc[et] = (f32x4){0.f, 0.f, 0.f, 0.f};
        bf16x8 wf[8];
#pragma unroll
        for (int ks = 0; ks < 2; ++ks)
#pragma unroll
            for (int et = 0; et < 4; ++et) wf[ks * 4 + et] = *(const GAS bf16x8*)(pt + (size_t)gi * 4096 + (et * 8 + ks * 4 + g) * 128 + (lane & 15) * 8);
#pragma unroll
        for (int ks = 0; ks < 2; ++ks) {
            const int cb = (gi * 8 + ks * 4 + g) * 128;
            float sum[8];
#pragma unroll
            for (int j = 0; j < 8; ++j) sum[j] = 0.f;
#pragma unroll
            for (int w2 = 0; w2 < 2 * half; ++w2) { const int s2 = s - half + w2; const bool ok = (s2 >= 0) && (s2 < SEQ);
                u32x4 v = (u32x4){0u, 0u, 0u, 0u}; if (ok) v = *(const GAS u32x4*)((const GAS char*)base + (unsigned)((s2 & ~15) * 512 + cb * 2 + (s2 & 15) * 16));
                sum[0] += bflo(v.x); sum[1] += bfhi(v.x); sum[2] += bflo(v.y); sum[3] += bfhi(v.y); sum[4] += bflo(v.z); sum[5] += bfhi(v.z); sum[6] += bflo(v.w); sum[7] += bfhi(v.w); }
            const u32x4 c = *(const GAS u32x4*)((const GAS char*)base + (unsigned)((s & ~15) * 512 + cb * 2 + (s & 15) * 16));
            u32x4 dd; dd.x = pk2(sum[0] * inv - bflo(c.x), sum[1] * inv - bfhi(c.x)); dd.y = pk2(sum[2] * inv - bflo(c.y), sum[3] * inv - bfhi(c.y));
            dd.z = pk2(sum[4] * inv - bflo(c.z), sum[5] * inv - bfhi(c.z)); dd.w = pk2(sum[6] * inv - bflo(c.w), sum[7] * inv - bfhi(c.w));
            const bf16x8 bfrag = __builtin_bit_cast(bf16x8, dd);
            if (ks == 0) asm volatile("" : "+v"(wf[0]), "+v"(wf[1]), "+v"(wf[2]), "+v"(wf[3]), "+v"(wf[4]), "+v"(wf[5]), "+v"(wf[6]), "+v"(wf[7]));
#pragma unroll
            for (int et = 0; et < 4; ++et) acc[et] = MFMA16(wf[ks * 4 + et], bfrag, acc[et]);
        }
#pragma unroll
        for (int et = 0; et < 4; ++et) { u32x2 w; w.x = pk2(acc[et][0], acc[et][1]); w.y = pk2(acc[et][2], acc[et][3]);
            *(GAS u32x2*)(ycat + (size_t)t * DM + 512 + gi * 64 + et * 16 + g * 4) = w; }
    }
}

__device__ __forceinline__ void na_item(Frame& F, const GAS bf16_t* proj, const GAS bf16_t* vta, const LAS float* rpbs, GAS bf16_t* ycat, int item) {
    int lane = F.lane; asm volatile("" : "+v"(lane));
    const int g = lane >> 4, ql = lane & 15;
    const int n = item & 3, r = (item >> 2) & 127, h = (item >> 9) & 3, b = item >> 11; const size_t tb = (size_t)b * SEQ;
    const int kr0 = min(max(r - 4, 0), 120), band = min(max(n * 16 - 8, 0), 32), qc = n * 16 + ql, win = min(max(qc - 8, 0), 48);
    const GAS bf16_t* qrow = proj + (tb + r * 64 + n * 16) * 256 + (h * 8 + g) * 128 + ql * 8;
    const bf16x8 q0 = *(const GAS bf16x8*)qrow, q1 = *(const GAS bf16x8*)(qrow + 4 * 128);
    f32x4 S[16];
    const int kcl = band + 8 * (ql >> 2) + (ql & 3);
    bf16x8 kf[32];
#pragma unroll
    for (int t = 0; t < 16; ++t) { const int i = t >> 1, hf = t & 1; const int kc = kcl + 4 * hf;
        const GAS bf16_t* krow = proj + ((size_t)NTOK + tb + (size_t)(kr0 + i) * 64 + (kc & ~15)) * 256 + (h * 8 + g) * 128 + (kc & 15) * 8;
        kf[2 * t] = *(const GAS bf16x8*)krow; kf[2 * t + 1] = *(const GAS bf16x8*)(krow + 4 * 128); }
    asm volatile("" ::: "memory");
#pragma unroll
    for (int tb8 = 0; tb8 < 2; ++tb8) {
        if (tb8 == 0) asm volatile("" : "+v"(kf[0]), "+v"(kf[1]), "+v"(kf[2]), "+v"(kf[3]), "+v"(kf[4]), "+v"(kf[5]), "+v"(kf[6]), "+v"(kf[7]), "+v"(kf[8]), "+v"(kf[9]), "+v"(kf[10]), "+v"(kf[11]), "+v"(kf[12]), "+v"(kf[13]), "+v"(kf[14]), "+v"(kf[15]));
        else asm volatile("" : "+v"(kf[16]), "+v"(kf[17]), "+v"(kf[18]), "+v"(kf[19]), "+v"(kf[20]), "+v"(kf[21]), "+v"(kf[22]), "+v"(kf[23]), "+v"(kf[24]), "+v"(kf[25]), "+v"(kf[26]), "+v"(kf[27]), "+v"(kf[28]), "+v"(kf[29]), "+v"(kf[30]), "+v"(kf[31]));
#pragma unroll
        for (int tt = 0; tt < 8; ++tt) { const int t = tb8 * 8 + tt; f32x4 a = (f32x4){0.f, 0.f, 0.f, 0.f}; a = MFMA16(kf[2 * t], q0, a); a = MFMA16(kf[2 * t + 1], q1, a); S[t] = a; } }
    bf16x8 vl[32];
#pragma unroll
    for (int i = 0; i < 8; ++i) { const GAS bf16_t* vb = vta + ((((size_t)(b * 128 + kr0 + i) * 4 + h) * 4) * 8 + (band >> 3) + g) * 128 + ql * 8;
#pragma unroll
        for (int dt = 0; dt < 4; ++dt) vl[i * 4 + dt] = *(const GAS bf16x8*)(vb + (size_t)dt * 8 * 128); }
    asm volatile("" ::: "memory");
    float mx = -3.0e38f;
#pragma unroll
    for (int t = 0; t < 16; ++t) { const int i = t >> 1, hf = t & 1; const LAS float* rp = rpbs + h * 465 + (kr0 + i - r + 7) * 31;
#pragma unroll
        for (int jj = 0; jj < 4; ++jj) { const int kc = band + g * 8 + hf * 4 + jj; const bool ok = (kc >= win) && (kc < win + 16);
            const float sc = ok ? S[t][jj] * 0.125f + rp[ok ? kc - qc + 15 : 0] : -3.0e38f; S[t][jj] = sc; mx = fmaxf(mx, sc); } }
    mx = fmaxf(mx, shfl_xor_f(mx, 16)); mx = fmaxf(mx, shfl_xor_f(mx, 32));
    float sum = 0.f;
#pragma unroll
    for (int t = 0; t < 16; ++t)
#pragma unroll
        for (int jj = 0; jj < 4; ++jj) { const float p = __expf(S[t][jj] - mx); S[t][jj] = p; sum += p; }
    sum += shfl_xor_f(sum, 16); sum += shfl_xor_f(sum, 32);
    const float inv = 1.0f / sum;
    f32x4 O[4];
#pragma unroll
    for (int dt = 0; dt < 4; ++dt) O[dt] = (f32x4){0.f, 0.f, 0.f, 0.f};
#pragma unroll
    for (int vb4 = 0; vb4 < 2; ++vb4) {
        if (vb4 == 0) asm volatile("" : "+v"(vl[0]), "+v"(vl[1]), "+v"(vl[2]), "+v"(vl[3]), "+v"(vl[4]), "+v"(vl[5]), "+v"(vl[6]), "+v"(vl[7]), "+v"(vl[8]), "+v"(vl[9]), "+v"(vl[10]), "+v"(vl[11]), "+v"(vl[12]), "+v"(vl[13]), "+v"(vl[14]), "+v"(vl[15]));
        else asm volatile("" : "+v"(vl[16]), "+v"(vl[17]), "+v"(vl[18]), "+v"(vl[19]), "+v"(vl[20]), "+v"(vl[21]), "+v"(vl[22]), "+v"(vl[23]), "+v"(vl[24]), "+v"(vl[25]), "+v"(vl[26]), "+v"(vl[27]), "+v"(vl[28]), "+v"(vl[29]), "+v"(vl[30]), "+v"(vl[31]));
#pragma unroll
        for (int ii = 0; ii < 4; ++ii) { const int i = vb4 * 4 + ii;
            u32x4 pw; pw.x = pk2(S[2 * i][0], S[2 * i][1]); pw.y = pk2(S[2 * i][2], S[2 * i][3]); pw.z = pk2(S[2 * i + 1][0], S[2 * i + 1][1]); pw.w = pk2(S[2 * i + 1][2], S[2 * i + 1][3]);
            const bf16x8 pf = __builtin_bit_cast(bf16x8, pw);
#pragma unroll
            for (int dt = 0; dt < 4; ++dt) O[dt] = MFMA16(pf, vl[i * 4 + dt], O[dt]); } }
#pragma unroll
    for (int jj = 0; jj < 4; ++jj) { const float iq = shfl_f(inv, g * 4 + jj); GAS bf16_t* orow = ycat + (tb + r * 64 + n * 16 + g * 4 + jj) * DM + h * 64 + ql;
#pragma unroll
        for (int dt = 0; dt < 4; ++dt) orow[dt * 16] = (bf16_t)f2bf(O[dt][jj] * iq); }
}

constexpr int RT_LD = 136;
__device__ __forceinline__ void ret_r1_item(Frame& F, GAS bf16_t* proj, const GAS float* rope, GAS bf16_t* KVT, int item) {
    int tid = F.tid; asm volatile("" : "+v"(tid));
    const int lane = tid & 63, g = lane >> 4, ql = lane & 15;
    const int c = item & 63, h = (item >> 6) & 3, b = item >> 8;
    const float lgf = log2f(1.0f - exp2f(-5.0f - (float)h)), lgb = log2f(1.0f - exp2f(-5.0f - (float)(3 - h)));
    LAS bf16_t* KT = (LAS bf16_t*)F.lds; LAS bf16_t* VTF = KT + 64 * RT_LD; LAS bf16_t* VTB = VTF + 64 * RT_LD;
    {
        constexpr size_t TS = (size_t)NTOK * 256;
        const int i = (tid >> 6) * 16 + (tid & 15), p = (tid >> 4) & 3, s = c * 128 + i; const size_t t = (size_t)b * SEQ + s;
        GAS bf16_t* row = proj + ((size_t)3 * NTOK + (t & ~(size_t)15)) * 256 + (h * 8 + p) * 128 + (i & 15) * 8;
        const u32x4 q1 = *(const GAS u32x4*)(row), q2 = *(const GAS u32x4*)(row + 512), k1 = *(const GAS u32x4*)(row + TS), k2 = *(const GAS u32x4*)(row + TS + 512);
        const GAS f32x4* cs = (const GAS f32x4*)(rope + ((size_t)s * 32 + 8 * p) * 2);
        float qa[8], qb[8], ka[8], kb[8];
        qa[0] = bflo(q1.x); qa[1] = bfhi(q1.x); qa[2] = bflo(q1.y); qa[3] = bfhi(q1.y); qa[4] = bflo(q1.z); qa[5] = bfhi(q1.z); qa[6] = bflo(q1.w); qa[7] = bfhi(q1.w);
        qb[0] = bflo(q2.x); qb[1] = bfhi(q2.x); qb[2] = bflo(q2.y); qb[3] = bfhi(q2.y); qb[4] = bflo(q2.z); qb[5] = bfhi(q2.z); qb[6] = bflo(q2.w); qb[7] = bfhi(q2.w);
        ka[0] = bflo(k1.x); ka[1] = bfhi(k1.x); ka[2] = bflo(k1.y); ka[3] = bfhi(k1.y); ka[4] = bflo(k1.z); ka[5] = bfhi(k1.z); ka[6] = bflo(k1.w); ka[7] = bfhi(k1.w);
        kb[0] = bflo(k2.x); kb[1] = bfhi(k2.x); kb[2] = bflo(k2.y); kb[3] = bfhi(k2.y); kb[4] = bflo(k2.z); kb[5] = bfhi(k2.z); kb[6] = bflo(k2.w); kb[7] = bfhi(k2.w);
        float qo1[8], qo2[8], ko1[8], ko2[8];
#pragma unroll
        for (int m = 0; m < 4; ++m) { const f32x4 w = cs[m];
            { const int j = 2 * m; const float cc = w.x, sn = w.y; qo1[j] = qa[j] * cc - qb[j] * sn; qo2[j] = qa[j] * sn + qb[j] * cc; ko1[j] = (ka[j] * cc - kb[j] * sn) * 0.125f; ko2[j] = (ka[j] * sn + kb[j] * cc) * 0.125f; }
            { const int j = 2 * m + 1; const float cc = w.z, sn = w.w; qo1[j] = qa[j] * cc - qb[j] * sn; qo2[j] = qa[j] * sn + qb[j] * cc; ko1[j] = (ka[j] * cc - kb[j] * sn) * 0.125f; ko2[j] = (ka[j] * sn + kb[j] * cc) * 0.125f; } }
        u32x4 o;
        o.x = pk2(qo1[0], qo1[1]); o.y = pk2(qo1[2], qo1[3]); o.z = pk2(qo1[4], qo1[5]); o.w = pk2(qo1[6], qo1[7]); *(GAS u32x4*)(row) = o;
        o.x = pk2(qo2[0], qo2[1]); o.y = pk2(qo2[2], qo2[3]); o.z = pk2(qo2[4], qo2[5]); o.w = pk2(qo2[6], qo2[7]); *(GAS u32x4*)(row + 512) = o;
        u32x4 ok1, ok2;
        ok1.x = pk2(ko1[0], ko1[1]); ok1.y = pk2(ko1[2], ko1[3]); ok1.z = pk2(ko1[4], ko1[5]); ok1.w = pk2(ko1[6], ko1[7]); *(GAS u32x4*)(row + TS) = ok1;
        ok2.x = pk2(ko2[0], ko2[1]); ok2.y = pk2(ko2[2], ko2[3]); ok2.z = pk2(ko2[4], ko2[5]); ok2.w = pk2(ko2[6], ko2[7]); *(GAS u32x4*)(row + TS + 512) = ok2;
        const unsigned kw1[4] = {ok1.x, ok1.y, ok1.z, ok1.w}, kw2[4] = {ok2.x, ok2.y, ok2.z, ok2.w};
#pragma unroll
        for (int j = 0; j < 8; ++j) { KT[(8 * p + j) * RT_LD + i] = (bf16_t)((kw1[j >> 1] >> ((j & 1) * 16)) & 0xffffu); KT[(32 + 8 * p + j) * RT_LD + i] = (bf16_t)((kw2[j >> 1] >> ((j & 1) * 16)) & 0xffffu); }
    }
    {   const int i = tid >> 2, p = tid & 3; const GAS bf16_t* vrow = proj + PJ((size_t)b * SEQ + c * 128 + i, 1280 + h * 64 + 16 * p);
        const u32x4 va = *(const GAS u32x4*)(vrow), vb = *(const GAS u32x4*)(vrow + 8);
        const unsigned vw[8] = {va.x, va.y, va.z, va.w, vb.x, vb.y, vb.z, vb.w};
        const float wf = exp2f((float)(127 - i) * lgf), wb = exp2f((float)i * lgb);
#pragma unroll
        for (int j = 0; j < 16; ++j) { const float v = (j & 1) ? bfhi(vw[j >> 1]) : bflo(vw[j >> 1]);
            VTF[(16 * p + j) * RT_LD + i] = (bf16_t)f2bf(v * wf); VTB[(16 * p + j) * RT_LD + i] = (bf16_t)f2bf(v * wb); }
    }
    __syncthreads();
    {
        const int dir = F.wave >> 2, et = F.wave & 3; const LAS bf16_t* VT = dir ? VTB : VTF;
        f32x4 acc[4];
#pragma unroll
        for (int dt = 0; dt < 4; ++dt) acc[dt] = (f32x4){0.f, 0.f, 0.f, 0.f};
#pragma unroll
        for (int ks = 0; ks < 4; ++ks) { const bf16x8 a = *(const LAS bf16x8*)(VT + (et * 16 + ql) * RT_LD + ks * 32 + g * 8);
#pragma unroll
            for (int dt = 0; dt < 4; ++dt) { const bf16x8 bb = *(const LAS bf16x8*)(KT + (dt * 16 + ql) * RT_LD + ks * 32 + g * 8); acc[dt] = MFMA16(a, bb, acc[dt]); } }
        GAS bf16_t* out = KVT + ((size_t)item * 2 + dir) * 4096;
#pragma unroll
        for (int dt = 0; dt < 4; ++dt)
#pragma unroll
            for (int jj = 0; jj < 4; ++jj) out[et * 1024 + (dt * 2 + (ql >> 3)) * 128 + (g * 4 + jj) * 8 + (ql & 7)] = (bf16_t)f2bf(acc[dt][jj]);
    }
    __syncthreads();
}
__device__ __forceinline__ void ret_r2_scan(Frame& F, const GAS bf16_t* KVT, GAS bf16_t* ST, size_t gt, size_t ngt) {
    for (size_t idx = gt; idx < (size_t)32 * 4096; idx += ngt) {
        const int chain = (int)(idx >> 12), el = (int)(idx & 4095), bh = chain >> 1, dir = chain & 1, h = bh & 3, hh = dir ? 3 - h : h;
        const float gC = exp2f(128.0f * log2f(1.0f - exp2f(-5.0f - (float)hh)));
        float S = 0.f;
        const size_t o0 = ((size_t)(bh * 64) * 2 + dir) * 4096 + el;
#pragma unroll
        for (int half = 0; half < 4; ++half) { bf16_t kv[16];
#pragma unroll
            for (int cc = 0; cc < 16; ++cc) { const int c = dir ? 63 - (half * 16 + cc) : half * 16 + cc; kv[cc] = KVT[o0 + (size_t)c * 8192]; }
#pragma unroll
            for (int cc = 0; cc < 16; ++cc) { const int c = dir ? 63 - (half * 16 + cc) : half * 16 + cc; ST[o0 + (size_t)c * 8192] = (bf16_t)f2bf(S); S = S * gC + bf2f(kv[cc]); } }
    }
}
__device__ __forceinline__ void ret_r3_item(Frame& F, const GAS bf16_t* proj, const GAS bf16_t* ST, const GAS float* retg, GAS bf16_t* ycat, int item) {
    int tid = F.tid; asm volatile("" : "+v"(tid));
    const int lane = tid & 63, g = lane >> 4, ql = lane & 15;
    const int c = item & 63, h = (item >> 6) & 3, b = item >> 8;
    const float lgf = log2f(1.0f - exp2f(-5.0f - (float)h)), lgb = log2f(1.0f - exp2f(-5.0f - (float)(3 - h)));
    LAS bf16_t* VT = (LAS bf16_t*)F.lds;
    const size_t t0 = (size_t)b * SEQ + c * 128;
    {   const int i = tid >> 2, p = tid & 3; const GAS bf16_t* row = proj + PJ(t0 + i, 1280 + h * 64 + 16 * p);
        const u32x4 va = *(const GAS u32x4*)(row), vb = *(const GAS u32x4*)(row + 8);
        const unsigned vw[8] = {va.x, va.y, va.z, va.w, vb.x, vb.y, vb.z, vb.w};
#pragma unroll
        for (int j = 0; j < 16; ++j) VT[(16 * p + j) * RT_LD + i] = (bf16_t)((vw[j >> 1] >> ((j & 1) * 16)) & 0xffffu); }
    __syncthreads();
    {
        const int qi = F.wave * 16 + ql; const size_t tq = t0 + qi;
        const GAS bf16_t* qrow = proj + ((size_t)3 * NTOK + t0 + F.wave * 16) * 256 + (h * 8 + g) * 128 + ql * 8;
        bf16x8 qf[2]; qf[0] = *(const GAS bf16x8*)(qrow); qf[1] = *(const GAS bf16x8*)(qrow + 512);
        f32x4 st[8];
        {   bf16x8 kf[16];
#pragma unroll
            for (int kt = 0; kt < 8; ++kt) { const GAS bf16_t* krow = proj + ((size_t)4 * NTOK + t0 + kt * 16) * 256 + (h * 8 + g) * 128 + ql * 8; kf[2 * kt] = *(const GAS bf16x8*)(krow); kf[2 * kt + 1] = *(const GAS bf16x8*)(krow + 512); }
            asm volatile("" : "+v"(kf[0]), "+v"(kf[1]), "+v"(kf[2]), "+v"(kf[3]), "+v"(kf[4]), "+v"(kf[5]), "+v"(kf[6]), "+v"(kf[7]), "+v"(kf[8]), "+v"(kf[9]), "+v"(kf[10]), "+v"(kf[11]), "+v"(kf[12]), "+v"(kf[13]), "+v"(kf[14]), "+v"(kf[15]));
#pragma unroll
            for (int kt = 0; kt < 8; ++kt) { f32x4 a = (f32x4){0.f, 0.f, 0.f, 0.f}; a = MFMA16(kf[2 * kt], qf[0], a); a = MFMA16(kf[2 * kt + 1], qf[1], a);
#pragma unroll
                for (int jj = 0; jj < 4; ++jj) { const int df = qi - (kt * 16 + g * 4 + jj); a[jj] *= (df >= 0) ? exp2f((float)df * lgf) : exp2f((float)(-df) * lgb); }
                st[kt] = a; } }
        f32x4 oi[4], of[4], ob[4];
#pragma unroll
        for (int et = 0; et < 4; ++et) { oi[et] = (f32x4){0.f, 0.f, 0.f, 0.f}; of[et] = oi[et]; ob[et] = oi[et]; }
#pragma unroll
        for (int kp = 0; kp < 4; ++kp) { u32x4 pw; pw.x = pk2(st[2 * kp][0], st[2 * kp][1]); pw.y = pk2(st[2 * kp][2], st[2 * kp][3]); pw.z = pk2(st[2 * kp + 1][0], st[2 * kp + 1][1]); pw.w = pk2(st[2 * kp + 1][2], st[2 * kp + 1][3]);
            const bf16x8 pf = __builtin_bit_cast(bf16x8, pw);
#pragma unroll
            for (int et = 0; et < 4; ++et) { const LAS bf16_t* vr = VT + (et * 16 + ql) * RT_LD + kp * 32 + g * 4;
                const u32x2 lo = *(const LAS u32x2*)(vr), hi = *(const LAS u32x2*)(vr + 16); u32x4 aw; aw.x = lo.x; aw.y = lo.y; aw.z = hi.x; aw.w = hi.y;
                oi[et] = MFMA16(__builtin_bit_cast(bf16x8, aw), pf, oi[et]); } }
        const GAS bf16_t* sf = ST + ((size_t)item * 2) * 4096; const GAS bf16_t* sb = sf + 4096;
        {   bf16x8 sfr[8], sbr[8];
#pragma unroll
            for (int et = 0; et < 4; ++et)
#pragma unroll
                for (int ks = 0; ks < 2; ++ks) { const int o = et * 1024 + (ks * 4 + g) * 128 + ql * 8; sfr[et * 2 + ks] = *(const GAS bf16x8*)(sf + o); sbr[et * 2 + ks] = *(const GAS bf16x8*)(sb + o); }
            asm volatile("" : "+v"(sfr[0]), "+v"(sfr[1]), "+v"(sfr[2]), "+v"(sfr[3]), "+v"(sfr[4]), "+v"(sfr[5]), "+v"(sfr[6]), "+v"(sfr[7]), "+v"(sbr[0]), "+v"(sbr[1]), "+v"(sbr[2]), "+v"(sbr[3]), "+v"(sbr[4]), "+v"(sbr[5]), "+v"(sbr[6]), "+v"(sbr[7]));
#pragma unroll
            for (int et = 0; et < 4; ++et)
#pragma unroll
                for (int ks = 0; ks < 2; ++ks) { of[et] = MFMA16(sfr[et * 2 + ks], qf[ks], of[et]); ob[et] = MFMA16(sbr[et * 2 + ks], qf[ks], ob[et]); } }
        const float af = exp2f((float)(qi + 1) * lgf), abw = exp2f((float)(128 - qi) * lgb);
        float sum = 0.f;
#pragma unroll
        for (int et = 0; et < 4; ++et) { oi[et] = oi[et] + of[et] * af + ob[et] * abw; sum += (oi[et][0] + oi[et][1]) + (oi[et][2] + oi[et][3]); }
        sum += shfl_xor_f(sum, 16); sum += shfl_xor_f(sum, 32);
        const float mu = sum * (1.0f / 64.0f); float vs = 0.f;
#pragma unroll
        for (int et = 0; et < 4; ++et) { oi[et] = oi[et] - mu; vs += (oi[et][0] * oi[et][0] + oi[et][1] * oi[et][1]) + (oi[et][2] * oi[et][2] + oi[et][3] * oi[et][3]); }
        vs += shfl_xor_f(vs, 16); vs += shfl_xor_f(vs, 32);
        const float rs = rsqrtf(vs * (1.0f / 64.0f) + EPS);
#pragma unroll
        for (int et = 0; et < 4; ++et) { const int e = et * 16 + g * 4;
            const u32x2 gt = *(const GAS u32x2*)(proj + ((size_t)6 * NTOK + t0 + F.wave * 16) * 256 + (h * 8 + et * 2 + (g >> 1)) * 128 + ql * 8 + (g & 1) * 4); const f32x4 gn = *(const GAS f32x4*)(retg + h * 64 + e);
            u32x2 w; w.x = pk2(oi[et][0] * rs * gn[0] * silu_f(bflo(gt.x)), oi[et][1] * rs * gn[1] * silu_f(bfhi(gt.x)));
            w.y = pk2(oi[et][2] * rs * gn[2] * silu_f(bflo(gt.y)), oi[et][3] * rs * gn[3] * silu_f(bfhi(gt.y)));
            *(GAS u32x2*)(ycat + tq * DM + 256 + h * 64 + e) = w; }
    }
    __syncthreads();
}

constexpr int G_LD = 72;
constexpr int G_K = 0, G_Q = 9216, G_KST = 18432, G_ATT = 39168, G_LD4 = 57600, G_LZ = 65792, G_UT = 84224, G_RB1 = 125696, G_GC = 133888, G_BETA = 134400;
#define PRW(r) ((r) + ((r) >> 3))
constexpr size_t GOP_BYTES = 32768;
__device__ __forceinline__ int natidx(int dir, int i) { return dir ? 63 - i : i; }

constexpr int G_TI = G_RB1;
__device__ __forceinline__ void gdn_tinv(LAS unsigned char* lds, int tid) {
    const int dir = tid >> 6, blk = (tid >> 4) & 3, col = tid & 15;
    const LAS float* ld = (const LAS float*)(lds + G_LD4) + (dir * 4 + blk) * 256;
    float sol[16];
#pragma unroll
    for (int r = 0; r < 16; ++r) sol[r] = (r == col) ? 1.f : 0.f;
#pragma unroll
    for (int r = 1; r < 16; ++r) {
#pragma unroll
        for (int j4 = 0; j4 < (r + 3) / 4; ++j4) { const f32x4 lv = *(const LAS f32x4*)(ld + r * 16 + j4 * 4);
#pragma unroll
            for (int jj = 0; jj < 4; ++jj) if (j4 * 4 + jj < r) sol[r] -= lv[jj] * sol[j4 * 4 + jj]; } }
    LAS bf16_t* ti = (LAS bf16_t*)(lds + G_TI) + (dir * 4 + blk) * 256 + col;
#pragma unroll
    for (int r = 0; r < 16; ++r) ti[r * 16] = (bf16_t)f2bf(sol[r]);
}
template <int BLK>
__device__ __forceinline__ void gdn_solve_blk(const LAS bf16_t* lzb, const LAS bf16_t* tib, LAS bf16_t* utr, int g) {
    constexpr int NKS = (BLK * 16 + 31) / 32;
    f32x4 acc = (f32x4){0.f, 0.f, 0.f, 0.f};
#pragma unroll
    for (int ks = 0; ks < (BLK > 0 ? NKS : 0); ++ks) acc = MFMA16(*(const LAS bf16x8*)(lzb + BLK * 16 * G_LD + ks * 32), *(const LAS bf16x8*)(utr + ks * 32 + g * 8), acc);
    const u32x2 rw = *(const LAS u32x2*)(utr + BLK * 16 + g * 4);
    const u32x2 tw = *(const LAS u32x2*)(tib + BLK * 256);
    u32x4 bx; bx.x = pk2(bflo(rw.x) - acc[0], bfhi(rw.x) - acc[1]); bx.y = pk2(bflo(rw.y) - acc[2], bfhi(rw.y) - acc[3]); bx.z = 0u; bx.w = 0u;
    u32x4 at; at.x = tw.x; at.y = tw.y; at.z = 0u; at.w = 0u;
    const f32x4 so = MFMA16(__builtin_bit_cast(bf16x8, at), __builtin_bit_cast(bf16x8, bx), ((f32x4){0.f, 0.f, 0.f, 0.f}));
    u32x2 w; w.x = pk2(so[0], so[1]); w.y = pk2(so[2], so[3]);
    *(LAS u32x2*)(utr + BLK * 16 + g * 4) = w;
    asm volatile("" ::: "memory");
}
__device__ __forceinline__ void gdn_solve_wave(LAS unsigned char* lds, int wave, int lane) {
    const int dir = wave >> 2, q = wave & 3, g = lane >> 4, ql = lane & 15;
    const LAS bf16_t* lzb = (const LAS bf16_t*)(lds + G_LZ) + (dir * 64 + ql) * G_LD + g * 8;
    const LAS bf16_t* tib = (const LAS bf16_t*)(lds + G_TI) + dir * 4 * 256 + ql * 16 + g * 4;
#pragma unroll
    for (int cc = 0; cc < 2; ++cc) { const int ct = q * 2 + cc;
        LAS bf16_t* utr = (LAS bf16_t*)(lds + G_UT) + (dir * 144 + ct * 18 + PRW(ql)) * G_LD;
        gdn_solve_blk<0>(lzb, tib, utr, g); gdn_solve_blk<1>(lzb, tib, utr, g); gdn_solve_blk<2>(lzb, tib, utr, g); gdn_solve_blk<3>(lzb, tib, utr, g); }
}

__device__ __forceinline__ void gdn_g1_item(Frame& F, const GAS bf16_t* proj, const GAS float* ab, const GAS float* convw, const GAS float* alog, const GAS float* dtb, GAS unsigned char* gop, int item) {
    int tid = F.tid; asm volatile("" : "+v"(tid));
    const int lane = tid & 63, g = lane >> 4, ql = lane & 15, wave = F.wave;
    const int n = item & 127, h = (item >> 7) & 3, b = item >> 9; const size_t tb = (size_t)b * SEQ; const int s0 = n * 64;
    LAS bf16_t* Ks = (LAS bf16_t*)(F.lds + G_K); LAS bf16_t* Qs = (LAS bf16_t*)(F.lds + G_Q);
    LAS float* GC = (LAS float*)(F.lds + G_GC); LAS float* BETA = (LAS float*)(F.lds + G_BETA);
    u32x4 xin[4][3];
    {   const int i = tid >> 3, p = tid & 7, s = s0 + i;
#pragma unroll
        for (int tap = 0; tap < 4; ++tap) { const int s2 = s + tap - 2; const bool ok = (s2 >= 0 && s2 < SEQ);
#pragma unroll
            for (int part = 0; part < 3; ++part) { xin[tap][part] = (u32x4){0u, 0u, 0u, 0u}; if (ok) xin[tap][part] = *(const GAS u32x4*)(proj + PJ(tb + s2, 2048 + part * 256 + h * 64 + 8 * p)); } } }
    if (tid < 128) { const int dir = tid >> 6, i = tid & 63; const size_t t = tb + s0 + i;
        const float a = ab[t * 16 + dir * 4 + h], bb = ab[t * 16 + 8 + dir * 4 + h];
        float v = -__expf(alog[dir * 4 + h]) * softplus_f(a + dtb[dir * 4 + h]);
#pragma unroll
        for (int off = 1; off < 64; off <<= 1) { const int srcl = dir ? lane + off : lane - off;
            const float o = __builtin_bit_cast(float, __builtin_amdgcn_ds_bpermute((srcl & 63) << 2, __builtin_bit_cast(int, v))); if (srcl >= 0 && srcl < 64) v += o; }
        GC[dir * 64 + i] = v; BETA[dir * 64 + i] = sigmoid_f(bb); }
    {   const int i = tid >> 3, p = tid & 7;
        float u[3][8];
#pragma unroll
        for (int part = 0; part < 3; ++part)
#pragma unroll
            for (int j = 0; j < 8; ++j) u[part][j] = 0.f;
#pragma unroll
        for (int tap = 0; tap < 4; ++tap) {
#pragma unroll
            for (int part = 0; part < 3; ++part) { const u32x4 x = xin[tap][part];
                const GAS float* wp = convw + tap * 768 + part * 256 + h * 64 + 8 * p; const f32x4 w0 = *(const GAS f32x4*)wp, w1 = *(const GAS f32x4*)(wp + 4);
                u[part][0] += w0[0] * bflo(x.x); u[part][1] += w0[1] * bfhi(x.x); u[part][2] += w0[2] * bflo(x.y); u[part][3] += w0[3] * bfhi(x.y);
                u[part][4] += w1[0] * bflo(x.z); u[part][5] += w1[1] * bfhi(x.z); u[part][6] += w1[2] * bflo(x.w); u[part][7] += w1[3] * bfhi(x.w); } }
        float ssq[2] = {0.f, 0.f};
#pragma unroll
        for (int part = 0; part < 3; ++part)
#pragma unroll
            for (int j = 0; j < 8; ++j) { u[part][j] = silu_f(u[part][j]); if (part < 2) ssq[part] += u[part][j] * u[part][j]; }
#pragma unroll
        for (int part = 0; part < 2; ++part) { float q = ssq[part];
#pragma unroll
            for (int m = 1; m < 8; m <<= 1) q += __builtin_bit_cast(float, __builtin_amdgcn_ds_bpermute((lane ^ m) << 2, __builtin_bit_cast(int, q)));
            ssq[part] = rsqrtf(q + EPS); }
        const float qs = ssq[0] * 0.125f, ks = ssq[1];
        __syncthreads();
        u32x4 o;
        o.x = pk2(u[0][0] * qs, u[0][1] * qs); o.y = pk2(u[0][2] * qs, u[0][3] * qs); o.z = pk2(u[0][4] * qs, u[0][5] * qs); o.w = pk2(u[0][6] * qs, u[0][7] * qs); *(LAS u32x4*)(Qs + i * G_LD + 8 * p) = o;
        o.x = pk2(u[1][0] * ks, u[1][1] * ks); o.y = pk2(u[1][2] * ks, u[1][3] * ks); o.z = pk2(u[1][4] * ks, u[1][5] * ks); o.w = pk2(u[1][6] * ks, u[1][7] * ks); *(LAS u32x4*)(Ks + i * G_LD + 8 * p) = o;
#pragma unroll
        for (int dir = 0; dir < 2; ++dir) { const float gci = GC[dir * 64 + i], bi = BETA[dir * 64 + i];
            const float sc = ks * __expf(GC[dir * 64 + (dir ? 0 : 63)] - gci), sw = ks * bi * __expf(gci); const int ip = natidx(dir, i);
            LAS bf16_t* kst = (LAS bf16_t*)(F.lds + G_KST) + dir * 72 * G_LD; LAS bf16_t* ut = (LAS bf16_t*)(F.lds + G_UT) + dir * 144 * G_LD;
#pragma unroll
            for (int j = 0; j < 8; ++j) { kst[(9 * p + j) * G_LD + ip] = (bf16_t)f2bf(u[1][j] * sc); ut[(9 * p + j) * G_LD + ip] = (bf16_t)f2bf(u[2][j] * bi); ut[(72 + 9 * p + j) * G_LD + ip] = (bf16_t)f2bf(u[1][j] * sw); } }
    }
    __syncthreads();
    {   const int dir = wave >> 2, it = wave & 3;
        const LAS float* gc = GC + dir * 64; const LAS float* be = BETA + dir * 64;
        LAS float* Ld = (LAS float*)(F.lds + G_LD4) + (dir * 4 + it) * 256; LAS bf16_t* Lz = (LAS bf16_t*)(F.lds + G_LZ) + dir * 64 * G_LD; LAS bf16_t* At = (LAS bf16_t*)(F.lds + G_ATT) + dir * 64 * G_LD;
        const int ra = natidx(dir, it * 16 + ql);
        bf16x8 ka[2], qa[2];
#pragma unroll
        for (int ks = 0; ks < 2; ++ks) { ka[ks] = *(const LAS bf16x8*)(Ks + ra * G_LD + ks * 32 + g * 8); qa[ks] = *(const LAS bf16x8*)(Qs + ra * G_LD + ks * 32 + g * 8); }
#pragma unroll
        for (int jt = 0; jt < 4; ++jt) { const int rb = natidx(dir, jt * 16 + ql);
            f32x4 kk = (f32x4){0.f, 0.f, 0.f, 0.f}, qk = kk;
#pragma unroll
            for (int ks = 0; ks < 2; ++ks) { const bf16x8 kb = *(const LAS bf16x8*)(Ks + rb * G_LD + ks * 32 + g * 8); kk = MFMA16(ka[ks], kb, kk); qk = MFMA16(qa[ks], kb, qk); }
            const int jp = jt * 16 + ql; const float gj = gc[natidx(dir, jp)];
#pragma unroll
            for (int jj = 0; jj < 4; ++jj) { const int ip = it * 16 + g * 4 + jj, ni = natidx(dir, ip); const float dec = (ip >= jp) ? __expf(gc[ni] - gj) : 0.f;
                const float lval = (ip > jp) ? be[ni] * kk[jj] * dec : 0.f;
                if (jt == it) Ld[(g * 4 + jj) * 16 + ql] = lval;
                Lz[ip * G_LD + jp] = (bf16_t)((jt < it) ? f2bf(lval) : 0u);
                At[ip * G_LD + jp] = (bf16_t)f2bf(qk[jj] * dec); } }
    }
    __syncthreads();
    if (tid < 128) gdn_tinv(F.lds, tid);
    __syncthreads();
    gdn_solve_wave(F.lds, wave, lane);
    __syncthreads();
    {   const int dir = wave >> 2, prod = wave & 3;
        const LAS float* gc = GC + dir * 64;
        const LAS bf16_t* At = (const LAS bf16_t*)(F.lds + G_ATT) + dir * 64 * G_LD; const LAS bf16_t* kst = (const LAS bf16_t*)(F.lds + G_KST) + dir * 72 * G_LD;
        const LAS bf16_t* UT = (const LAS bf16_t*)(F.lds + G_UT) + dir * 144 * G_LD; const LAS bf16_t* WT = UT + 72 * G_LD;
        const int arow = PRW(ql), brow = (prod >= 2) ? PRW(ql) : ql, bstep = (prod >= 2) ? 18 : 16;
        GAS unsigned char* outp = gop + ((size_t)item * 2 + dir) * GOP_BYTES;
        const LAS bf16_t* Am = (prod == 0) ? UT : (prod == 3) ? kst : WT;
        const LAS bf16_t* Bm = (prod == 3) ? UT : (prod == 2) ? kst : At;
        f32x4 acc[4][4];
#pragma unroll
        for (int x = 0; x < 4; ++x)
#pragma unroll
            for (int y = 0; y < 4; ++y) acc[x][y] = (f32x4){0.f, 0.f, 0.f, 0.f};
#pragma unroll
        for (int ks = 0; ks < 2; ++ks) { bf16x8 bf[4];
#pragma unroll
            for (int y = 0; y < 4; ++y) bf[y] = *(const LAS bf16x8*)(Bm + (y * bstep + brow) * G_LD + ks * 32 + g * 8);
#pragma unroll
            for (int x = 0; x < 4; ++x) { const bf16x8 af = *(const LAS bf16x8*)(Am + (x * 18 + arow) * G_LD + ks * 32 + g * 8);
#pragma unroll
                for (int y = 0; y < 4; ++y) acc[x][y] = MFMA16(af, bf[y], acc[x][y]); } }
        if (prod == 0 || prod == 3) {
            GAS unsigned char* o = outp + (prod == 0 ? 16384 : 24576);
#pragma unroll
            for (int x = 0; x < 4; ++x)
#pragma unroll
                for (int y = 0; y < 4; ++y) { u32x2 w; w.x = pk2(acc[x][y][0], acc[x][y][1]); w.y = pk2(acc[x][y][2], acc[x][y][3]); *(GAS u32x2*)(o + ((size_t)(((prod == 0) ? (x * 4 + y) : (y * 4 + x)) * 64 + lane)) * 8) = w; }
        } else {
            const float a_last = __expf(gc[dir ? 0 : 63]);
#pragma unroll
            for (int y = 0; y < 4; ++y) { float val[4][4];
                const int col = y * 16 + ql;
#pragma unroll
                for (int x = 0; x < 4; ++x) {
                    if (prod == 1) { const int ni = natidx(dir, col); const float eg = __expf(gc[ni]); const u32x2 qv = *(const LAS u32x2*)(Qs + ni * G_LD + x * 16 + g * 4);
                        val[x][0] = bflo(qv.x) * eg - acc[x][y][0]; val[x][1] = bfhi(qv.x) * eg - acc[x][y][1]; val[x][2] = bflo(qv.y) * eg - acc[x][y][2]; val[x][3] = bfhi(qv.y) * eg - acc[x][y][3]; }
                    else {
#pragma unroll
                        for (int jj = 0; jj < 4; ++jj) val[x][jj] = ((x * 16 + g * 4 + jj == col) ? a_last : 0.f) - acc[x][y][jj]; } }
#pragma unroll
                for (int ks = 0; ks < 2; ++ks) { u32x4 w; w.x = pk2(val[2 * ks][0], val[2 * ks][1]); w.y = pk2(val[2 * ks][2], val[2 * ks][3]); w.z = pk2(val[2 * ks + 1][0], val[2 * ks + 1][1]); w.w = pk2(val[2 * ks + 1][2], val[2 * ks + 1][3]);
                    *(GAS u32x4*)(outp + (prod == 1 ? 0 : 8192) + ((size_t)((y * 2 + ks) * 64 + lane)) * 16) = w; } }
        }
    }
    __syncthreads();
}

constexpr int GS_SLOT = 20480, GS_NSLOT = 6;
struct GdnStage { u32x4 a[5]; };
__device__ __forceinline__ const GAS unsigned char* gdn_src_piece(const GAS unsigned char* src, int sl, int p) {
    const int off = p * 16;
    return src + (off < 16384 ? off : (off < 18432 ? off + sl * 2048 : 24576 + sl * 2048 + (off - 18432)));
}
__device__ __forceinline__ void gdn_ld_stage(GdnStage& R, const GAS unsigned char* src, int sl, int lw, int lane) {
#pragma unroll
    for (int j = 0; j < 5; ++j) R.a[j] = *(const GAS u32x4*)gdn_src_piece(src, sl, lw * 320 + j * 64 + lane);
}
__device__ __forceinline__ void gdn_st_stage(const GdnStage& R, LAS unsigned char* slot, int lw, int lane) {
#pragma unroll
    for (int j = 0; j < 5; ++j) *(LAS u32x4*)(slot + (lw * 320 + j * 64 + lane) * 16) = R.a[j];
}
__device__ __forceinline__ void gdn_compute(const LAS unsigned char* slot, f32x4 (&S)[4], GAS bf16_t* orow0, int dir, int ql, int lane) {
    bf16x8 qf[8]; u32x2 o0[4], b0[4];
#pragma unroll
    for (int i = 0; i < 8; ++i) qf[i] = *(const LAS bf16x8*)(slot + (i * 64 + lane) * 16);
#pragma unroll
    for (int x = 0; x < 4; ++x) { o0[x] = *(const LAS u32x2*)(slot + 16384 + (x * 64 + lane) * 8); b0[x] = *(const LAS u32x2*)(slot + 18432 + (x * 64 + lane) * 8); }
    bf16x8 sf[2];
#pragma unroll
    for (int ks = 0; ks < 2; ++ks) { u32x4 w; w.x = pk2(S[2 * ks][0], S[2 * ks][1]); w.y = pk2(S[2 * ks][2], S[2 * ks][3]); w.z = pk2(S[2 * ks + 1][0], S[2 * ks + 1][1]); w.w = pk2(S[2 * ks + 1][2], S[2 * ks + 1][3]); sf[ks] = __builtin_bit_cast(bf16x8, w); }
    asm volatile("s_waitcnt lgkmcnt(0)" : "+v"(qf[0]), "+v"(qf[1]), "+v"(qf[2]), "+v"(qf[3]), "+v"(qf[4]), "+v"(qf[5]), "+v"(qf[6]), "+v"(qf[7]), "+v"(o0[0]), "+v"(o0[1]), "+v"(o0[2]), "+v"(o0[3]), "+v"(b0[0]), "+v"(b0[1]), "+v"(b0[2]), "+v"(b0[3]));
    bf16x8 mf[8];
#pragma unroll
    for (int i = 0; i < 8; ++i) mf[i] = *(const LAS bf16x8*)(slot + 8192 + (i * 64 + lane) * 16);
#pragma unroll
    for (int x = 0; x < 4; ++x) { f32x4 o = (f32x4){bflo(o0[x].x), bfhi(o0[x].x), bflo(o0[x].y), bfhi(o0[x].y)};
        o = MFMA16(sf[0], qf[x * 2], o); o = MFMA16(sf[1], qf[x * 2 + 1], o);
        u32x2 w; w.x = pk2(o[0], o[1]); w.y = pk2(o[2], o[3]); *(GAS u32x2*)(orow0 + (size_t)natidx(dir, x * 16 + ql) * 256) = w; }
    asm volatile("s_waitcnt lgkmcnt(0)" : "+v"(mf[0]), "+v"(mf[1]), "+v"(mf[2]), "+v"(mf[3]), "+v"(mf[4]), "+v"(mf[5]), "+v"(mf[6]), "+v"(mf[7]));
#pragma unroll
    for (int x = 0; x < 4; ++x) { f32x4 n = (f32x4){bflo(b0[x].x), bfhi(b0[x].x), bflo(b0[x].y), bfhi(b0[x].y)};
        n = MFMA16(mf[x * 2], sf[0], n); n = MFMA16(mf[x * 2 + 1], sf[1], n); S[x] = n; }
}
__device__ __forceinline__ void gdn_scan_block(Frame& F, const GAS unsigned char* gop, GAS bf16_t* Og, int chain) {
    const int lane = F.lane, g = lane >> 4, ql = lane & 15, wave = F.wave, sl = chain & 3, dir = (chain >> 2) & 1, bh = chain >> 3, h = bh & 3, b = bh >> 2;
    const bool loader = (wave >= 1 && wave <= 4), comp = (wave == 0); const int lw = wave - 1;
    f32x4 S[4];
#pragma unroll
    for (int x = 0; x < 4; ++x) S[x] = (f32x4){0.f, 0.f, 0.f, 0.f};
    const GAS unsigned char* base = gop + ((size_t)bh * 128 * 2 + dir) * GOP_BYTES;
    GAS bf16_t* obase = Og + ((size_t)dir * NTOK + (size_t)b * SEQ) * 256 + h * 64 + sl * 16 + g * 4;
    LAS unsigned char* ring = F.lds;
#define GDN_BAR() do { asm volatile("s_waitcnt lgkmcnt(0)" ::: "memory"); __builtin_amdgcn_s_barrier(); asm volatile("" ::: "memory"); } while (0)
#define GDN_SRC(st) (base + (size_t)(dir ? 127 - (st) : (st)) * 2 * GOP_BYTES)
    if (loader) {
        GdnStage R0, R1, R2, R3;
        gdn_ld_stage(R0, GDN_SRC(0), sl, lw, lane); gdn_ld_stage(R1, GDN_SRC(1), sl, lw, lane); gdn_ld_stage(R2, GDN_SRC(2), sl, lw, lane); gdn_ld_stage(R3, GDN_SRC(3), sl, lw, lane);
        gdn_st_stage(R0, ring + 0 * GS_SLOT, lw, lane); gdn_st_stage(R1, ring + 1 * GS_SLOT, lw, lane); gdn_st_stage(R2, ring + 2 * GS_SLOT, lw, lane); gdn_st_stage(R3, ring + 3 * GS_SLOT, lw, lane);
        gdn_ld_stage(R0, GDN_SRC(4), sl, lw, lane); gdn_ld_stage(R1, GDN_SRC(5), sl, lw, lane); gdn_ld_stage(R2, GDN_SRC(6), sl, lw, lane); gdn_ld_stage(R3, GDN_SRC(7), sl, lw, lane);
        GDN_BAR();
        int sw = 4;
#define GDN_STEP(stv, RN) do { const int _st = (stv); gdn_st_stage(RN, ring + sw * GS_SLOT, lw, lane); gdn_ld_stage(RN, GDN_SRC(min(_st + 8, 127)), sl, lw, lane); \
        GDN_BAR(); sw = (sw == GS_NSLOT - 1) ? 0 : sw + 1; } while (0)
        GDN_STEP(0, R0); GDN_STEP(1, R1); GDN_STEP(2, R2); GDN_STEP(3, R3);
        for (int st = 4; st < 128; st += 4) { GDN_STEP(st, R0); GDN_STEP(st + 1, R1); GDN_STEP(st + 2, R2); GDN_STEP(st + 3, R3); }
    } else if (comp) {
        GDN_BAR();
        int s0 = 0;
        for (int st = 0; st < 128; ++st) { gdn_compute(ring + s0 * GS_SLOT, S, obase + (size_t)(dir ? 127 - st : st) * 64 * 256, dir, ql, lane); GDN_BAR(); s0 = (s0 == GS_NSLOT - 1) ? 0 : s0 + 1; }
    } else {
        GDN_BAR();
        for (int st = 0; st < 128; ++st) GDN_BAR();
    }
#undef GDN_STEP
#undef GDN_SRC
#undef GDN_BAR
}

__device__ __forceinline__ void gdn_finalize(Frame& F, const GAS bf16_t* proj, const GAS bf16_t* Og, const GAS float* gdng, GAS bf16_t* ycat, int gw, int ngw) {
    const int lane = F.lane, sub = lane >> 4, e4 = (lane & 15) * 4;
    const f32x4 gn = *(const GAS f32x4*)(gdng + e4);
    for (int base = gw * 16; base < NTOK * 4; base += ngw * 16) {
#pragma unroll
        for (int u = 0; u < 4; ++u) { const int pair = base + u * 4 + sub, t = pair >> 2, h = pair & 3; const size_t o = (size_t)t * 256 + h * 64 + e4;
            const u32x2 a = *(const GAS u32x2*)(Og + o), b = *(const GAS u32x2*)(Og + (size_t)NTOK * 256 + o), gt = *(const GAS u32x2*)(proj + PJ((size_t)t, 2816 + h * 64 + e4));
            const float x0 = bflo(a.x) + bflo(b.x), x1 = bfhi(a.x) + bfhi(b.x), x2 = bflo(a.y) + bflo(b.y), x3 = bfhi(a.y) + bfhi(b.y);
            float ms = (x0 * x0 + x1 * x1) + (x2 * x2 + x3 * x3);
            ms += shfl_xor_f(ms, 1); ms += shfl_xor_f(ms, 2); ms += shfl_xor_f(ms, 4); ms += shfl_xor_f(ms, 8);
            const float rs = rsqrtf(ms * (1.0f / 64.0f) + EPS);
            u32x2 w; w.x = pk2(x0 * rs * gn[0] * silu_f(bflo(gt.x)), x1 * rs * gn[1] * silu_f(bfhi(gt.x))); w.y = pk2(x2 * rs * gn[2] * silu_f(bflo(gt.y)), x3 * rs * gn[3] * silu_f(bfhi(gt.y)));
            *(GAS u32x2*)(ycat + (size_t)t * DM + 768 + h * 64 + e4) = w; }
    }
}

__device__ __forceinline__ void router_phase(Frame& F, int l) {
    GAS unsigned char* ws = F.ws; const int lane = F.lane, g = lane >> 4;
    const GAS bf16_t* X = (const GAS bf16_t*)(ws + WS_XB); const GAS float* ssq = (const GAS float*)(ws + WS_SSQ);
    const GAS bf16x8* fh = (const GAS bf16x8*)(ws + WS_TAB + TAB_RFR + (size_t)l * 196608); const GAS bf16x8* fl = fh + 6144;
    GAS int* toke = (GAS int*)(ws + WS_TAB + TAB_TOKE); GAS float* tokw = (GAS float*)(ws + WS_TAB + TAB_TOKW);
    LAS float* lg = (LAS float*)(F.lds + F.wave * 4096);
    LAS int* hist = (LAS int*)(F.lds + LDS_MISC + 256);
    if (F.tid < NEXP) hist[F.tid] = 0;
    __syncthreads();
    const GAS float* bg = F.inp(I_BGRP) + l * 4; const GAS float* br = F.inp(I_BRT) + l * 32;
    for (int tile = F.gw; tile < NTOK / 16; tile += F.ngw) {
        const int t0 = tile * 16; const GAS bf16_t* xr = X + (size_t)(t0 + (lane & 15)) * DM + g * 8;
        f32x4 acc[3];
#pragma unroll
        for (int ct = 0; ct < 3; ++ct) acc[ct] = (f32x4){0.f, 0.f, 0.f, 0.f};
#pragma unroll 1
        for (int kb = 0; kb < 8; ++kb) {
            bf16x8 xa[4]; bf16x8 wh[4][3], wl[4][3];
#pragma unroll
            for (int i = 0; i < 4; ++i) { const int ks = kb * 4 + i; xa[i] = *(const GAS bf16x8*)(xr + ks * 32);
#pragma unroll
                for (int ct = 0; ct < 3; ++ct) { wh[i][ct] = fh[(ks * 3 + ct) * 64 + lane]; wl[i][ct] = fl[(ks * 3 + ct) * 64 + lane]; } }
            asm volatile("" : "+v"(xa[0]), "+v"(xa[1]), "+v"(xa[2]), "+v"(xa[3]),
                              "+v"(wh[0][0]), "+v"(wh[0][1]), "+v"(wh[0][2]), "+v"(wh[1][0]), "+v"(wh[1][1]), "+v"(wh[1][2]), "+v"(wh[2][0]), "+v"(wh[2][1]), "+v"(wh[2][2]), "+v"(wh[3][0]), "+v"(wh[3][1]), "+v"(wh[3][2]));
#pragma unroll
            for (int i = 0; i < 4; ++i)
#pragma unroll
                for (int ct = 0; ct < 3; ++ct) { acc[ct] = MFMA16(wh[i][ct], xa[i], acc[ct]); acc[ct] = MFMA16(wl[i][ct], xa[i], acc[ct]); }
        }
#pragma unroll
        for (int ct = 0; ct < 3; ++ct)
#pragma unroll
            for (int j = 0; j < 4; ++j) lg[(lane & 15) * 48 + ct * 16 + g * 4 + j] = acc[ct][j];
        LDS_WAIT(); asm volatile("" ::: "memory");
        if (lane < 16) {
            const int t = t0 + lane; const float rs = row_rstd(ssq, t); const LAS float* L = lg + lane * 48;
            int gi = 0; float gm = L[32] * rs + bg[0];
            float gl[4]; gl[0] = gm;
#pragma unroll
            for (int j = 1; j < 4; ++j) { gl[j] = L[32 + j] * rs + bg[j]; if (gl[j] > gm) { gm = gl[j]; gi = j; } }
            float gs = 0.f;
#pragma unroll
            for (int j = 0; j < 4; ++j) gs += __expf(gl[j] - gm);
            const float gp = 1.0f / gs;
            int e1 = 0, e2 = 0; float l1 = -3.0e38f, l2 = -3.0e38f;
            for (int j = 0; j < 8; ++j) { const float v = L[gi * 8 + j] * rs + br[gi * 8 + j];
                if (v > l1) { l2 = l1; e2 = e1; l1 = v; e1 = j; } else if (v > l2) { l2 = v; e2 = j; } }
            const float p2 = __expf(l2 - l1), w1 = gp / (1.0f + p2), w2 = gp * p2 / (1.0f + p2);
            const int x1 = gi * 8 + e1, x2 = gi * 8 + e2;
            toke[t * 2] = x1; toke[t * 2 + 1] = x2; tokw[t * 2] = w1; tokw[t * 2 + 1] = w2;
            __hip_atomic_fetch_add(hist + x1, 1, __ATOMIC_RELAXED, __HIP_MEMORY_SCOPE_WORKGROUP); __hip_atomic_fetch_add(hist + x2, 1, __ATOMIC_RELAXED, __HIP_MEMORY_SCOPE_WORKGROUP);
        }
        LDS_WAIT(); asm volatile("" ::: "memory");
    }
    __syncthreads();
    if (F.tid < NEXP) __hip_atomic_fetch_add((GAS unsigned*)(ws + WS_CTL) + CW_CNT + l * 32 + F.tid, (unsigned)hist[F.tid], __ATOMIC_RELAXED, __HIP_MEMORY_SCOPE_AGENT);
}

__device__ __forceinline__ int moe_pad_table(Frame& F, int l, LAS int* pad_end) {
    if (F.tid == 0) { const GAS unsigned* cnt = (const GAS unsigned*)(F.ws + WS_CTL) + CW_CNT + l * 32; int acc = 0;
        for (int e = 0; e < NEXP; ++e) { const unsigned c = __hip_atomic_load(cnt + e, __ATOMIC_RELAXED, __HIP_MEMORY_SCOPE_AGENT); acc += (int)((c + 255u) & ~255u); pad_end[e] = acc; } }
    __syncthreads();
    return pad_end[NEXP - 1];
}

__device__ __forceinline__ void assign_gather_phase(Frame& F, int l) {
    GAS unsigned char* ws = F.ws;
    LAS int* pad_end = (LAS int*)(F.lds + LDS_MISC + 64);
    LAS int* lhist = (LAS int*)(F.lds + LDS_MISC + 256);
    LAS int* lbase = (LAS int*)(F.lds + LDS_MISC + 512);
    LAS int* aslot = (LAS int*)(F.lds);
    LAS int* atok = (LAS int*)(F.lds + 1024);
    moe_pad_table(F, l, pad_end);
    if ((int)blockIdx.x < NEXP) {
        const int e = blockIdx.x; const unsigned cnt = __hip_atomic_load((const GAS unsigned*)(ws + WS_CTL) + CW_CNT + l * 32 + e, __ATOMIC_RELAXED, __HIP_MEMORY_SCOPE_AGENT);
        const int p0 = (e ? pad_end[e - 1] : 0) + (int)cnt, p1 = pad_end[e];
        for (int sl = p0 + F.tid; sl < p1; sl += NTHREADS) { ((GAS int*)(ws + WS_SLOT + SL_TOK))[sl] = 0; ((GAS float*)(ws + WS_SLOT + SL_W))[sl] = 0.f; ((GAS float*)(ws + WS_SLOT + SL_RSTD))[sl] = 0.f; } }
    const GAS int* toke = (const GAS int*)(ws + WS_TAB + TAB_TOKE); const GAS float* tokw = (const GAS float*)(ws + WS_TAB + TAB_TOKW);
    GAS int* slot_tok = (GAS int*)(ws + WS_SLOT + SL_TOK); GAS float* slot_w = (GAS float*)(ws + WS_SLOT + SL_W); GAS float* slot_rstd = (GAS float*)(ws + WS_SLOT + SL_RSTD); GAS int* tok_slot = (GAS int*)(ws + WS_SLOT + SL_TSLOT);
    const GAS float* ssq = (const GAS float*)(ws + WS_SSQ);
    const GAS bf16_t* xb = (const GAS bf16_t*)(ws + WS_XB); GAS bf16_t* sa = (GAS bf16_t*)(ws + WS_SORTA);
    GAS unsigned* cur = (GAS unsigned*)(ws + WS_CTL) + CW_CUR + l * 32;
    for (int ch = blockIdx.x; ch < NTOK / 128; ch += F.G) {
        if (F.tid < NEXP) lhist[F.tid] = 0;
        __syncthreads();
        int e = 0, pos = 0, t = 0;
        if (F.tid < 256) { t = ch * 128 + (F.tid >> 1); e = toke[t * 2 + (F.tid & 1)]; pos = __hip_atomic_fetch_add(lhist + e, 1, __ATOMIC_RELAXED, __HIP_MEMORY_SCOPE_WORKGROUP); }
        __syncthreads();
        if (F.tid < NEXP) lbase[F.tid] = (int)__hip_atomic_fetch_add(cur + F.tid, (unsigned)lhist[F.tid], __ATOMIC_RELAXED, __HIP_MEMORY_SCOPE_AGENT);
        __syncthreads();
        if (F.tid < 256) { const int slot = (e ? pad_end[e - 1] : 0) + lbase[e] + pos;
            slot_tok[slot] = t; slot_w[slot] = tokw[t * 2 + (F.tid & 1)]; slot_rstd[slot] = row_rstd(ssq, t); tok_slot[t * 2 + (F.tid & 1)] = slot;
            aslot[F.tid] = slot; atok[F.tid] = t; }
        __syncthreads();
        __syncthreads();
    }
}

__device__ __forceinline__ void combine_phase(Frame& F, int l) {
    GAS unsigned char* ws = F.ws; const int lane = F.lane;
    const GAS int* tok_slot = (const GAS int*)(ws + WS_SLOT + SL_TSLOT); const GAS bf16_t* Y = (const GAS bf16_t*)(ws + WS_SORTA);
    GAS bf16_t* xb = (GAS bf16_t*)(ws + WS_XB); GAS float* ssq = (GAS float*)(ws + WS_SSQ);
    const GAS f32x4* fing = (const GAS f32x4*)F.inp(I_FING);
    for (int t0 = F.gw * 4; t0 < NTOK; t0 += F.ngw * 4) {
        int sl0[4], sl1[4];
#pragma unroll
        for (int k = 0; k < 4; ++k) { sl0[k] = tok_slot[(t0 + k) * 2]; sl1[k] = tok_slot[(t0 + k) * 2 + 1]; }
        f32x4 v[4][4]; u32x2 xa[4][4], ya[4][4], yb[4][4];
#pragma unroll
        for (int k = 0; k < 4; ++k) { const GAS u32x2* xr = (const GAS u32x2*)(xb + (size_t)(t0 + k) * DM) + lane;
            const GAS u32x2* y0 = (const GAS u32x2*)(Y + (size_t)sl0[k] * DM) + lane; const GAS u32x2* y1 = (const GAS u32x2*)(Y + (size_t)sl1[k] * DM) + lane;
#pragma unroll
            for (int j = 0; j < 4; ++j) { xa[k][j] = xr[64 * j]; ya[k][j] = y0[64 * j]; yb[k][j] = y1[64 * j]; } }
#pragma unroll
        for (int k = 0; k < 4; ++k) { const int t = t0 + k; float s = 0.f; u32x2 w[4];
#pragma unroll
            for (int j = 0; j < 4; ++j) { const u32x2 x = xa[k][j], a = ya[k][j], b = yb[k][j];
                v[k][j].x = bflo(x.x) + bflo(a.x) + bflo(b.x); v[k][j].y = bfhi(x.x) + bfhi(a.x) + bfhi(b.x); v[k][j].z = bflo(x.y) + bflo(a.y) + bflo(b.y); v[k][j].w = bfhi(x.y) + bfhi(a.y) + bfhi(b.y);
                if (l == DEPTH - 1) s += (v[k][j].x * v[k][j].x + v[k][j].y * v[k][j].y) + (v[k][j].z * v[k][j].z + v[k][j].w * v[k][j].w);
                else { w[j].x = pk2(v[k][j].x, v[k][j].y); w[j].y = pk2(v[k][j].z, v[k][j].w); const float r0 = bflo(w[j].x), r1 = bfhi(w[j].x), r2 = bflo(w[j].y), r3 = bfhi(w[j].y); s += (r0 * r0 + r1 * r1) + (r2 * r2 + r3 * r3); } }
            s = wave_sum(s);
            if (l == DEPTH - 1) { const float rs = rsqrtf(s * (1.0f / DM) + EPS); GAS f32x4* orow = (GAS f32x4*)(F.out + (size_t)t * DM) + lane;
#pragma unroll
                for (int j = 0; j < 4; ++j) orow[64 * j] = v[k][j] * rs * fing[lane + 64 * j];
            } else {
                GAS u32x2* o8 = (GAS u32x2*)(xb + (size_t)t * DM) + lane;
#pragma unroll
                for (int j = 0; j < 4; ++j) o8[64 * j] = w[j];
                if (lane < 16) ssq[(size_t)t * 16 + lane] = (lane == 0) ? s : 0.f;
                if (lane == 0) ((GAS float*)(ws + WS_TAB + TAB_RSTD))[t] = rsqrtf(s * (1.0f / DM) + EPS);
            } }
    }
}

__device__ __forceinline__ void ab_phase(Frame& F, int l) {
    const int lane = lane_now(), g = lane >> 4, ql = lane & 15;
    const GAS bf16_t* xb = (const GAS bf16_t*)(F.ws + WS_XB); const GAS float* ssq = (const GAS float*)(F.ws + WS_SSQ); GAS float* ab = (GAS float*)(F.ws + WS_AB);
    const GAS bf16x8* fr = (const GAS bf16x8*)(F.ws + WS_TAB + TAB_ABF) + (size_t)l * 2048;
    for (int tile = F.gw; tile < NTOK / 16; tile += F.ngw) {
        const int t = tile * 16 + ql; const GAS bf16_t* xr = xb + (size_t)t * DM + g * 8;
        f32x4 acc = (f32x4){0.f, 0.f, 0.f, 0.f};
#pragma unroll
        for (int kb = 0; kb < 2; ++kb) { bf16x8 a[16], x[16];
#pragma unroll
            for (int i = 0; i < 16; ++i) { a[i] = fr[(kb * 16 + i) * 64 + lane]; x[i] = *(const GAS bf16x8*)(xr + (kb * 16 + i) * 32); }
            asm volatile("" : "+v"(x[0]), "+v"(x[1]), "+v"(x[2]), "+v"(x[3]), "+v"(x[4]), "+v"(x[5]), "+v"(x[6]), "+v"(x[7]), "+v"(x[8]), "+v"(x[9]), "+v"(x[10]), "+v"(x[11]), "+v"(x[12]), "+v"(x[13]), "+v"(x[14]), "+v"(x[15]),
                              "+v"(a[0]), "+v"(a[2]), "+v"(a[4]), "+v"(a[6]), "+v"(a[8]), "+v"(a[10]), "+v"(a[12]), "+v"(a[14]));
#pragma unroll
            for (int i = 0; i < 16; ++i) acc = MFMA16(a[i], x[i], acc); }
        const float rs = ((const GAS float*)(F.ws + WS_TAB + TAB_RSTD))[t];
        *(GAS f32x4*)(ab + (size_t)t * 16 + g * 4) = acc * rs;
    }
}

constexpr int PH_PRO = 0, PH_KV = 1, PH_FOLD = 2, PH_L0 = 3, PPL = 12, NPH = PH_L0 + DEPTH * PPL;
enum { LP_INPROJ = 0, LP_MIX, LP_MIX2, LP_FIN, LP_OUTPROJ, LP_SCORES, LP_PV, LP_ROUTER, LP_ASSIGN, LP_GATEUP, LP_DOWN, LP_COMBINE };

struct Args { const float* in[28]; float* out; unsigned char* ws; int ph_lo, ph_hi, mode, pad; };

__global__ void __launch_bounds__(NTHREADS, 2) fwd_kernel(Args args) {
    extern __shared__ __attribute__((aligned(16))) unsigned char lds_raw[];
    Frame F;
    F.lds = (LAS unsigned char*)lds_raw;
    F.tid = threadIdx.x; F.lane = F.tid & 63; F.wave = __builtin_amdgcn_readfirstlane(F.tid >> 6);
    F.G = gridDim.x; F.gw = blockIdx.x * NWAVES + F.wave; F.ngw = F.G * NWAVES;
    F.ka = (const CAS unsigned char*)__builtin_amdgcn_kernarg_segment_ptr();
    F.out = (GAS float*)args.out; F.ws = (GAS unsigned char*)args.ws;
    GAS unsigned char* ws0 = (GAS unsigned char*)args.ws;
    for (int u = F.tid; u < (LDS_BYTES - LDS_MISC) / 4; u += NTHREADS) ((LAS unsigned*)(F.lds + LDS_MISC))[u] = 0u;
    __syncthreads();
    const int lo = args.ph_lo, hi = args.ph_hi;
    XcdBarrier bar; bar.bar = (GAS unsigned*)(ws0 + WS_CTL) + CW_BAR; bar.x = 0; bar.st = (volatile LAS unsigned*)(F.lds + LDS_MISC);
    if (hi - lo > 1) bar = xcd_barrier_post((GAS unsigned*)(ws0 + WS_CTL) + CW_BAR, (volatile LAS unsigned*)(F.lds + LDS_MISC), F.tid == 0);
#ifndef LPMASK
#define LPMASK 0xfff
#endif
#ifndef PMASK
#define PMASK 7
#endif
#define IN(k) (lo <= (k) && (k) < hi)
#define INP(k) (((PMASK >> (k)) & 1) && IN(k))
#define INL(k) (((LPMASK >> (k)) & 1) && IN(pb + (k)))
#define SEAM(k) do { if (IN(k) && IN((k) + 1)) { unsigned _z = 0u; asm volatile("" : "+v"(_z));   \
        xcd_barrier(bar, F.wave == 0 && __builtin_amdgcn_mbcnt_hi(~0u, __builtin_amdgcn_mbcnt_lo(~0u, _z)) == 0u); } } while (0)
#define PH_ENTER() int c_id; GAS unsigned char* ws; do { unsigned _z0 = 0u; asm volatile("" : "+v"(_z0)); int _t = F.wave * 64 + (int)__builtin_amdgcn_mbcnt_hi(~0u, __builtin_amdgcn_mbcnt_lo(~0u, _z0)); asm volatile("" : "+v"(_t)); F.tid = _t; F.lane = _t & 63; GAS unsigned char* _w = (GAS unsigned char*)args.ws; asm volatile("" : "+s"(_w)); F.ws = _w; ws = _w; \
        GAS float* _o = (GAS float*)args.out; asm volatile("" : "+s"(_o)); F.out = _o;     int _c = blockIdx.x; asm volatile("" : "+s"(_c)); c_id = _c; F.gw = _c * NWAVES + F.wave; } while (0)

    if (INP(PH_PRO)) { PH_ENTER(); (void)c_id; (void)ws; p0_prologue(F); }
    SEAM(PH_PRO);

    for (int l = 0; l < DEPTH; ++l) {
        const int pb = PH_L0 + l * PPL;
        if (INL(LP_INPROJ)) { PH_ENTER();
            OrdInProj S{(const GAS char*)(ws + WS_XB), (const GAS char*)(ws + WS_WIN) + (size_t)l * PINP * DM * 2, (size_t)256 * DM * 2, NTOK / 256, PINP / 256, F.G, c_id};
            EpiProj E{(GAS bf16_t*)(ws + WS_PROJ), (GAS float*)(ws + WS_AB), (const GAS float*)(ws + WS_TAB + TAB_RSTD), (GAS bf16_t*)(ws + WS_VTA)};
            pg8::gemm_phase<EpiProj, OrdInProj>(F.lds, F.tid, pg8::Gemm{DM, DM, DM}, S, E);
            ab_phase(F, l);
            if (l == 0) { PH_ENTER();
                OrdKV S{(const GAS char*)(ws + WS_MEMN), (const GAS char*)(ws + WS_WKV), F.G, c_id};
                EpiBf E{(GAS bf16_t*)(ws + WS_KV), 2048};
                pg8::gemm_phase<EpiBf, OrdKV>(F.lds, F.tid, pg8::Gemm{DM, DM, DM}, S, E); }
        }
        SEAM(pb + LP_INPROJ);
        if (INL(LP_MIX) && l == 0) {
            { PH_ENTER(); OrdKq S{(const GAS char*)(ws + WS_KV), (const GAS char*)(ws + WS_WQB), F.G, c_id}; EpiBf E{(GAS bf16_t*)(ws + WS_KQT), DM};
              int kf = 256; asm volatile("" : "+s"(kf)); pg8::gemm_phase<EpiBf, OrdKq>(F.lds, F.tid, pg8::Gemm{2048, DM, kf}, S, E); }
            { PH_ENTER(); OrdVo S{(const GAS char*)(ws + WS_KV), (const GAS char*)(ws + WS_WOT), F.G, (c_id + 128) % F.G}; EpiBf E{(GAS bf16_t*)(ws + WS_VOT), DM};
              int kf = 256; asm volatile("" : "+s"(kf)); pg8::gemm_phase<EpiBf, OrdVo>(F.lds, F.tid, pg8::Gemm{DM, 2048, kf}, S, E); }
        }
        if (INL(LP_MIX)) { PH_ENTER();
            GAS bf16_t* proj = (GAS bf16_t*)(ws + WS_PROJ); GAS bf16_t* ycat = (GAS bf16_t*)(ws + WS_YCAT);
            const GAS float* rope = (const GAS float*)(ws + WS_TAB + TAB_ROPE);
            if (args.mode != 2 && args.mode != 4) {   const GAS bf16_t* pt = (const GAS bf16_t*)(ws + WS_TAB + TAB_POOL) + (size_t)l * 4 * 64 * 64;
                const GAS float* rpb = F.inp(I_RPB) + (size_t)l * 4 * 15 * 31;
                LAS float* rpbs = (LAS float*)(F.lds);
                for (int i = F.tid; i < 4 * 465; i += NTHREADS) rpbs[i] = rpb[i];
                __syncthreads();
                const int gws = ((F.G & 7) == 0 ? (c_id & 7) * (F.G >> 3) + (c_id >> 3) : c_id) * NWAVES + F.wave;
                for (int it = gws; it < 8192 + NTOK / 16; it += F.ngw) {
                    if (it < 8192) { if (args.mode != 3) na_item(F, proj, (const GAS bf16_t*)(ws + WS_VTA), rpbs, ycat, it); } else if (args.mode != 1) pool_item(F, proj, pt, ycat, it - 8192);
                }
                __syncthreads(); }
            if (args.mode == 0) for (int item = blockIdx.x; item < 1024; item += F.G) ret_r1_item(F, proj, rope, (GAS bf16_t*)(ws + WS_RET), item);
            const GAS float* convw = F.inp(I_CONVW) + (size_t)l * 4 * 768; const GAS float* alog = F.inp(I_ALOG) + l * 8; const GAS float* dtb = F.inp(I_DTB) + l * 8;
            if (args.mode != 1 && args.mode != 3 && args.mode != 4) for (int item = blockIdx.x; item < 2048; item += F.G) gdn_g1_item(F, proj, (const GAS float*)(ws + WS_AB), convw, alog, dtb, ws + WS_MIXS, item);
        }
        SEAM(pb + LP_MIX);
        if (INL(LP_MIX2)) { PH_ENTER(); (void)c_id;
            const int nsc = (F.G >= 256) ? 128 : 0;
            if (nsc == 0) { for (int ch = blockIdx.x; ch < 128; ch += F.G) gdn_scan_block(F, ws + WS_MIXS, (GAS bf16_t*)((GAS unsigned char*)F.out + 16 * MiB), ch);
                ret_r2_scan(F, (const GAS bf16_t*)(ws + WS_RET), (GAS bf16_t*)F.out, (size_t)blockIdx.x * NTHREADS + F.tid, (size_t)F.G * NTHREADS); }
            else if ((int)blockIdx.x < nsc) { const int cb = blockIdx.x, chain = (((cb & 7) * 4 + (cb >> 5)) * 4) + ((cb >> 3) & 3);
                gdn_scan_block(F, ws + WS_MIXS, (GAS bf16_t*)((GAS unsigned char*)F.out + 16 * MiB), chain); __syncthreads(); }
            else { const int wb = (int)blockIdx.x - nsc, nwb = F.G - nsc;
                ret_r2_scan(F, (const GAS bf16_t*)(ws + WS_RET), (GAS bf16_t*)F.out, (size_t)wb * NTHREADS + F.tid, (size_t)nwb * NTHREADS); }
            convert_experts_queue(F, l);
        }
        SEAM(pb + LP_MIX2);
        if (INL(LP_FIN)) { PH_ENTER(); (void)c_id;
            const GAS float* retg = F.inp(I_RETG) + l * 256; const GAS float* gdng = F.inp(I_GDNG) + l * 64;
            for (int item = blockIdx.x; item < 1024; item += F.G) ret_r3_item(F, (const GAS bf16_t*)(ws + WS_PROJ), (const GAS bf16_t*)F.out, retg, (GAS bf16_t*)(ws + WS_YCAT), item);
            gdn_finalize(F, (const GAS bf16_t*)(ws + WS_PROJ), (const GAS bf16_t*)((GAS unsigned char*)F.out + 16 * MiB), gdng, (GAS bf16_t*)(ws + WS_YCAT), F.gw, F.ngw);
        }
        SEAM(pb + LP_FIN);
        if (INL(LP_OUTPROJ)) { PH_ENTER();
            OrdStd S{(const GAS char*)(ws + WS_YCAT), (const GAS char*)(ws + WS_WOUT) + (size_t)l * DM * DM * 2, (size_t)256 * DM * 2, (size_t)256 * DM * 2, 0, NTOK / 256, 4, F.G, c_id};
            EpiResid E{(GAS bf16_t*)(ws + WS_XB), (GAS float*)(ws + WS_SSQ)};
            pg8::gemm_phase<EpiResid, OrdStd>(F.lds, F.tid, pg8::Gemm{DM, DM, DM}, S, E);
        }
        SEAM(pb + LP_OUTPROJ);
        if (INL(LP_SCORES)) { PH_ENTER();
            OrdStd S{(const GAS char*)(ws + WS_XB), (const GAS char*)(ws + WS_KQT) + (size_t)l * 4 * DM * DM * 2, (size_t)256 * DM * 2, (size_t)256 * DM * 2, (size_t)DM * DM * 2, NTOK / 256, 4, F.G, c_id};
            EpiSoftmax E{(GAS bf16_t*)(ws + WS_P), (const GAS float*)(ws + WS_SSQ), (LAS float*)(F.lds + LDS_EX)};
            pg8::gemm_phase<EpiSoftmax, OrdStd>(F.lds, F.tid, pg8::Gemm{DM, DM, DM}, S, E);
        }
        SEAM(pb + LP_SCORES);
        if (INL(LP_PV)) { PH_ENTER();
            OrdStd S{(const GAS char*)(ws + WS_P), (const GAS char*)(ws + WS_VOT) + (size_t)l * 4 * DM * DM * 2, (size_t)256 * DM * 2, (size_t)256 * DM * 2, (size_t)DM * DM * 2, NTOK / 256, 4, F.G, c_id};
            EpiResid E{(GAS bf16_t*)(ws + WS_XB), (GAS float*)(ws + WS_SSQ)};
            pg8::gemm_phase<EpiResid, OrdStd, false, true>(F.lds, F.tid, pg8::Gemm{DM, DM, DM}, S, E);
        }
        SEAM(pb + LP_PV);
        if (INL(LP_ROUTER)) { PH_ENTER(); (void)c_id; (void)ws; router_phase(F, l); }
        SEAM(pb + LP_ROUTER);
        if (INL(LP_ASSIGN)) { PH_ENTER(); (void)c_id; (void)ws; assign_gather_phase(F, l); }
        SEAM(pb + LP_ASSIGN);
        if (INL(LP_GATEUP)) { PH_ENTER();
            LAS int* pad_end = (LAS int*)(F.lds + LDS_MISC + 64);
            const int total = moe_pad_table(F, l, pad_end);
            int cs = ((F.G & 7) == 0) ? (c_id & 7) * (F.G >> 3) + (c_id >> 3) : c_id; asm volatile("" : "+s"(cs));
            OrdMoE S{(const GAS char*)(ws + WS_XB), (const GAS char*)(ws + WS_WGU), (size_t)0, (size_t)1024 * DM * 2, (size_t)256 * DM * 2, (total / 256) * 4, pad_end, F.G, cs, (const GAS int*)(ws + WS_SLOT + SL_TOK), (GAS unsigned*)(ws + WS_CTL) + CW_PAN + l * 320 * 16, 0};
            EpiGateUp E{(GAS bf16_t*)(ws + WS_HMID), (const GAS float*)(ws + WS_SLOT + SL_RSTD)};
            pg8::gemm_phase<EpiGateUp, OrdMoE, true, false, true>(F.lds, F.tid, pg8::Gemm{DM, DM, DM}, S, E);
        }
        if (INL(LP_DOWN)) { PH_ENTER();
            LAS int* pad_end = (LAS int*)(F.lds + LDS_MISC + 64);
            const int total = moe_pad_table(F, l, pad_end);
            int cs = ((F.G & 7) == 0) ? (c_id & 7) * (F.G >> 3) + (c_id >> 3) : c_id; const int nu = (total / 256) * 4, rem = nu % F.G; cs -= rem; if (cs < 0) cs += F.G; cs = __builtin_amdgcn_readfirstlane(cs); const int bal = __builtin_amdgcn_readfirstlane((3 * rem <= F.G && nu >= 2 * F.G) ? 1 : 0);
            OrdMoE S{(const GAS char*)(ws + WS_HMID), (const GAS char*)(ws + WS_WD), (size_t)256 * DEXP * 2, (size_t)1024 * DEXP * 2, (size_t)256 * DEXP * 2, (total / 256) * 4, pad_end, F.G, cs, nullptr, (GAS unsigned*)(ws + WS_CTL) + CW_PAN + l * 320 * 16, bal};
            EpiDown E{(GAS bf16_t*)(ws + WS_SORTA), (const GAS float*)(ws + WS_SLOT + SL_W)};
            pg8::gemm_phase<EpiDown, OrdMoE, false, true, true>(F.lds, F.tid, pg8::Gemm{DEXP, DEXP, DEXP}, S, E);
        }
        SEAM(pb + LP_DOWN);
        if (INL(LP_COMBINE)) { PH_ENTER(); (void)c_id; (void)ws; combine_phase(F, l); }
        SEAM(pb + LP_COMBINE);
    }
#undef IN
#undef SEAM
}

extern "C" void kernel_launch(void* const* d_in, const int* in_sizes, int n_in, void* d_out, int out_size, void* d_ws, size_t ws_size, hipStream_t stream) {
    static int grid = 0;
    if (grid == 0) {
        if (n_in != 28 || out_size != NTOK * DM || ws_size < WS_END) { fprintf(stderr, "kernel_launch: unexpected shapes (n_in %d out %d ws %zu need %zu)\n", n_in, out_size, ws_size, (size_t)WS_END); grid = -1; return; }
        int dev = 0, cus = 0;
        if (hipGetDevice(&dev) != hipSuccess || hipDeviceGetAttribute(&cus, hipDeviceAttributeMultiprocessorCount, dev) != hipSuccess) { grid = -1; return; }
        if (hipFuncSetAttribute((const void*)fwd_kernel, hipFuncAttributeMaxDynamicSharedMemorySize, LDS_BYTES) != hipSuccess) { grid = -1; return; }
        int per_cu = 0;
        if (hipOccupancyMaxActiveBlocksPerMultiprocessor(&per_cu, (const void*)fwd_kernel, NTHREADS, LDS_BYTES) != hipSuccess || per_cu < 1) { fprintf(stderr, "occupancy query: %d\n", per_cu); }
        (void)hipGetLastError();
        grid = cus;
    }
    if (grid < 0) return;
    (void)hipMemsetAsync((char*)d_ws + WS_CTL, 0, CTL_ZERO_BYTES, stream);
    Args a{};
    for (int i = 0; i < 28; ++i) a.in[i] = (const float*)d_in[i];
    a.out = (float*)d_out; a.ws = (unsigned char*)d_ws;
#if MK_ONE_LAUNCH
    a.ph_lo = 0; a.ph_hi = NPH;
    hipLaunchKernelGGL(fwd_kernel, dim3(grid), dim3(NTHREADS), LDS_BYTES, stream, a);
#else
#ifndef PROBE_PH
#define PROBE_PH -1
#endif
#ifndef PROBE_REPS
#define PROBE_REPS 1
#endif
    for (int p = 0; p < NPH; ++p) { a.ph_lo = p; a.ph_hi = p + 1; const int reps = (PROBE_PH >= 0 && (p == PROBE_PH || p == PROBE_PH + PPL)) ? 1 + PROBE_REPS : 1;
#ifndef PROBE_MODE
#define PROBE_MODE 0
#endif
        for (int r = 0; r < reps; ++r) { a.mode = (r > 0) ? PROBE_MODE : 0; hipLaunchKernelGGL(fwd_kernel, dim3(grid), dim3(NTHREADS), LDS_BYTES, stream, a); } a.mode = 0; }
#endif
}
```

```cpp
#include <hip/hip_runtime.h>
#include <stdint.h>
#include <stdio.h>

#define LAS __attribute__((address_space(3)))
#define GAS __attribute__((address_space(1)))
typedef unsigned short bf16_t;
typedef short bf16x8 __attribute__((ext_vector_type(8)));
typedef float f32x4 __attribute__((ext_vector_type(4)));
typedef float f32x2 __attribute__((ext_vector_type(2)));
typedef unsigned u32x4 __attribute__((ext_vector_type(4)));
typedef unsigned u32x2 __attribute__((ext_vector_type(2)));

#ifndef MK_ONE_LAUNCH
#define MK_ONE_LAUNCH 1
#endif

constexpr int NB = 4, SEQ = 8192, DM = 1024, NTOK = NB * SEQ, NMEM = 256, DEPTH = 2;
constexpr int PINP = 3072;
constexpr int NEXP = 32, DEXP = 512;
constexpr int CAP = NTOK * 2 + NEXP * 256;
constexpr float EPS = 1e-6f;
constexpr int NWAVES = 8, NTHREADS = 512;

constexpr size_t MiB = 1u << 20;
constexpr size_t WS_CTL   = 0;
constexpr size_t WS_WIN   = 1 * MiB;
constexpr size_t WS_WOUT  = 14 * MiB;
constexpr size_t WS_WQB   = 18 * MiB;
constexpr size_t WS_WKV   = 22 * MiB;
constexpr size_t WS_WOT   = 30 * MiB;
constexpr size_t WS_MEMN  = 34 * MiB;
constexpr size_t WS_KV    = 38 * MiB;
constexpr size_t WS_KQT   = 46 * MiB;
constexpr size_t WS_VOT   = 62 * MiB;
constexpr size_t WS_SSQ   = 78 * MiB;
constexpr size_t WS_TAB   = 80 * MiB;
constexpr size_t WS_XB    = 84 * MiB;
constexpr size_t WS_STAGE = 148 * MiB;
constexpr size_t WS_PROJ  = WS_STAGE;
constexpr size_t WS_VTA   = WS_PROJ + 32 * MiB;
constexpr size_t WS_WD    = WS_PROJ;
constexpr size_t WS_P     = WS_PROJ + 48 * MiB;
constexpr size_t WS_WGU   = WS_PROJ + 112 * MiB;
constexpr size_t WS_AB    = WS_PROJ + 192 * MiB;
constexpr size_t WS_YCAT  = WS_AB + 2 * MiB;
constexpr size_t WS_MIXS  = WS_YCAT + 64 * MiB;
constexpr size_t WS_RET   = WS_MIXS + 128 * MiB;
constexpr size_t WS_MIX_END = WS_RET + 16 * MiB;
constexpr size_t WS_SORTA = WS_AB;
constexpr size_t WS_HMID  = WS_SORTA + 144 * MiB;
constexpr size_t WS_SLOT  = WS_HMID + 72 * MiB;
constexpr size_t WS_MOE_END = WS_SLOT + 2 * MiB;
constexpr size_t WS_END = WS_MIX_END > WS_MOE_END ? WS_MIX_END : WS_MOE_END;
static_assert(WS_END <= 580 * MiB, "workspace budget");
constexpr size_t TAB_ROPE = 0;
constexpr size_t TAB_RFR  = 2 * MiB;
constexpr size_t TAB_POOL = 3 * MiB;
constexpr size_t SL_TOK = 0, SL_W = 512 * 1024, SL_RSTD = 1024 * 1024, SL_TSLOT = 1536 * 1024;
constexpr size_t TAB_TOKE = 3 * MiB + 256 * 1024;
constexpr size_t TAB_TOKW = 3 * MiB + 512 * 1024;
constexpr size_t TAB_RSTD = 3 * MiB + 832 * 1024;
constexpr size_t TAB_ABF  = 3 * MiB + 768 * 1024;
constexpr int CW_BAR = 4096;
constexpr int CW_CNT = 16384;
constexpr int CW_CUR = 16384 + 64;
constexpr int CW_PAN = 16384 + 1024;
constexpr int CW_CQ = 16384 + 256;
constexpr size_t CTL_ZERO_BYTES = 1 * MiB;

constexpr int LDS_RING = 0, LDS_RING_BYTES = 131072;
constexpr int LDS_EX = 131072;
constexpr int LDS_MISC = 131072 + 8192;
constexpr int LDS_BYTES = 147456;

typedef __bf16 bf16v2_t __attribute__((ext_vector_type(2)));
__device__ __forceinline__ unsigned pk2(float lo, float hi) { const f32x2 v = (f32x2){lo, hi}; const bf16v2_t r = __builtin_convertvector(v, bf16v2_t); return __builtin_bit_cast(unsigned, r); }
__device__ __forceinline__ unsigned f2bf(float f) { return pk2(f, f) & 0xffffu; }
__device__ __forceinline__ float bflo(unsigned w) { return __builtin_bit_cast(float, w << 16); }
__device__ __forceinline__ float bfhi(unsigned w) { return __builtin_bit_cast(float, w & 0xffff0000u); }
__device__ __forceinline__ float bf2f(bf16_t b) { return __builtin_bit_cast(float, ((unsigned)b) << 16); }
__device__ __forceinline__ int lane_now() { unsigned z = 0u; asm volatile("" : "+v"(z)); return (int)__builtin_amdgcn_mbcnt_hi(~0u, __builtin_amdgcn_mbcnt_lo(~0u, z)); }
__device__ __forceinline__ float shfl_xor_f(float v, int m) { return __builtin_bit_cast(float, __builtin_amdgcn_ds_bpermute((lane_now() ^ m) << 2, __builtin_bit_cast(int, v))); }
__device__ __forceinline__ float shfl_f(float v, int src) { return __builtin_bit_cast(float, __builtin_amdgcn_ds_bpermute(src << 2, __builtin_bit_cast(int, v))); }
__device__ __forceinline__ float wave_sum(float v) {
#pragma unroll
    for (int o = 1; o < 64; o <<= 1) v += shfl_xor_f(v, o);
    return v;
}
__device__ __forceinline__ float wave_max(float v) {
#pragma unroll
    for (int o = 1; o < 64; o <<= 1) v = fmaxf(v, shfl_xor_f(v, o));
    return v;
}
__device__ __forceinline__ float silu_f(float x) { return x * __builtin_amdgcn_rcpf(1.f + __expf(-x)); }
__device__ __forceinline__ float sigmoid_f(float x) { return __builtin_amdgcn_rcpf(1.f + __expf(-x)); }
__device__ __forceinline__ float softplus_f(float x) { const float e = __expf(x); return x > 15.f ? x : (x < -15.f ? e : __logf(1.0f + e)); }
#define LDS_WAIT() asm volatile("s_waitcnt lgkmcnt(0)" ::: "memory")
#define VM_WAIT() asm volatile("s_waitcnt vmcnt(0)" ::: "memory")

#define XB_TMO      128
#define XB_XCNT(j)  (256  + 64 * (j))
#define XB_XSUB(j)  (1280 + 64 * (j))
#define XB_XGEN(j)  (2304 + 64 * (j))
#define XB_TOP      3328
#define XB_TOPGEN   3392
#define XCD_BAR_WORDS 3456
#define XB_SPIN_CAP (1u << 22)

__device__ __forceinline__ unsigned xb_ld(GAS unsigned* p)              { return __hip_atomic_load(p, __ATOMIC_RELAXED, __HIP_MEMORY_SCOPE_AGENT); }
__device__ __forceinline__ unsigned xb_add(GAS unsigned* p, unsigned v) { return __hip_atomic_fetch_add(p, v, __ATOMIC_RELAXED, __HIP_MEMORY_SCOPE_AGENT); }
__device__ __forceinline__ unsigned xb_xcc_id() { return (unsigned)__builtin_amdgcn_s_getreg((3 << 11) | 20) & 0xFu; }
#define XB_SPIN(cond, bar) do { unsigned _sp = 0; while (cond) { __builtin_amdgcn_s_sleep(1); \
    if ((++_sp & 255u) == 0u) { if (xb_ld(&(bar)[XB_TMO])) break; if (_sp > XB_SPIN_CAP) { xb_add(&(bar)[XB_TMO], 1u); break; } } } } while (0)

struct XcdBarrier { GAS unsigned* bar; unsigned x; volatile LAS unsigned* st; };

__device__ __forceinline__ XcdBarrier xcd_barrier_post(GAS unsigned* bar, volatile LAS unsigned* st, const bool leader) {
    XcdBarrier b; b.bar = bar; b.x = xb_xcc_id(); b.st = st;
    if (leader) (void)xb_add(&bar[XB_XCNT(b.x)], 1u);
    return b;
}
__device__ __forceinline__ void xcd_barrier_complete(GAS unsigned* bar, unsigned x, unsigned& nloc, unsigned& nx) {
    const unsigned G = gridDim.x * gridDim.y * gridDim.z;
    unsigned sum, cnt, mine, sp = 0u;
    for (;;) {
        sum = 0u; cnt = 0u; mine = 0u;
#pragma unroll
        for (unsigned j = 0; j < 16; ++j) { const unsigned c = xb_ld(&bar[XB_XCNT(j)]); sum += c; cnt += (c > 0u) ? 1u : 0u; mine = (j == x) ? c : mine; }
        if (sum == G) break;
        __builtin_amdgcn_s_sleep(1);
        if ((++sp & 255u) == 0u) { if (xb_ld(&bar[XB_TMO])) break; if (sp > XB_SPIN_CAP) { xb_add(&bar[XB_TMO], 1u); break; } }
    }
    nloc = mine > 0u ? mine : 1u; nx = cnt > 0u ? cnt : 1u;
}
__device__ __forceinline__ void xcd_barrier(const XcdBarrier& b, const bool leader) {
    asm volatile("s_waitcnt vmcnt(0)" ::: "memory");
    __syncthreads();
    if (leader) {
        GAS unsigned* bar = b.bar;
        __builtin_amdgcn_s_waitcnt(0);
        unsigned nloc = b.st[0], nx = b.st[1];
        if (nloc == 0u) { xcd_barrier_complete(bar, b.x, nloc, nx); b.st[0] = nloc; b.st[1] = nx; }
        const unsigned old = xb_add(&bar[XB_XSUB(b.x)], 1u);
        const unsigned gen = old / nloc;
        if (old + 1u == (gen + 1u) * nloc) {
            __builtin_amdgcn_fence(__ATOMIC_RELEASE, "agent");
            asm volatile("s_waitcnt vmcnt(0)" ::: "memory");
            const unsigned og = xb_add(&bar[XB_TOP], 1u);
            const unsigned tg = og / nx;
            if (og + 1u == (tg + 1u) * nx) xb_add(&bar[XB_TOPGEN], 1u);
            else XB_SPIN(xb_ld(&bar[XB_TOPGEN]) == tg, bar);
            __builtin_amdgcn_fence(__ATOMIC_ACQUIRE, "agent");
            xb_add(&bar[XB_XGEN(b.x)], 1u);
            asm volatile("s_waitcnt vmcnt(0)" ::: "memory");
        } else {
            XB_SPIN(xb_ld(&bar[XB_XGEN(b.x)]) == gen, bar);
            __builtin_amdgcn_fence(__ATOMIC_ACQUIRE, "agent");
            asm volatile("s_waitcnt vmcnt(0)" ::: "memory");
        }
    }
    __syncthreads();
}

namespace pg8 {
constexpr int BM = 256, BK = 64, HALF = 128, HTB = HALF * BK * 2, STAGE_BYTES = 8 * HTB, NXCD = 8, WGM = 8;
__host__ __device__ __forceinline__ int lds_byte(int r, int c) { const int st = (r >> 4) * 2 + (c >> 5), rr = r & 15, cc = c & 31, ob = rr * 64 + cc * 2; return st * 1024 + (ob ^ (((ob >> 9) & 1) << 5)); }
__host__ __device__ __forceinline__ void stage_rc(int b, int& R, int& C) { const int st = b / 1024, sb = b % 1024, swz = sb ^ (((sb >> 9) & 1) << 5); R = (st >> 1) * 16 + swz / 64; C = (st & 1) * 32 + (swz % 64) / 2; }
__host__ __device__ __forceinline__ int perm32(int rho) { const int n = rho >> 4, i = rho & 15; return 8 * (i >> 2) + 4 * n + (i & 3); }

struct Unit { int pm, pn, z; };
struct Gemm { int lda, ldb, K; };

__device__ __forceinline__ void static_map(int wgid, int nM, int nN, int& pm, int& pn) {
    const int nwg = nM * nN;
    { const int q = nwg / NXCD, r = nwg % NXCD, xcd = wgid % NXCD, off = wgid / NXCD; wgid = (xcd < r ? xcd * (q + 1) : r * (q + 1) + (xcd - r) * q) + off; }
    const int nig = WGM * nN, gid = wgid / nig, fm = gid * WGM, gsz = (nM - fm) < WGM ? (nM - fm) : WGM;
    pm = fm + ((wgid % nig) % gsz); pn = (wgid % nig) / gsz;
}

__device__ __forceinline__ unsigned cvt_pk_bf16(float lo, float hi) { unsigned r; asm volatile("v_cvt_pk_bf16_f32 %0, %1, %2" : "=v"(r) : "v"(lo), "v"(hi)); return r; }

template <class Epi, class Sched, bool GATHER = false, bool ABLK = false, bool HOOKS = false>
__device__ __forceinline__ void gemm_phase(LAS unsigned char* lds, const int tid, const Gemm g, const Sched& S, const Epi& E) {
    const int wid = __builtin_amdgcn_readfirstlane(tid >> 6), lane = tid & 63, wr = wid >> 2, wc = wid & 3, fr = lane & 15, fq = lane >> 4;
    const int K = g.K, nt = K / BK;
    unsigned voffA[2], voffB[2];
#pragma unroll
    for (int i = 0; i < 2; ++i) { int R, C; stage_rc(tid * 16 + i * 8192, R, C); const int Rb = Epi::PERM ? ((R & ~31) + perm32(R & 31)) : R;
        voffA[i] = ABLK ? (unsigned)((R >> 4) * 16 * g.lda) * 2u + (unsigned)(((C >> 5) * 4 + (lane >> 4)) * 256 + (lane & 15) * 16) : (unsigned)(R * g.lda + C) * 2u; voffB[i] = (unsigned)(Rb * g.ldb + C) * 2u; }
    unsigned voA[2][2]; int gr[2][2];
#define PG8_GROWS(u) do { _Pragma("unroll") for (int _h = 0; _h < 2; ++_h) _Pragma("unroll") for (int _i = 0; _i < 2; ++_i) { int _R, _C; stage_rc(tid * 16 + _i * 8192, _R, _C); gr[_h][_i] = S.row_of((u), _h * HALF + _R); } } while (0)
#define PG8_GOFFS(dst) do { _Pragma("unroll") for (int _h = 0; _h < 2; ++_h) _Pragma("unroll") for (int _i = 0; _i < 2; ++_i) { int _R, _C; stage_rc(tid * 16 + _i * 8192, _R, _C); (dst)[_h][_i] = (unsigned)(gr[_h][_i] * g.lda + _C) * 2u; } } while (0)
    const size_t kstep = (size_t)(BK * 2), kstepA = ABLK ? (size_t)2048 : kstep;
    const size_t hstepA = (size_t)HALF * g.lda * 2, hstepB = (size_t)HALF * g.ldb * 2;
    const unsigned ldsw = (unsigned)wid * 1024u;
    const int aoff = ABLK ? wr * 8192 + fq * 256 + fr * 16 : lds_byte(wr * 64 + fr, fq * 8), boff = lds_byte(wc * 32 + fr, fq * 8);
#define PG8_SA(b, h) (((b) * 2 + (h)) * HTB)
#define PG8_SB(b, h) ((4 + (b) * 2 + (h)) * HTB)
#define PG8_STAGE(bufoff, gbase, voff) do { _Pragma("unroll") for (int _i = 0; _i < 2; ++_i) \
        __builtin_amdgcn_global_load_lds((const GAS unsigned*)((const GAS char*)(gbase) + (voff)[_i]), (LAS unsigned*)(lds + (bufoff) + ldsw + _i * 8192), 16, 0, 0); } while (0)
#define PG8_LDA(dst, b, h) do { _Pragma("unroll") for (int m = 0; m < 4; ++m) _Pragma("unroll") for (int k = 0; k < 2; ++k) dst[m][k] = *(const LAS bf16x8*)(lds + PG8_SA(b, h) + aoff + m * 2048 + k * 1024); } while (0)
#define PG8_LDB(dst, b, h) do { _Pragma("unroll") for (int n = 0; n < 2; ++n) _Pragma("unroll") for (int k = 0; k < 2; ++k) dst[n][k] = *(const LAS bf16x8*)(lds + PG8_SB(b, h) + boff + n * 2048 + k * 1024); } while (0)
#define PG8_MMA(ai, bj, At, Bt) do { __builtin_amdgcn_s_setprio(1); _Pragma("unroll") for (int m = 0; m < 4; ++m) _Pragma("unroll") for (int n = 0; n < 2; ++n) _Pragma("unroll") for (int k = 0; k < 2; ++k) \
        acc[ai][bj][m][n] = __builtin_amdgcn_mfma_f32_16x16x32_bf16(Bt[n][k], At[m][k], acc[ai][bj][m][n], 0, 0, 0); __builtin_amdgcn_s_setprio(0); } while (0)
#define PG8_WAIT_V(n) asm volatile("s_waitcnt vmcnt(" #n ")" ::: "memory")
#define PG8_WAIT_L(n) asm volatile("s_waitcnt lgkmcnt(" #n ")" ::: "memory")
#define PG8_BAR __builtin_amdgcn_s_barrier()
#define PG8_SCHED __builtin_amdgcn_sched_barrier(0)
    Unit cur, nxt; int ui = 0;
    if (!S.next(0, cur)) return;
    if constexpr (HOOKS) S.a_ready(cur, wid);
    f32x4 acc[2][2][4][2];
#pragma unroll
    for (int a = 0; a < 2; ++a)
#pragma unroll
        for (int b = 0; b < 2; ++b)
#pragma unroll
            for (int m = 0; m < 4; ++m)
#pragma unroll
                for (int n = 0; n < 2; ++n) acc[a][b][m][n] = (f32x4){0.f, 0.f, 0.f, 0.f};
    bf16x8 At[4][2], B0[2][2], B1[2][2];
    const GAS char* cA = S.a_ptr(cur); const GAS char* cB = S.b_ptr(cur);
    {
        if constexpr (GATHER) { PG8_GROWS(cur); PG8_GOFFS(voA); }
        else { _Pragma("unroll") for (int _i = 0; _i < 2; ++_i) { voA[0][_i] = voffA[_i]; voA[1][_i] = voffA[_i] + (unsigned)hstepA; } }
        PG8_STAGE(PG8_SB(0, 0), cB, voffB); PG8_STAGE(PG8_SB(0, 1), cB + hstepB, voffB); PG8_STAGE(PG8_SA(0, 0), cA, voA[0]); PG8_STAGE(PG8_SA(0, 1), cA, voA[1]);
        if (wr == 1) PG8_BAR;
        PG8_WAIT_V(2); PG8_BAR;
        PG8_STAGE(PG8_SB(1, 0), cB + kstep, voffB); PG8_STAGE(PG8_SA(1, 0), cA + kstepA, voA[0]); PG8_STAGE(PG8_SB(1, 1), cB + hstepB + kstep, voffB);
        PG8_WAIT_V(6); PG8_BAR;
    }
    for (;;) {
        const bool has_next = S.next(ui + 1, nxt);
        const GAS char* nA = has_next ? S.a_ptr(nxt) : cA; const GAS char* nB = has_next ? S.b_ptr(nxt) : cB;
        if constexpr (HOOKS) { if (has_next) S.a_ready(nxt, wid); }
        if constexpr (GATHER) { if (has_next) PG8_GROWS(nxt); }
        for (int t = 0; t < nt; t += 2) {
            const bool last = (t == nt - 2);
            const GAS char* a1 = cA + (size_t)(t + 1) * kstepA;
            const GAS char* a2 = last ? nA : cA + (size_t)(t + 2) * kstepA; const GAS char* b2 = last ? nB : cB + (size_t)(t + 2) * kstep;
            const GAS char* a3 = a2 + kstepA; const GAS char* b3 = b2 + kstep;
            PG8_LDB(B0, 0, 0); PG8_LDB(B1, 0, 1); PG8_SCHED; PG8_LDA(At, 0, 0); PG8_STAGE(PG8_SA(1, 1), a1, voA[1]);
            if constexpr (GATHER) { if (last && has_next) { asm volatile("" : "+v"(gr[0][0]), "+v"(gr[0][1]), "+v"(gr[1][0]), "+v"(gr[1][1])); PG8_GOFFS(voA); } }
            PG8_WAIT_V(8); PG8_WAIT_L(0); PG8_BAR; PG8_MMA(0, 0, At, B0); PG8_MMA(0, 1, At, B1); PG8_BAR; PG8_SCHED;
            PG8_LDA(At, 0, 1); PG8_STAGE(PG8_SB(0, 0), b2, voffB); PG8_STAGE(PG8_SB(0, 1), b2 + hstepB, voffB); PG8_STAGE(PG8_SA(0, 0), a2, voA[0]);
            PG8_WAIT_V(8); PG8_WAIT_L(0); PG8_BAR; PG8_MMA(1, 0, At, B0); PG8_MMA(1, 1, At, B1); PG8_BAR; PG8_SCHED;
            PG8_LDB(B0, 1, 0); PG8_LDB(B1, 1, 1); PG8_SCHED; PG8_LDA(At, 1, 0); PG8_STAGE(PG8_SA(0, 1), a2, voA[1]);
            PG8_WAIT_V(8); PG8_WAIT_L(0); PG8_BAR; PG8_MMA(0, 0, At, B0); PG8_MMA(0, 1, At, B1); PG8_BAR; PG8_SCHED;
            PG8_LDA(At, 1, 1); PG8_STAGE(PG8_SB(1, 0), b3, voffB); PG8_STAGE(PG8_SB(1, 1), b3 + hstepB, voffB); PG8_STAGE(PG8_SA(1, 0), a3, voA[0]);
            PG8_WAIT_V(8); PG8_WAIT_L(0); PG8_BAR; PG8_MMA(1, 0, At, B0); PG8_MMA(1, 1, At, B1); PG8_BAR; PG8_SCHED;
        }
        if (wr == 0) PG8_BAR;
        E(acc, cur, wr, wc, fr, fq);
        if constexpr (HOOKS) S.done(cur);
        if (!has_next) break;
#pragma unroll
        for (int a = 0; a < 2; ++a)
#pragma unroll
            for (int b = 0; b < 2; ++b)
#pragma unroll
                for (int m = 0; m < 4; ++m)
#pragma unroll
                    for (int n = 0; n < 2; ++n) acc[a][b][m][n] = (f32x4){0.f, 0.f, 0.f, 0.f};
        cur = nxt; cA = nA; cB = nB; ++ui;
        if (wr == 1) PG8_BAR;
    }
    PG8_WAIT_V(0);
    PG8_BAR;
#undef PG8_GROWS
#undef PG8_GOFFS
#undef PG8_SA
#undef PG8_SB
#undef PG8_STAGE
#undef PG8_LDA
#undef PG8_LDB
#undef PG8_MMA
#undef PG8_WAIT_V
#undef PG8_WAIT_L
#undef PG8_BAR
#undef PG8_SCHED
}
}

struct OrdStd {
    const GAS char* A; const GAS char* B; size_t a_tile, b_tile, b_batch; int nM, nN, G, c;
    __device__ __forceinline__ bool next(int i, pg8::Unit& u) const {
        const long L = (long)i * G + c; if (L >= (long)nM * nN) return false;
        pg8::static_map((int)L, nM, nN, u.pm, u.pn); u.z = 0; return true; }
    __device__ __forceinline__ const GAS char* a_ptr(const pg8::Unit& u) const { return A + (size_t)u.pm * a_tile; }
    __device__ __forceinline__ const GAS char* b_ptr(const pg8::Unit& u) const { return B + (size_t)(u.pm >> 5) * b_batch + (size_t)u.pn * b_tile; }
};
struct OrdInProj {
    const GAS char* A; const GAS char* B; size_t tile; int nM, nN, G, c;
    __device__ __forceinline__ bool next(int i, pg8::Unit& u) const {
        const long L = (long)i * G + c; if (L >= (long)nM * nN) return false;
        pg8::static_map((int)L, nM, nN, u.pm, u.pn); u.z = 0; return true; }
    __device__ __forceinline__ const GAS char* a_ptr(const pg8::Unit& u) const { return u.pn == 2 ? B + (size_t)u.pn * tile : A + (size_t)u.pm * tile; }
    __device__ __forceinline__ const GAS char* b_ptr(const pg8::Unit& u) const { return u.pn == 2 ? A + (size_t)u.pm * tile : B + (size_t)u.pn * tile; }
};
struct OrdKV {
    const GAS char* memn; const GAS char* wkv; int G, c;
    __device__ __forceinline__ bool next(int i, pg8::Unit& u) const { const int L = i * G + c; if (L >= 64) return false; u.pm = L >> 3; u.pn = L & 7; u.z = 0; return true; }
    __device__ __forceinline__ const GAS char* a_ptr(const pg8::Unit& u) const { return memn + (size_t)u.pm * 256 * 1024 * 2; }
    __device__ __forceinline__ const GAS char* b_ptr(const pg8::Unit& u) const { return wkv + ((size_t)(u.pm >> 2) * 2048 + (size_t)u.pn * 256) * 1024 * 2; }
};
struct OrdKq {
    const GAS char* kv; const GAS char* wqb; int G, c;
    __device__ __forceinline__ bool next(int i, pg8::Unit& u) const { const int L = i * G + c; if (L >= 128) return false;
        const int l = L >> 6, b = (L >> 4) & 3, h = (L >> 2) & 3, q = L & 3; u.pm = (l * 4 + b) * 4 + h; u.pn = q; u.z = L; return true; }
    __device__ __forceinline__ const GAS char* a_ptr(const pg8::Unit& u) const { const int L = u.z, l = L >> 6, b = (L >> 4) & 3, h = (L >> 2) & 3;
        return kv + (((size_t)l * 1024 + b * 256) * 2048 + h * 256) * 2; }
    __device__ __forceinline__ const GAS char* b_ptr(const pg8::Unit& u) const { const int L = u.z, l = L >> 6, h = (L >> 2) & 3, q = L & 3;
        return wqb + ((size_t)l * 1048576 + (size_t)q * 256 * 1024 + h * 256) * 2; }
};
struct OrdVo {
    const GAS char* kv; const GAS char* wot; int G, c;
    __device__ __forceinline__ bool next(int i, pg8::Unit& u) const { const int L = i * G + c; if (L >= 128) return false;
        const int l = L >> 6, b = (L >> 4) & 3, h = (L >> 2) & 3, q = L & 3; u.pm = (l * 4 + b) * 4 + q; u.pn = h; u.z = L; return true; }
    __device__ __forceinline__ const GAS char* a_ptr(const pg8::Unit& u) const { const int L = u.z, l = L >> 6, h = (L >> 2) & 3, q = L & 3;
        return wot + ((size_t)l * 1048576 + (size_t)q * 256 * 1024 + h * 256) * 2; }
    __device__ __forceinline__ const GAS char* b_ptr(const pg8::Unit& u) const { const int L = u.z, l = L >> 6, b = (L >> 4) & 3, h = (L >> 2) & 3;
        return kv + (((size_t)l * 1024 + b * 256) * 2048 + 1024 + h * 256) * 2; }
};
struct OrdMoE {
    const GAS char* A; const GAS char* B; size_t a_tile, b_exp, b_tile; int nunits; const LAS int* pad_end; int G, c; const GAS int* rowtab; GAS unsigned* pan; int bal;
    __device__ __forceinline__ bool next(int i, pg8::Unit& u) const {
        long L = (long)i * G + c;
        if (bal) {
            const int fr = nunits / G, rem = nunits - fr * G;
            if (i == fr - 1) { if (c >= G - rem) return false; }
            else if (i == fr) { if (c >= 2 * rem) return false; L = (long)fr * G - rem + c; }
            else if (i > fr) return false;
        }
        if (L >= nunits) return false;
        u.pm = (int)(L >> 2); u.pn = (int)(L & 3); int e = 0; const int r0 = u.pm * 256;
        const LAS int* pe = pad_end; asm volatile("" : "+v"(pe));
        for (int j = 0; j < NEXP; ++j) e += (pe[j] <= r0) ? 1 : 0;
        e = __builtin_amdgcn_readfirstlane(e);
        u.z = e < NEXP ? e : NEXP - 1; return true; }
    __device__ __forceinline__ const GAS char* a_ptr(const pg8::Unit& u) const { return A + (size_t)u.pm * a_tile; }
    __device__ __forceinline__ const GAS char* b_ptr(const pg8::Unit& u) const { return B + (size_t)u.z * b_exp + (size_t)u.pn * b_tile; }
    __device__ __forceinline__ int row_of(const pg8::Unit& u, int r) const { return rowtab[u.pm * 256 + r]; }
    __device__ __forceinline__ void done(const pg8::Unit& u) const {
        if (rowtab == nullptr) return;
        asm volatile("s_waitcnt vmcnt(0)" ::: "memory");
        if (lane_now() == 0) __hip_atomic_fetch_add(pan + 16 * u.pm, 1u, __ATOMIC_RELAXED, __HIP_MEMORY_SCOPE_AGENT);
    }
    __device__ __forceinline__ void a_ready(const pg8::Unit& u, int wid) const {
        if (rowtab != nullptr) return;
        if (wid == 0) { GAS unsigned* p = pan + 16 * u.pm; unsigned sp = 0;
            while (xb_ld(p) < 32u) { __builtin_amdgcn_s_sleep(1); if (++sp > XB_SPIN_CAP) break; }
            __builtin_amdgcn_fence(__ATOMIC_ACQUIRE, "agent"); asm volatile("s_waitcnt vmcnt(0)" ::: "memory"); }
        asm volatile("" ::: "memory"); __builtin_amdgcn_s_barrier(); asm volatile("" ::: "memory");
    }
};

typedef const f32x4 (&AccRef)[2][2][4][2];
__device__ __forceinline__ float row_rstd(const GAS float* ssq, int row) {
    const GAS f32x4* p = (const GAS f32x4*)(ssq + (size_t)row * 16);
    const f32x4 a = p[0], b = p[1], c = p[2], d = p[3];
    const float s = ((a.x + a.y) + (a.z + a.w)) + ((b.x + b.y) + (b.z + b.w)) + ((c.x + c.y) + (c.z + c.w)) + ((d.x + d.y) + (d.z + d.w));
    return rsqrtf(s * (1.0f / DM) + EPS);
}
__device__ __forceinline__ u32x4 pack8(f32x4 v0, f32x4 v1) {
    u32x4 w; w.x = pg8::cvt_pk_bf16(v0[0], v0[1]); w.y = pg8::cvt_pk_bf16(v0[2], v0[3]); w.z = pg8::cvt_pk_bf16(v1[0], v1[1]); w.w = pg8::cvt_pk_bf16(v1[2], v1[3]); return w; }

struct EpiBf {
    static constexpr bool PERM = true; GAS bf16_t* O; int ldc;
    __device__ __forceinline__ void operator()(AccRef acc, const pg8::Unit& u, int wr, int wc, int fr, int fq) const {
        { const int _l = lane_now(); fr = _l & 15; fq = _l >> 4; }
        const int row0 = u.pm * 256 + wr * 64 + fr, col0 = u.pn * 256 + wc * 32 + 8 * fq;
#pragma unroll
        for (int ai = 0; ai < 2; ++ai)
#pragma unroll
            for (int m = 0; m < 4; ++m) { asm volatile("" ::: "memory"); GAS bf16_t* rowp = O + (size_t)(row0 + ai * 128 + m * 16) * ldc + col0;
#pragma unroll
                for (int bj = 0; bj < 2; ++bj) *(GAS u32x4*)(rowp + bj * 128) = pack8(acc[ai][bj][m][0], acc[ai][bj][m][1]); }
    }
};
struct EpiProj {
    static constexpr bool PERM = true; GAS bf16_t* proj; GAS float* ab; const GAS float* ssq; GAS bf16_t* vta;
    __device__ __forceinline__ void operator()(AccRef acc, const pg8::Unit& u, int wr, int wc, int fr, int fq) const {
        { const int _l = lane_now(); fr = _l & 15; fq = _l >> 4; }
        if (u.pn == 2) {
            const int tok0 = u.pm * 256 + wc * 32 + 8 * fq;
#pragma unroll
            for (int bj = 0; bj < 2; ++bj) { float rs[8];
#pragma unroll
                for (int e = 0; e < 8; ++e) rs[e] = ssq[tok0 + bj * 128 + e];
                const int tk = tok0 + bj * 128; GAS bf16_t* vb = vta + ((size_t)(tk >> 6) * 128 + ((tk & 63) >> 3)) * 128 + fr * 8;
#pragma unroll
                for (int ai = 0; ai < 2; ++ai)
#pragma unroll
                    for (int m = 0; m < 4; ++m) { const f32x4 a0 = acc[ai][bj][m][0], a1 = acc[ai][bj][m][1];
                        const f32x4 s0 = (f32x4){a0[0] * rs[0], a0[1] * rs[1], a0[2] * rs[2], a0[3] * rs[3]}, s1 = (f32x4){a1[0] * rs[4], a1[1] * rs[5], a1[2] * rs[6], a1[3] * rs[7]};
                        *(GAS u32x4*)(vb + (size_t)(((2 * ai + wr) * 4 + m) * 8) * 128) = pack8(s0, s1); } }
            return; }
        const int row0 = u.pm * 256 + wr * 64 + fr;
        float rsv[2][4];
#pragma unroll
        for (int ai = 0; ai < 2; ++ai)
#pragma unroll
            for (int m = 0; m < 4; ++m) rsv[ai][m] = ssq[row0 + ai * 128 + m * 16];
#pragma unroll
        for (int ai = 0; ai < 2; ++ai)
#pragma unroll
            for (int m = 0; m < 4; ++m) { asm volatile("" ::: "memory"); const int row = row0 + ai * 128 + m * 16; const float rs = rsv[ai][m];
                const bool blk = (0xdb >> u.pn) & 1;
                GAS bf16_t* rowp = blk ? proj + ((size_t)u.pn * NTOK + (row & ~15)) * 256 + (wc * 4 + fq) * 128 + (row & 15) * 8
                                              : proj + ((size_t)u.pn * NTOK + row) * 256 + wc * 32 + 8 * fq;
                const int bjs = blk ? 16 * 128 : 128;
#pragma unroll
                for (int bj = 0; bj < 2; ++bj) *(GAS u32x4*)(rowp + bj * bjs) = pack8(acc[ai][bj][m][0] * rs, acc[ai][bj][m][1] * rs);
            }
    }
};
struct EpiResid {
    static constexpr bool PERM = true; GAS bf16_t* xb; GAS float* ssq;
    __device__ __forceinline__ void operator()(AccRef acc, const pg8::Unit& u, int wr, int wc, int fr, int fq) const {
        { const int _l = lane_now(); fr = _l & 15; fq = _l >> 4; }
        const int row0 = u.pm * 256 + wr * 64 + fr, col0 = u.pn * 256 + wc * 32 + 8 * fq;
#pragma unroll
        for (int ai = 0; ai < 2; ++ai) { asm volatile("" ::: "memory");
            u32x4 xo[4][2];
#pragma unroll
            for (int m = 0; m < 4; ++m)
#pragma unroll
                for (int bj = 0; bj < 2; ++bj) xo[m][bj] = *(const GAS u32x4*)(xb + (size_t)(row0 + ai * 128 + m * 16) * DM + col0 + bj * 128);
#pragma unroll
            for (int m = 0; m < 4; ++m) { const int row = row0 + ai * 128 + m * 16; float s = 0.f;
#pragma unroll
                for (int bj = 0; bj < 2; ++bj) { const size_t o = (size_t)row * DM + col0 + bj * 128; const u32x4 x = xo[m][bj];
                    const f32x4 v0 = acc[ai][bj][m][0] + (f32x4){bflo(x.x), bfhi(x.x), bflo(x.y), bfhi(x.y)}, v1 = acc[ai][bj][m][1] + (f32x4){bflo(x.z), bfhi(x.z), bflo(x.w), bfhi(x.w)};
                    const u32x4 w = pack8(v0, v1); *(GAS u32x4*)(xb + o) = w;
                    const float r0 = bflo(w.x), r1 = bfhi(w.x), r2 = bflo(w.y), r3 = bfhi(w.y), r4 = bflo(w.z), r5 = bfhi(w.z), r6 = bflo(w.w), r7 = bfhi(w.w);
                    s += (r0 * r0 + r1 * r1) + (r2 * r2 + r3 * r3) + (r4 * r4 + r5 * r5) + (r6 * r6 + r7 * r7); }
                s += shfl_xor_f(s, 16); s += shfl_xor_f(s, 32);
                if (fq == 0) ssq[(size_t)row * 16 + u.pn * 4 + wc] = s; } }
    }
};
struct EpiSoftmax {
    static constexpr bool PERM = true; GAS bf16_t* P; const GAS float* ssq; LAS float* ex;
    __device__ __forceinline__ void operator()(AccRef acc, const pg8::Unit& u, int wr, int wc, int fr, int fq) const {
        { const int _l = lane_now(); fr = _l & 15; fq = _l >> 4; }
        const int rl0 = wr * 64 + fr, col0 = u.pn * 256 + wc * 32 + 8 * fq;
        LAS float* exm = ex; LAS float* exs = ex + 1024; LAS float* exr = ex + 2048 + 256;
#pragma unroll
        for (int ai = 0; ai < 2; ++ai)
#pragma unroll
            for (int m = 0; m < 4; ++m) { const int rl = rl0 + ai * 128 + m * 16;
                float mx = -3.0e38f;
#pragma unroll
                for (int bj = 0; bj < 2; ++bj)
#pragma unroll
                    for (int n = 0; n < 2; ++n) { const f32x4 v = acc[ai][bj][m][n]; mx = fmaxf(mx, fmaxf(fmaxf(v[0], v[1]), fmaxf(v[2], v[3]))); }
                mx = fmaxf(mx, shfl_xor_f(mx, 16)); mx = fmaxf(mx, shfl_xor_f(mx, 32));
                if (fq == 0) exm[rl * 4 + wc] = mx; }
        if (wr == 0) { const int rl = wc * 64 + fq * 16 + fr; exr[rl] = row_rstd(ssq, u.pm * 256 + rl); }
        asm volatile("s_waitcnt lgkmcnt(0)" ::: "memory"); __builtin_amdgcn_s_barrier(); asm volatile("" ::: "memory");
#pragma unroll
        for (int ai = 0; ai < 2; ++ai)
#pragma unroll
            for (int m = 0; m < 4; ++m) { asm volatile("" ::: "memory"); const int rl = rl0 + ai * 128 + m * 16; const f32x4 q = *(const LAS f32x4*)(exm + rl * 4); const float rs = exr[rl];
                const float mx = fmaxf(fmaxf(q[0], q[1]), fmaxf(q[2], q[3])) * rs; float s = 0.f;
#pragma unroll
                for (int bj = 0; bj < 2; ++bj)
#pragma unroll
                    for (int n = 0; n < 2; ++n) { const f32x4 v = acc[ai][bj][m][n] * rs - mx; s += (__expf(v[0]) + __expf(v[1])) + (__expf(v[2]) + __expf(v[3])); }
                s += shfl_xor_f(s, 16); s += shfl_xor_f(s, 32);
                if (fq == 0) exs[rl * 4 + wc] = s; }
        asm volatile("s_waitcnt lgkmcnt(0)" ::: "memory"); __builtin_amdgcn_s_barrier(); asm volatile("" ::: "memory");
#pragma unroll
        for (int ai = 0; ai < 2; ++ai)
#pragma unroll
            for (int m = 0; m < 4; ++m) { asm volatile("" ::: "memory"); const int rl = rl0 + ai * 128 + m * 16; const f32x4 q = *(const LAS f32x4*)(exs + rl * 4), qm = *(const LAS f32x4*)(exm + rl * 4);
                const float rs = exr[rl];
                const float inv = 1.0f / ((q[0] + q[1]) + (q[2] + q[3])); const float mx = fmaxf(fmaxf(qm[0], qm[1]), fmaxf(qm[2], qm[3])) * rs;
                GAS bf16_t* rowp = P + (size_t)(u.pm * 256 + (rl & ~15)) * DM + (col0 >> 3) * 128 + (rl & 15) * 8;
#pragma unroll
                for (int bj = 0; bj < 2; ++bj) { f32x4 v0 = acc[ai][bj][m][0] * rs - mx, v1 = acc[ai][bj][m][1] * rs - mx;
#pragma unroll
                    for (int j = 0; j < 4; ++j) { v0[j] = __expf(v0[j]) * inv; v1[j] = __expf(v1[j]) * inv; }
                    *(GAS u32x4*)(rowp + bj * 2048) = pack8(v0, v1); } }
        asm volatile("s_waitcnt lgkmcnt(0)" ::: "memory");
    }
};
struct EpiGateUp {
    static constexpr bool PERM = true; GAS bf16_t* hmid; const GAS float* slot_rstd;
    __device__ __forceinline__ void operator()(AccRef acc, const pg8::Unit& u, int wr, int wc, int fr, int fq) const {
        { const int _l = lane_now(); fr = _l & 15; fq = _l >> 4; }
        const int row0 = u.pm * 256 + wr * 64 + fr, col0 = u.pn * 128 + wc * 16 + 4 * fq;
        float rsv[2][4];
#pragma unroll
        for (int ai = 0; ai < 2; ++ai)
#pragma unroll
            for (int m = 0; m < 4; ++m) rsv[ai][m] = slot_rstd[row0 + ai * 128 + m * 16];
#pragma unroll
        for (int ai = 0; ai < 2; ++ai)
#pragma unroll
            for (int m = 0; m < 4; ++m) { const int row = row0 + ai * 128 + m * 16; const float rs = rsv[ai][m];
#pragma unroll
                for (int bj = 0; bj < 2; ++bj) { const f32x4 v0 = acc[ai][bj][m][0] * rs, v1 = acc[ai][bj][m][1] * rs;
                    u32x2 w; w.x = pg8::cvt_pk_bf16(silu_f(v0[0]) * v0[1], silu_f(v0[2]) * v0[3]); w.y = pg8::cvt_pk_bf16(silu_f(v1[0]) * v1[1], silu_f(v1[2]) * v1[3]);
                    __hip_atomic_store((GAS unsigned long long*)(hmid + (size_t)(row & ~15) * DEXP + ((col0 >> 3) + bj * 8) * 128 + (row & 15) * 8 + (col0 & 4)), (unsigned long long)w.x | ((unsigned long long)w.y << 32), __ATOMIC_RELAXED, __HIP_MEMORY_SCOPE_AGENT); } }
    }
};
struct EpiDown {
    static constexpr bool PERM = true; GAS bf16_t* Y; const GAS float* slot_w;
    __device__ __forceinline__ void operator()(AccRef acc, const pg8::Unit& u, int wr, int wc, int fr, int fq) const {
        { const int _l = lane_now(); fr = _l & 15; fq = _l >> 4; }
        const int row0 = u.pm * 256 + wr * 64 + fr, col0 = u.pn * 256 + wc * 32 + 8 * fq;
        float gwv[2][4];
#pragma unroll
        for (int ai = 0; ai < 2; ++ai)
#pragma unroll
            for (int m = 0; m < 4; ++m) gwv[ai][m] = slot_w[row0 + ai * 128 + m * 16];
#pragma unroll
        for (int ai = 0; ai < 2; ++ai)
#pragma unroll
            for (int m = 0; m < 4; ++m) { const int row = row0 + ai * 128 + m * 16; const float gw = gwv[ai][m]; GAS bf16_t* rowp = Y + (size_t)row * DM + col0;
#pragma unroll
                for (int bj = 0; bj < 2; ++bj) *(GAS u32x4*)(rowp + bj * 128) = pack8(acc[ai][bj][m][0] * gw, acc[ai][bj][m][1] * gw); }
    }
};

#define CAS __attribute__((address_space(4)))
#if defined(__HIP_DEVICE_COMPILE__)
#define ASSUME_GLOBAL(p) do { __builtin_assume(!__builtin_amdgcn_is_shared((const __attribute__((address_space(0))) GAS void*)(p))); __builtin_assume(!__builtin_amdgcn_is_private((const __attribute__((address_space(0))) GAS void*)(p))); } while (0)
#else
#define ASSUME_GLOBAL(p) do { } while (0)
#endif
struct Frame {
    LAS unsigned char* lds; int tid, lane, wave, G, gw, ngw;
    const CAS unsigned char* ka; GAS float* out; GAS unsigned char* ws;
    __device__ __forceinline__ const GAS float* inp(int i) const { const CAS unsigned char* p = ka; asm volatile("" : "+s"(p)); const GAS float* r = (const GAS float*)(((const float* const CAS*)p)[i]); return r; }
};
enum { I_X = 0, I_MEM, I_MIXG, I_WIN, I_RPB, I_RETG, I_POOLW, I_POOLS, I_CONVW, I_ALOG, I_DTB, I_GDNG, I_WOUT, I_MQG, I_MKVG, I_WQ, I_WK, I_WV, I_WO, I_FFNG, I_WGRP, I_BGRP, I_WRT, I_BRT, I_WGATE, I_WUP, I_WDOWN, I_FING };

__device__ __forceinline__ void tr_item(const GAS float* W, int ldw, int nvalid, const GAS float* gain, float scale, GAS bf16_t* WT, int ldt, int row_off, int row_mul,
                                        LAS float* scr, int kb, int nb, int lane) {
    const int k0 = 64 * kb, n0 = 32 * nb, n4 = (lane & 7) * 4, kr = lane >> 3;
    f32x4 v[8];
    const bool full = (n0 + n4 + 3 < nvalid);
#pragma unroll
    for (int i = 0; i < 8; ++i) { const int kk = 8 * i + kr; const GAS float* p = W + (size_t)(k0 + kk) * ldw + n0 + n4;
        if (full) v[i] = *(const GAS f32x4*)p;
        else { v[i] = (f32x4){0.f, 0.f, 0.f, 0.f};
#pragma unroll
            for (int j = 0; j < 4; ++j) if (n0 + n4 + j < nvalid) v[i][j] = p[j]; } }
#pragma unroll
    for (int i = 0; i < 8; ++i) { const int kk = 8 * i + kr; const float sc = gain ? gain[k0 + kk] * scale : scale;
#pragma unroll
        for (int j = 0; j < 4; ++j) scr[kk * 33 + n4 + j] = v[i][j] * sc; }
    LDS_WAIT(); asm volatile("" ::: "memory");
    const int c = lane & 7;
#pragma unroll
    for (int j = 0; j < 4; ++j) { const int n = (lane >> 3) + 8 * j; const LAS float* s = scr + (8 * c) * 33 + n;
        u32x4 o; o.x = pk2(s[0 * 33], s[1 * 33]); o.y = pk2(s[2 * 33], s[3 * 33]); o.z = pk2(s[4 * 33], s[5 * 33]); o.w = pk2(s[6 * 33], s[7 * 33]);
        *(GAS u32x4*)(WT + (size_t)(row_off + (n0 + n) * row_mul) * ldt + k0 + 8 * c) = o; }
    LDS_WAIT(); asm volatile("" ::: "memory");
}

__device__ __forceinline__ float row_to_bf16(const GAS float* xrow, GAS bf16_t* orow, const GAS float* gain, bool norm, int lane) {
    const GAS f32x4* xr = (const GAS f32x4*)xrow + lane;
    f32x4 v[4]; float s = 0.f;
#pragma unroll
    for (int j = 0; j < 4; ++j) { v[j] = xr[64 * j]; s += (v[j].x * v[j].x + v[j].y * v[j].y) + (v[j].z * v[j].z + v[j].w * v[j].w); }
    s = wave_sum(s);
    if (norm) { const float rs = rsqrtf(s * (1.0f / DM) + EPS);
#pragma unroll
        for (int j = 0; j < 4; ++j) { const f32x4 g = ((const GAS f32x4*)gain)[lane + 64 * j]; v[j] = v[j] * rs * g; } }
    GAS u32x2* o8 = (GAS u32x2*)orow + lane;
#pragma unroll
    for (int j = 0; j < 4; ++j) { u32x2 w; w.x = pk2(v[j].x, v[j].y); w.y = pk2(v[j].z, v[j].w); o8[64 * j] = w; }
    return s;
}

__device__ __forceinline__ void p0_prologue(Frame& F) {
    GAS unsigned char* ws = F.ws;
    LAS float* scr = (LAS float*)(F.lds + F.wave * 16384);
    constexpr int I_IN = 16 * 96, I_SQ = 16 * 32;
    constexpr int PER_L = I_IN + 4 * I_SQ;
    for (int it = F.gw; it < 2 * PER_L; it += F.ngw) {
        const int l = it / PER_L; int r = it % PER_L;
        if (r < I_IN) { tr_item(F.inp(I_WIN) + (size_t)l * DM * 3088, 3088, 3088, F.inp(I_MIXG) + l * DM, 1.f, (GAS bf16_t*)(ws + WS_WIN) + (size_t)l * PINP * DM, DM, 0, 1, scr, r / 96, r % 96, F.lane); continue; }
        r -= I_IN;
        if (r < I_SQ) { tr_item(F.inp(I_WOUT) + (size_t)l * DM * DM, DM, DM, nullptr, 1.f, (GAS bf16_t*)(ws + WS_WOUT) + (size_t)l * DM * DM, DM, 0, 1, scr, r / 32, r % 32, F.lane); continue; }
        r -= I_SQ;
        if (r < I_SQ) { tr_item(F.inp(I_WK) + (size_t)l * DM * DM, DM, DM, nullptr, 1.f, (GAS bf16_t*)(ws + WS_WKV) + (size_t)l * 2048 * DM, DM, 0, 1, scr, r / 32, r % 32, F.lane); continue; }
        r -= I_SQ;
        if (r < I_SQ) { tr_item(F.inp(I_WV) + (size_t)l * DM * DM, DM, DM, nullptr, 1.f, (GAS bf16_t*)(ws + WS_WKV) + (size_t)l * 2048 * DM, DM, 1024, 1, scr, r / 32, r % 32, F.lane); continue; }
        r -= I_SQ;
        tr_item(F.inp(I_WO) + (size_t)l * DM * DM, DM, DM, nullptr, 1.f, (GAS bf16_t*)(ws + WS_WOT) + (size_t)l * DM * DM, DM, 0, 1, scr, r / 32, r % 32, F.lane);
    }
    {   const GAS float* X = F.inp(I_X); GAS bf16_t* xbp = (GAS bf16_t*)(ws + WS_XB); GAS float* ssqp = (GAS float*)(ws + WS_SSQ);
        for (int m0 = F.gw * 4; m0 < NTOK; m0 += F.ngw * 4) {
            f32x4 v[4][4];
#pragma unroll
            for (int k = 0; k < 4; ++k)
#pragma unroll
                for (int j = 0; j < 4; ++j) v[k][j] = ((const GAS f32x4*)(X + (size_t)(m0 + k) * DM))[F.lane + 64 * j];
#pragma unroll
            for (int k = 0; k < 4; ++k) { float sq = 0.f; GAS u32x2* o8 = (GAS u32x2*)(xbp + (size_t)(m0 + k) * DM) + F.lane;
#pragma unroll
                for (int j = 0; j < 4; ++j) { sq += (v[k][j].x * v[k][j].x + v[k][j].y * v[k][j].y) + (v[k][j].z * v[k][j].z + v[k][j].w * v[k][j].w);
                    u32x2 w; w.x = pk2(v[k][j].x, v[k][j].y); w.y = pk2(v[k][j].z, v[k][j].w); o8[64 * j] = w; }
                sq = wave_sum(sq);
                if (F.lane < 16) ssqp[(size_t)(m0 + k) * 16 + F.lane] = (F.lane == 0) ? sq : 0.f;
                if (F.lane == 0) ((GAS float*)(ws + WS_TAB + TAB_RSTD))[m0 + k] = rsqrtf(sq * (1.0f / DM) + EPS); } }
        for (int r = F.gw; r < 2048; r += F.ngw) { const int l = r >> 10;
            row_to_bf16(F.inp(I_MEM) + (size_t)(r & 1023) * DM, (GAS bf16_t*)(ws + WS_MEMN) + (size_t)r * DM, F.inp(I_MKVG) + l * DM, true, F.lane); }
    }
    const size_t gt = (size_t)blockIdx.x * NTHREADS + F.tid, ngt = (size_t)F.G * NTHREADS;
    {
        GAS bf16_t* o = (GAS bf16_t*)(ws + WS_WQB);
        for (size_t i = gt; i < (size_t)2 * DM * DM / 4; i += ngt) { const size_t e = i * 4; const int l = (int)(e >> 20), k = (int)((e >> 10) & 1023);
            const f32x4 w = *(const GAS f32x4*)(F.inp(I_WQ) + e); const float g = F.inp(I_MQG)[l * DM + k] * 0.0625f;
            u32x2 p; p.x = pk2(w.x * g, w.y * g); p.y = pk2(w.z * g, w.w * g); *(GAS u32x2*)(o + e) = p; }
    }
    {
        GAS float* tab = (GAS float*)(ws + WS_TAB + TAB_ROPE);
        for (size_t i = gt; i < (size_t)SEQ * 32; i += ngt) { const int pos = (int)(i >> 5), j = (int)(i & 31);
            const float inv = exp2f(-(float)j * (13.287712379549449f / 32.0f)); const float ang = (float)pos * inv;
            const double rev = (double)ang * 0.15915494309189535; const float fr = (float)(rev - floor(rev));
            tab[i * 2] = __builtin_amdgcn_cosf(fr); tab[i * 2 + 1] = __builtin_amdgcn_sinf(fr); }
    }
    {
        GAS bf16_t* fr = (GAS bf16_t*)(ws + WS_TAB + TAB_RFR);
        for (size_t i = gt; i < (size_t)2 * 49152; i += ngt) { const int l = (int)(i / 49152), r = (int)(i % 49152), j = r & 7, ln = (r >> 3) & 63, ct = (r >> 9) % 3, ks = r / 1536;
            const int k = 32 * ks + 8 * (ln >> 4) + j, o = 16 * ct + (ln & 15);
            float w = 0.f; if (o < 32) w = F.inp(I_WRT)[(size_t)l * DM * 32 + (size_t)k * 32 + o]; else if (o < 36) w = F.inp(I_WGRP)[(size_t)l * DM * 4 + (size_t)k * 4 + (o - 32)];
            w *= F.inp(I_FFNG)[l * DM + k];
            const unsigned hi = f2bf(w); const float lo = w - __builtin_bit_cast(float, hi << 16);
            fr[(size_t)l * 98304 + r] = (bf16_t)hi; fr[(size_t)l * 98304 + 49152 + r] = (bf16_t)f2bf(lo); }
    }
    {
        GAS bf16_t* fr = (GAS bf16_t*)(ws + WS_TAB + TAB_ABF);
        for (size_t i = gt; i < (size_t)2 * 16384; i += ngt) { const int l = (int)(i >> 14), r = (int)(i & 16383), j = r & 7, ln = (r >> 3) & 63, ks = r >> 9;
            const int k = 32 * ks + 8 * (ln >> 4) + j, o = ln & 15;
            fr[i] = (bf16_t)f2bf(F.inp(I_WIN)[(size_t)l * DM * 3088 + (size_t)k * 3088 + 3072 + o] * F.inp(I_MIXG)[l * DM + k]); }
    }
    {
        GAS bf16_t* pt = (GAS bf16_t*)(ws + WS_TAB + TAB_POOL);
        for (size_t i = gt; i < (size_t)2 * 4 * 64 * 64; i += ngt) { const int c = (int)(i & 63), e = (int)((i >> 6) & 63), gi = (int)((i >> 12) & 3), l = (int)(i >> 14);
            pt[(i & ~(size_t)4095) + ((e >> 4) * 8 + (c >> 3)) * 128 + (e & 15) * 8 + (c & 7)] = (bf16_t)f2bf(F.inp(I_POOLW)[(((size_t)l * 4 + gi) * 64 + c) * 64 + e] * F.inp(I_POOLS)[l * 256 + gi * 64 + e]); }
    }
}

__device__ __forceinline__ void convert_experts_queue(Frame& F, int l) {
    GAS unsigned char* ws = F.ws;
    LAS float* scr = (LAS float*)(F.lds + F.wave * 16384);
    constexpr int IG = 16 * 16, ID = 8 * 32, PER_E = 2 * IG + ID;
    GAS unsigned* q = (GAS unsigned*)(ws + WS_CTL) + CW_CQ + l * 64;
    const GAS float* wg = F.inp(I_WGATE); const GAS float* wu = F.inp(I_WUP); const GAS float* wd = F.inp(I_WDOWN); const GAS float* gn = F.inp(I_FFNG) + l * DM;
    LAS unsigned* qs = (LAS unsigned*)(F.lds + LDS_MISC + 2048);
    for (;;) {
        __syncthreads();
        if (F.tid == 0) *qs = __hip_atomic_fetch_add(q, 64u, __ATOMIC_RELAXED, __HIP_MEMORY_SCOPE_AGENT);
        __syncthreads();
        const unsigned qb = *qs;
        if (qb >= (unsigned)(NEXP * PER_E)) break;
    for (int it = (int)qb + F.wave; it < (int)qb + 64 && it < NEXP * PER_E; it += NWAVES) {
        const int e = (int)it / PER_E; int r = (int)it % PER_E; const size_t le = (size_t)l * NEXP + e;
        if (r < IG) { tr_item(wg + le * DM * DEXP, DEXP, DEXP, gn, 1.f, (GAS bf16_t*)(ws + WS_WGU) + (size_t)e * 1024 * DM, DM, 0, 2, scr, r / 16, r % 16, F.lane); continue; }
        r -= IG;
        if (r < IG) { tr_item(wu + le * DM * DEXP, DEXP, DEXP, gn, 1.f, (GAS bf16_t*)(ws + WS_WGU) + (size_t)e * 1024 * DM, DM, 1, 2, scr, r / 16, r % 16, F.lane); continue; }
        r -= IG;
        tr_item(wd + le * DEXP * DM, DM, DM, nullptr, 1.f, (GAS bf16_t*)(ws + WS_WD) + (size_t)e * DM * DEXP, DEXP, 0, 1, scr, r / 32, r % 32, F.lane);
    }
    }
}

__device__ __forceinline__ size_t PJ(size_t t, int c) { return ((size_t)(c >> 8) * NTOK + t) * 256 + (c & 255); }
#define MFMA16(a, b, c) __builtin_amdgcn_mfma_f32_16x16x32_bf16((a), (b), (c), 0, 0, 0)

__device__ __forceinline__ void pool_item(Frame& F, const GAS bf16_t* proj, const GAS bf16_t* pt, GAS bf16_t* ycat, int item) {
    int lane = F.lane; asm volatile("" : "+v"(lane));
    const int g = lane >> 4, t = item * 16 + (lane & 15), s = t & (SEQ - 1);
    const GAS bf16_t* base = proj + ((size_t)7 * NTOK + (t - s)) * 256;
#pragma unroll
    for (int gi = 0; gi < 4; ++gi) {
        const int half = 1 << gi; const int lo = max(s - half, 0), hi = min(s + half, SEQ); const float inv = 1.0f / (float)(hi - lo);
        f32x4 acc[4];
#pragma unroll
        for (int et = 0; et < 4; ++et) acc[et] = (f32x4){0.f, 0.f, 0.f, 0.f};
        bf16x8 wf[8];
#pragma unroll
        for (int ks = 0; ks < 2; ++ks)
#pragma unroll
            for (int et = 0; et < 4; ++et) wf[ks * 4 + et] = *(const GAS bf16x8*)(pt + (size_t)gi * 4096 + (et * 8 + ks * 4 + g) * 128 + (lane & 15) * 8);
#pragma unroll
        for (int ks = 0; ks < 2; ++ks) {
            const int cb = (gi * 8 + ks * 4 + g) * 128;
            float sum[8];
#pragma unroll
            for (int j = 0; j < 8; ++j) sum[j] = 0.f;
#pragma unroll
            for (int w2 = 0; w2 < 2 * half; ++w2) { const int s2 = s - half + w2; const bool ok = (s2 >= 0) && (s2 < SEQ);
                u32x4 v = (u32x4){0u, 0u, 0u, 0u}; if (ok) v = *(const GAS u32x4*)((const GAS char*)base + (unsigned)((s2 & ~15) * 512 + cb * 2 + (s2 & 15) * 16));
                sum[0] += bflo(v.x); sum[1] += bfhi(v.x); sum[2] += bflo(v.y); sum[3] += bfhi(v.y); sum[4] += bflo(v.z); sum[5] += bfhi(v.z); sum[6] += bflo(v.w); sum[7] += bfhi(v.w); }
            const u32x4 c = *(const GAS u32x4*)((const GAS char*)base + (unsigned)((s & ~15) * 512 + cb * 2 + (s & 15) * 16));
            u32x4 dd; dd.x = pk2(sum[0] * inv - bflo(c.x), sum[1] * inv - bfhi(c.x)); dd.y = pk2(sum[2] * inv - bflo(c.y), sum[3] * inv - bfhi(c.y));
            dd.z = pk2(sum[4] * inv - bflo(c.z), sum[5] * inv - bfhi(c.z)); dd.w = pk2(sum[6] * inv - bflo(c.w), sum[7] * inv - bfhi(c.w));
            const bf16x8 bfrag = __builtin_bit_cast(bf16x8, dd);
            if (ks == 0) asm volatile("" : "+v"(wf[0]), "+v"(wf[1]), "+v"(wf[2]), "+v"(wf[3]), "+v"(wf[4]), "+v"(wf[5]), "+v"(wf[6]), "+v"(wf[7]));
#pragma unroll
            for (int et = 0; et < 4; ++et) acc[et] = MFMA16(wf[ks * 4 + et], bfrag, acc[et]);
        }
#pragma unroll
        for (int et = 0; et < 4; ++et) { u32x2 w; w.x = pk2(acc[et][0], acc[et][1]); w.y = pk2(acc[et][2], acc[et][3]);
            *(GAS u32x2*)(ycat + (size_t)t * DM + 512 + gi * 64 + et * 16 + g * 4) = w; }
    }
}

__device__ __forceinline__ void na_item(Frame& F, const GAS bf16_t* proj, const GAS bf16_t* vta, const LAS float* rpbs, GAS bf16_t* ycat, int item) {
    const int lane = F.lane, g = lane >> 4, ql = lane & 15;
    const int n = item & 3, r = (item >> 2) & 127, h = (item >> 9) & 3, b = item >> 11; const size_t tb = (size_t)b * SEQ;
    const int kr0 = min(max(r - 4, 0), 120), band = min(max(n * 16 - 8, 0), 32), qc = n * 16 + ql, win = min(max(qc - 8, 0), 48);
    const GAS bf16_t* qrow = proj + (tb + r * 64 + n * 16) * 256 + (h * 8 + g) * 128 + ql * 8;
    const bf16x8 q0 = *(const GAS bf16x8*)qrow, q1 = *(const GAS bf16x8*)(qrow + 4 * 128);
    f32x4 S[16];
    const int kcl = band + 8 * (ql >> 2) + (ql & 3);
#pragma unroll
    for (int tb8 = 0; tb8 < 2; ++tb8) { bf16x8 kf[16];
#pragma unroll
        for (int tt = 0; tt < 8; ++tt) { const int t = tb8 * 8 + tt, i = t >> 1, hf = t & 1; const int kc = kcl + 4 * hf;
            const GAS bf16_t* krow = proj + ((size_t)NTOK + tb + (size_t)(kr0 + i) * 64 + (kc & ~15)) * 256 + (h * 8 + g) * 128 + (kc & 15) * 8;
            kf[2 * tt] = *(const GAS bf16x8*)krow; kf[2 * tt + 1] = *(const GAS bf16x8*)(krow + 4 * 128); }
        asm volatile("" : "+v"(kf[0]), "+v"(kf[1]), "+v"(kf[2]), "+v"(kf[3]), "+v"(kf[4]), "+v"(kf[5]), "+v"(kf[6]), "+v"(kf[7]), "+v"(kf[8]), "+v"(kf[9]), "+v"(kf[10]), "+v"(kf[11]), "+v"(kf[12]), "+v"(kf[13]), "+v"(kf[14]), "+v"(kf[15]));
#pragma unroll
        for (int tt = 0; tt < 8; ++tt) { f32x4 a = (f32x4){0.f, 0.f, 0.f, 0.f}; a = MFMA16(kf[2 * tt], q0, a); a = MFMA16(kf[2 * tt + 1], q1, a); S[tb8 * 8 + tt] = a; } }
    float mx = -3.0e38f;
#pragma unroll
    for (int t = 0; t < 16; ++t) { const int i = t >> 1, hf = t & 1; const LAS float* rp = rpbs + h * 465 + (kr0 + i - r + 7) * 31;
#pragma unroll
        for (int jj = 0; jj < 4; ++jj) { const int kc = band + g * 8 + hf * 4 + jj; const bool ok = (kc >= win) && (kc < win + 16);
            const float sc = ok ? S[t][jj] * 0.125f + rp[ok ? kc - qc + 15 : 0] : -3.0e38f; S[t][jj] = sc; mx = fmaxf(mx, sc); } }
    mx = fmaxf(mx, shfl_xor_f(mx, 16)); mx = fmaxf(mx, shfl_xor_f(mx, 32));
    float sum = 0.f;
#pragma unroll
    for (int t = 0; t < 16; ++t)
#pragma unroll
        for (int jj = 0; jj < 4; ++jj) { const float p = __expf(S[t][jj] - mx); S[t][jj] = p; sum += p; }
    sum += shfl_xor_f(sum, 16); sum += shfl_xor_f(sum, 32);
    const float inv = 1.0f / sum;
    f32x4 O[4];
#pragma unroll
    for (int dt = 0; dt < 4; ++dt) O[dt] = (f32x4){0.f, 0.f, 0.f, 0.f};
#pragma unroll
    for (int vb4 = 0; vb4 < 2; ++vb4) { bf16x8 vl[16];
#pragma unroll
        for (int ii = 0; ii < 4; ++ii) { const int i = vb4 * 4 + ii;
            const GAS bf16_t* vb = vta + ((((size_t)(b * 128 + kr0 + i) * 4 + h) * 4) * 8 + (band >> 3) + g) * 128 + ql * 8;
#pragma unroll
            for (int dt = 0; dt < 4; ++dt) vl[ii * 4 + dt] = *(const GAS bf16x8*)(vb + (size_t)dt * 8 * 128); }
        asm volatile("" : "+v"(vl[0]), "+v"(vl[1]), "+v"(vl[2]), "+v"(vl[3]), "+v"(vl[4]), "+v"(vl[5]), "+v"(vl[6]), "+v"(vl[7]), "+v"(vl[8]), "+v"(vl[9]), "+v"(vl[10]), "+v"(vl[11]), "+v"(vl[12]), "+v"(vl[13]), "+v"(vl[14]), "+v"(vl[15]));
#pragma unroll
        for (int ii = 0; ii < 4; ++ii) { const int i = vb4 * 4 + ii;
            u32x4 pw; pw.x = pk2(S[2 * i][0], S[2 * i][1]); pw.y = pk2(S[2 * i][2], S[2 * i][3]); pw.z = pk2(S[2 * i + 1][0], S[2 * i + 1][1]); pw.w = pk2(S[2 * i + 1][2], S[2 * i + 1][3]);
            const bf16x8 pf = __builtin_bit_cast(bf16x8, pw);
#pragma unroll
            for (int dt = 0; dt < 4; ++dt) O[dt] = MFMA16(pf, vl[ii * 4 + dt], O[dt]); } }
#pragma unroll
    for (int jj = 0; jj < 4; ++jj) { const float iq = shfl_f(inv, g * 4 + jj); GAS bf16_t* orow = ycat + (tb + r * 64 + n * 16 + g * 4 + jj) * DM + h * 64 + ql;
#pragma unroll
        for (int dt = 0; dt < 4; ++dt) orow[dt * 16] = (bf16_t)f2bf(O[dt][jj] * iq); }
}

constexpr int NA_TILE = 8192;
#define NA_BAR() do { asm volatile("s_waitcnt lgkmcnt(0)" ::: "memory"); __builtin_amdgcn_s_barrier(); asm volatile("" ::: "memory"); } while (0)
__device__ __forceinline__ void na_rounds(Frame& F, const GAS bf16_t* proj, const GAS bf16_t* vta, const LAS float* rpbs, GAS bf16_t* ycat, int cs) {
    int tid = F.tid; asm volatile("" : "+v"(tid));
    int wave = F.wave; asm volatile("" : "+s"(wave));
    const int lane = tid & 63, g = lane >> 4, ql = lane & 15;
    const int n = wave & 3, r0 = (cs * 2) & 127, r = r0 + (wave >> 2), h = (cs >> 6) & 3;
    const int kb = min(max(r0 - 4, 0), 120), kr0 = min(max(r - 4, 0), 120), lr0 = kr0 - kb;
    const int band = min(max(n * 16 - 8, 0), 32), qc = n * 16 + ql, win = min(max(qc - 8, 0), 48);
    const int kcl = band + 8 * (ql >> 2) + (ql & 3);
    LAS unsigned char* tile = F.lds + NA_TILE;
    u32x4 pre[9];
#pragma unroll
    for (int p = 0; p < 9; ++p) { const int row = min(kb + p, 127); pre[p] = *(const GAS u32x4*)(proj + ((size_t)NTOK + (size_t)row * 64 + (tid >> 7) * 16) * 256 + h * 8 * 128 + (tid & 127) * 8); }
    for (int b = 0; b < 4; ++b) { const size_t tb = (size_t)b * SEQ;
#pragma unroll
        for (int p = 0; p < 9; ++p) *(LAS u32x4*)(tile + p * 8192 + tid * 16) = pre[p];
        NA_BAR();
#pragma unroll
        for (int p = 0; p < 9; ++p) { const int row = min(kb + p, 127); pre[p] = *(const GAS u32x4*)(vta + ((size_t)(b * 128 + row) * 4 + h) * 4096 + tid * 8); }
        const GAS bf16_t* qrow = proj + (tb + r * 64 + n * 16) * 256 + (h * 8 + g) * 128 + ql * 8;
        const bf16x8 q0 = *(const GAS bf16x8*)qrow, q1 = *(const GAS bf16x8*)(qrow + 4 * 128);
        f32x4 S[16];
#pragma unroll
        for (int tb8 = 0; tb8 < 2; ++tb8) { bf16x8 kf[16];
#pragma unroll
            for (int tt = 0; tt < 8; ++tt) { const int t = tb8 * 8 + tt, i = t >> 1, hf = t & 1; const int kc = kcl + 4 * hf;
                const LAS unsigned char* kp = tile + (lr0 + i) * 8192 + (kc >> 4) * 2048 + g * 256 + (kc & 15) * 16;
                kf[2 * tt] = *(const LAS bf16x8*)kp; kf[2 * tt + 1] = *(const LAS bf16x8*)(kp + 4 * 256); }
            asm volatile("s_waitcnt lgkmcnt(0)" : "+v"(kf[0]), "+v"(kf[1]), "+v"(kf[2]), "+v"(kf[3]), "+v"(kf[4]), "+v"(kf[5]), "+v"(kf[6]), "+v"(kf[7]), "+v"(kf[8]), "+v"(kf[9]), "+v"(kf[10]), "+v"(kf[11]), "+v"(kf[12]), "+v"(kf[13]), "+v"(kf[14]), "+v"(kf[15]));
#pragma unroll
            for (int tt = 0; tt < 8; ++tt) { f32x4 a = (f32x4){0.f, 0.f, 0.f, 0.f}; a = MFMA16(kf[2 * tt], q0, a); a = MFMA16(kf[2 * tt + 1], q1, a); S[tb8 * 8 + tt] = a; } }
        float mx = -3.0e38f;
#pragma unroll
        for (int t = 0; t < 16; ++t) { const int i = t >> 1, hf = t & 1; const LAS float* rp = rpbs + h * 465 + (kr0 + i - r + 7) * 31;
#pragma unroll
            for (int jj = 0; jj < 4; ++jj) { const int kc = band + g * 8 + hf * 4 + jj; const bool ok = (kc >= win) && (kc < win + 16);
                const float sc = ok ? S[t][jj] * 0.125f + rp[ok ? kc - qc + 15 : 0] : -3.0e38f; S[t][jj] = sc; mx = fmaxf(mx, sc); } }
        mx = fmaxf(mx, shfl_xor_f(mx, 16)); mx = fmaxf(mx, shfl_xor_f(mx, 32));
        float sum = 0.f;
#pragma unroll
        for (int t = 0; t < 16; ++t)
#pragma unroll
            for (int jj = 0; jj < 4; ++jj) { const float p = __expf(S[t][jj] - mx); S[t][jj] = p; sum += p; }
        sum += shfl_xor_f(sum, 16); sum += shfl_xor_f(sum, 32);
        const float inv = 1.0f / sum;
        NA_BAR();
#pragma unroll
        for (int p = 0; p < 9; ++p) *(LAS u32x4*)(tile + p * 8192 + tid * 16) = pre[p];
        NA_BAR();
        if (b < 3) {
#pragma unroll
            for (int p = 0; p < 9; ++p) { const int row = min(kb + p, 127); pre[p] = *(const GAS u32x4*)(proj + ((size_t)NTOK + tb + SEQ + (size_t)row * 64 + (tid >> 7) * 16) * 256 + h * 8 * 128 + (tid & 127) * 8); } }
        f32x4 O[4];
#pragma unroll
        for (int dt = 0; dt < 4; ++dt) O[dt] = (f32x4){0.f, 0.f, 0.f, 0.f};
#pragma unroll
        for (int vb4 = 0; vb4 < 2; ++vb4) { bf16x8 vl[16];
#pragma unroll
            for (int ii = 0; ii < 4; ++ii) { const int i = vb4 * 4 + ii; const LAS unsigned char* vp = tile + (lr0 + i) * 8192 + ((band >> 3) + g) * 256 + ql * 16;
#pragma unroll
                for (int dt = 0; dt < 4; ++dt) vl[ii * 4 + dt] = *(const LAS bf16x8*)(vp + dt * 2048); }
            asm volatile("s_waitcnt lgkmcnt(0)" : "+v"(vl[0]), "+v"(vl[1]), "+v"(vl[2]), "+v"(vl[3]), "+v"(vl[4]), "+v"(vl[5]), "+v"(vl[6]), "+v"(vl[7]), "+v"(vl[8]), "+v"(vl[9]), "+v"(vl[10]), "+v"(vl[11]), "+v"(vl[12]), "+v"(vl[13]), "+v"(vl[14]), "+v"(vl[15]));
#pragma unroll
            for (int ii = 0; ii < 4; ++ii) { const int i = vb4 * 4 + ii;
                u32x4 pw; pw.x = pk2(S[2 * i][0], S[2 * i][1]); pw.y = pk2(S[2 * i][2], S[2 * i][3]); pw.z = pk2(S[2 * i + 1][0], S[2 * i + 1][1]); pw.w = pk2(S[2 * i + 1][2], S[2 * i + 1][3]);
                const bf16x8 pf = __builtin_bit_cast(bf16x8, pw);
#pragma unroll
                for (int dt = 0; dt < 4; ++dt) O[dt] = MFMA16(pf, vl[ii * 4 + dt], O[dt]); } }
#pragma unroll
        for (int jj = 0; jj < 4; ++jj) { const float iq = shfl_f(inv, g * 4 + jj); GAS bf16_t* orow = ycat + (tb + r * 64 + n * 16 + g * 4 + jj) * DM + h * 64 + ql;
#pragma unroll
            for (int dt = 0; dt < 4; ++dt) orow[dt * 16] = (bf16_t)f2bf(O[dt][jj] * iq); }
        NA_BAR();
    }
}

constexpr int RT_LD = 136;
__device__ __forceinline__ void ret_r1_item(Frame& F, GAS bf16_t* proj, const GAS float* rope, GAS bf16_t* KVT, int item) {
    int tid = F.tid; asm volatile("" : "+v"(tid));
    const int lane = tid & 63, g = lane >> 4, ql = lane & 15;
    const int c = item & 63, h = (item >> 6) & 3, b = item >> 8;
    const float lgf = log2f(1.0f - exp2f(-5.0f - (float)h)), lgb = log2f(1.0f - exp2f(-5.0f - (float)(3 - h)));
    LAS bf16_t* KT = (LAS bf16_t*)F.lds; LAS bf16_t* VTF = KT + 64 * RT_LD; LAS bf16_t* VTB = VTF + 64 * RT_LD;
    {
        constexpr size_t TS = (size_t)NTOK * 256;
        const int i = (tid >> 6) * 16 + (tid & 15), p = (tid >> 4) & 3, s = c * 128 + i; const size_t t = (size_t)b * SEQ + s;
        GAS bf16_t* row = proj + ((size_t)3 * NTOK + (t & ~(size_t)15)) * 256 + (h * 8 + p) * 128 + (i & 15) * 8;
        const u32x4 q1 = *(const GAS u32x4*)(row), q2 = *(const GAS u32x4*)(row + 512), k1 = *(const GAS u32x4*)(row + TS), k2 = *(const GAS u32x4*)(row + TS + 512);
        const GAS f32x4* cs = (const GAS f32x4*)(rope + ((size_t)s * 32 + 8 * p) * 2);
        float qa[8], qb[8], ka[8], kb[8];
        qa[0] = bflo(q1.x); qa[1] = bfhi(q1.x); qa[2] = bflo(q1.y); qa[3] = bfhi(q1.y); qa[4] = bflo(q1.z); qa[5] = bfhi(q1.z); qa[6] = bflo(q1.w); qa[7] = bfhi(q1.w);
        qb[0] = bflo(q2.x); qb[1] = bfhi(q2.x); qb[2] = bflo(q2.y); qb[3] = bfhi(q2.y); qb[4] = bflo(q2.z); qb[5] = bfhi(q2.z); qb[6] = bflo(q2.w); qb[7] = bfhi(q2.w);
        ka[0] = bflo(k1.x); ka[1] = bfhi(k1.x); ka[2] = bflo(k1.y); ka[3] = bfhi(k1.y); ka[4] = bflo(k1.z); ka[5] = bfhi(k1.z); ka[6] = bflo(k1.w); ka[7] = bfhi(k1.w);
        kb[0] = bflo(k2.x); kb[1] = bfhi(k2.x); kb[2] = bflo(k2.y); kb[3] = bfhi(k2.y); kb[4] = bflo(k2.z); kb[5] = bfhi(k2.z); kb[6] = bflo(k2.w); kb[7] = bfhi(k2.w);
        float qo1[8], qo2[8], ko1[8], ko2[8];
#pragma unroll
        for (int m = 0; m < 4; ++m) { const f32x4 w = cs[m];
            { const int j = 2 * m; const float cc = w.x, sn = w.y; qo1[j] = qa[j] * cc - qb[j] * sn; qo2[j] = qa[j] * sn + qb[j] * cc; ko1[j] = (ka[j] * cc - kb[j] * sn) * 0.125f; ko2[j] = (ka[j] * sn + kb[j] * cc) * 0.125f; }
            { const int j = 2 * m + 1; const float cc = w.z, sn = w.w; qo1[j] = qa[j] * cc - qb[j] * sn; qo2[j] = qa[j] * sn + qb[j] * cc; ko1[j] = (ka[j] * cc - kb[j] * sn) * 0.125f; ko2[j] = (ka[j] * sn + kb[j] * cc) * 0.125f; } }
        u32x4 o;
        o.x = pk2(qo1[0], qo1[1]); o.y = pk2(qo1[2], qo1[3]); o.z = pk2(qo1[4], qo1[5]); o.w = pk2(qo1[6], qo1[7]); *(GAS u32x4*)(row) = o;
        o.x = pk2(qo2[0], qo2[1]); o.y = pk2(qo2[2], qo2[3]); o.z = pk2(qo2[4], qo2[5]); o.w = pk2(qo2[6], qo2[7]); *(GAS u32x4*)(row + 512) = o;
        u32x4 ok1, ok2;
        ok1.x = pk2(ko1[0], ko1[1]); ok1.y = pk2(ko1[2], ko1[3]); ok1.z = pk2(ko1[4], ko1[5]); ok1.w = pk2(ko1[6], ko1[7]); *(GAS u32x4*)(row + TS) = ok1;
        ok2.x = pk2(ko2[0], ko2[1]); ok2.y = pk2(ko2[2], ko2[3]); ok2.z = pk2(ko2[4], ko2[5]); ok2.w = pk2(ko2[6], ko2[7]); *(GAS u32x4*)(row + TS + 512) = ok2;
        const unsigned kw1[4] = {ok1.x, ok1.y, ok1.z, ok1.w}, kw2[4] = {ok2.x, ok2.y, ok2.z, ok2.w};
#pragma unroll
        for (int j = 0; j < 8; ++j) { KT[(8 * p + j) * RT_LD + i] = (bf16_t)((kw1[j >> 1] >> ((j & 1) * 16)) & 0xffffu); KT[(32 + 8 * p + j) * RT_LD + i] = (bf16_t)((kw2[j >> 1] >> ((j & 1) * 16)) & 0xffffu); }
    }
    {   const int i = tid >> 2, p = tid & 3; const GAS bf16_t* vrow = proj + PJ((size_t)b * SEQ + c * 128 + i, 1280 + h * 64 + 16 * p);
        const u32x4 va = *(const GAS u32x4*)(vrow), vb = *(const GAS u32x4*)(vrow + 8);
        const unsigned vw[8] = {va.x, va.y, va.z, va.w, vb.x, vb.y, vb.z, vb.w};
        const float wf = exp2f((float)(127 - i) * lgf), wb = exp2f((float)i * lgb);
#pragma unroll
        for (int j = 0; j < 16; ++j) { const float v = (j & 1) ? bfhi(vw[j >> 1]) : bflo(vw[j >> 1]);
            VTF[(16 * p + j) * RT_LD + i] = (bf16_t)f2bf(v * wf); VTB[(16 * p + j) * RT_LD + i] = (bf16_t)f2bf(v * wb); }
    }
    __syncthreads();
    {
        const int dir = F.wave >> 2, et = F.wave & 3; const LAS bf16_t* VT = dir ? VTB : VTF;
        f32x4 acc[4];
#pragma unroll
        for (int dt = 0; dt < 4; ++dt) acc[dt] = (f32x4){0.f, 0.f, 0.f, 0.f};
#pragma unroll
        for (int ks = 0; ks < 4; ++ks) { const bf16x8 a = *(const LAS bf16x8*)(VT + (et * 16 + ql) * RT_LD + ks * 32 + g * 8);
#pragma unroll
            for (int dt = 0; dt < 4; ++dt) { const bf16x8 bb = *(const LAS bf16x8*)(KT + (dt * 16 + ql) * RT_LD + ks * 32 + g * 8); acc[dt] = MFMA16(a, bb, acc[dt]); } }
        GAS bf16_t* out = KVT + ((size_t)item * 2 + dir) * 4096;
#pragma unroll
        for (int dt = 0; dt < 4; ++dt)
#pragma unroll
            for (int jj = 0; jj < 4; ++jj) out[et * 1024 + (dt * 2 + (ql >> 3)) * 128 + (g * 4 + jj) * 8 + (ql & 7)] = (bf16_t)f2bf(acc[dt][jj]);
    }
    __syncthreads();
}
__device__ __forceinline__ void ret_r2_scan(Frame& F, const GAS bf16_t* KVT, GAS bf16_t* ST, size_t gt, size_t ngt) {
    for (size_t idx = gt; idx < (size_t)32 * 4096; idx += ngt) {
        const int chain = (int)(idx >> 12), el = (int)(idx & 4095), bh = chain >> 1, dir = chain & 1, h = bh & 3, hh = dir ? 3 - h : h;
        const float gC = exp2f(128.0f * log2f(1.0f - exp2f(-5.0f - (float)hh)));
        float S = 0.f;
        const size_t o0 = ((size_t)(bh * 64) * 2 + dir) * 4096 + el;
#pragma unroll
        for (int half = 0; half < 4; ++half) { bf16_t kv[16];
#pragma unroll
            for (int cc = 0; cc < 16; ++cc) { const int c = dir ? 63 - (half * 16 + cc) : half * 16 + cc; kv[cc] = KVT[o0 + (size_t)c * 8192]; }
#pragma unroll
            for (int cc = 0; cc < 16; ++cc) { const int c = dir ? 63 - (half * 16 + cc) : half * 16 + cc; ST[o0 + (size_t)c * 8192] = (bf16_t)f2bf(S); S = S * gC + bf2f(kv[cc]); } }
    }
}
__device__ __forceinline__ void ret_r3_item(Frame& F, const GAS bf16_t* proj, const GAS bf16_t* ST, const GAS float* retg, GAS bf16_t* ycat, int item) {
    int tid = F.tid; asm volatile("" : "+v"(tid));
    const int lane = tid & 63, g = lane >> 4, ql = lane & 15;
    const int c = item & 63, h = (item >> 6) & 3, b = item >> 8;
    const float lgf = log2f(1.0f - exp2f(-5.0f - (float)h)), lgb = log2f(1.0f - exp2f(-5.0f - (float)(3 - h)));
    LAS bf16_t* VT = (LAS bf16_t*)F.lds;
    const size_t t0 = (size_t)b * SEQ + c * 128;
    {   const int i = tid >> 2, p = tid & 3; const GAS bf16_t* row = proj + PJ(t0 + i, 1280 + h * 64 + 16 * p);
        const u32x4 va = *(const GAS u32x4*)(row), vb = *(const GAS u32x4*)(row + 8);
        const unsigned vw[8] = {va.x, va.y, va.z, va.w, vb.x, vb.y, vb.z, vb.w};
#pragma unroll
        for (int j = 0; j < 16; ++j) VT[(16 * p + j) * RT_LD + i] = (bf16_t)((vw[j >> 1] >> ((j & 1) * 16)) & 0xffffu); }
    __syncthreads();
    {
        const int qi = F.wave * 16 + ql; const size_t tq = t0 + qi;
        const GAS bf16_t* qrow = proj + ((size_t)3 * NTOK + t0 + F.wave * 16) * 256 + (h * 8 + g) * 128 + ql * 8;
        bf16x8 qf[2]; qf[0] = *(const GAS bf16x8*)(qrow); qf[1] = *(const GAS bf16x8*)(qrow + 512);
        f32x4 st[8];
        {   bf16x8 kf[16];
#pragma unroll
            for (int kt = 0; kt < 8; ++kt) { const GAS bf16_t* krow = proj + ((size_t)4 * NTOK + t0 + kt * 16) * 256 + (h * 8 + g) * 128 + ql * 8; kf[2 * kt] = *(const GAS bf16x8*)(krow); kf[2 * kt + 1] = *(const GAS bf16x8*)(krow + 512); }
            asm volatile("" : "+v"(kf[0]), "+v"(kf[1]), "+v"(kf[2]), "+v"(kf[3]), "+v"(kf[4]), "+v"(kf[5]), "+v"(kf[6]), "+v"(kf[7]), "+v"(kf[8]), "+v"(kf[9]), "+v"(kf[10]), "+v"(kf[11]), "+v"(kf[12]), "+v"(kf[13]), "+v"(kf[14]), "+v"(kf[15]));
#pragma unroll
            for (int kt = 0; kt < 8; ++kt) { f32x4 a = (f32x4){0.f, 0.f, 0.f, 0.f}; a = MFMA16(kf[2 * kt], qf[0], a); a = MFMA16(kf[2 * kt + 1], qf[1], a);
#pragma unroll
                for (int jj = 0; jj < 4; ++jj) { const int df = qi - (kt * 16 + g * 4 + jj); a[jj] *= (df >= 0) ? exp2f((float)df * lgf) : exp2f((float)(-df) * lgb); }
                st[kt] = a; } }
        f32x4 oi[4], of[4], ob[4];
#pragma unroll
        for (int et = 0; et < 4; ++et) { oi[et] = (f32x4){0.f, 0.f, 0.f, 0.f}; of[et] = oi[et]; ob[et] = oi[et]; }
#pragma unroll
        for (int kp = 0; kp < 4; ++kp) { u32x4 pw; pw.x = pk2(st[2 * kp][0], st[2 * kp][1]); pw.y = pk2(st[2 * kp][2], st[2 * kp][3]); pw.z = pk2(st[2 * kp + 1][0], st[2 * kp + 1][1]); pw.w = pk2(st[2 * kp + 1][2], st[2 * kp + 1][3]);
            const bf16x8 pf = __builtin_bit_cast(bf16x8, pw);
#pragma unroll
            for (int et = 0; et < 4; ++et) { const LAS bf16_t* vr = VT + (et * 16 + ql) * RT_LD + kp * 32 + g * 4;
                const u32x2 lo = *(const LAS u32x2*)(vr), hi = *(const LAS u32x2*)(vr + 16); u32x4 aw; aw.x = lo.x; aw.y = lo.y; aw.z = hi.x; aw.w = hi.y;
                oi[et] = MFMA16(__builtin_bit_cast(bf16x8, aw), pf, oi[et]); } }
        const GAS bf16_t* sf = ST + ((size_t)item * 2) * 4096; const GAS bf16_t* sb = sf + 4096;
        {   bf16x8 sfr[8], sbr[8];
#pragma unroll
            for (int et = 0; et < 4; ++et)
#pragma unroll
                for (int ks = 0; ks < 2; ++ks) { const int o = et * 1024 + (ks * 4 + g) * 128 + ql * 8; sfr[et * 2 + ks] = *(const GAS bf16x8*)(sf + o); sbr[et * 2 + ks] = *(const GAS bf16x8*)(sb + o); }
            asm volatile("" : "+v"(sfr[0]), "+v"(sfr[1]), "+v"(sfr[2]), "+v"(sfr[3]), "+v"(sfr[4]), "+v"(sfr[5]), "+v"(sfr[6]), "+v"(sfr[7]), "+v"(sbr[0]), "+v"(sbr[1]), "+v"(sbr[2]), "+v"(sbr[3]), "+v"(sbr[4]), "+v"(sbr[5]), "+v"(sbr[6]), "+v"(sbr[7]));
#pragma unroll
            for (int et = 0; et < 4; ++et)
#pragma unroll
                for (int ks = 0; ks < 2; ++ks) { of[et] = MFMA16(sfr[et * 2 + ks], qf[ks], of[et]); ob[et] = MFMA16(sbr[et * 2 + ks], qf[ks], ob[et]); } }
        const float af = exp2f((float)(qi + 1) * lgf), abw = exp2f((float)(128 - qi) * lgb);
        float sum = 0.f;
#pragma unroll
        for (int et = 0; et < 4; ++et) { oi[et] = oi[et] + of[et] * af + ob[et] * abw; sum += (oi[et][0] + oi[et][1]) + (oi[et][2] + oi[et][3]); }
        sum += shfl_xor_f(sum, 16); sum += shfl_xor_f(sum, 32);
        const float mu = sum * (1.0f / 64.0f); float vs = 0.f;
#pragma unroll
        for (int et = 0; et < 4; ++et) { oi[et] = oi[et] - mu; vs += (oi[et][0] * oi[et][0] + oi[et][1] * oi[et][1]) + (oi[et][2] * oi[et][2] + oi[et][3] * oi[et][3]); }
        vs += shfl_xor_f(vs, 16); vs += shfl_xor_f(vs, 32);
        const float rs = rsqrtf(vs * (1.0f / 64.0f) + EPS);
#pragma unroll
        for (int et = 0; et < 4; ++et) { const int e = et * 16 + g * 4;
            const u32x2 gt = *(const GAS u32x2*)(proj + ((size_t)6 * NTOK + t0 + F.wave * 16) * 256 + (h * 8 + et * 2 + (g >> 1)) * 128 + ql * 8 + (g & 1) * 4); const f32x4 gn = *(const GAS f32x4*)(retg + h * 64 + e);
            u32x2 w; w.x = pk2(oi[et][0] * rs * gn[0] * silu_f(bflo(gt.x)), oi[et][1] * rs * gn[1] * silu_f(bfhi(gt.x)));
            w.y = pk2(oi[et][2] * rs * gn[2] * silu_f(bflo(gt.y)), oi[et][3] * rs * gn[3] * silu_f(bfhi(gt.y)));
            *(GAS u32x2*)(ycat + tq * DM + 256 + h * 64 + e) = w; }
    }
    __syncthreads();
}

constexpr int G_LD = 72;
constexpr int G_K = 0, G_Q = 9216, G_KST = 18432, G_ATT = 39168, G_LD4 = 57600, G_LZ = 65792, G_UT = 84224, G_RB1 = 125696, G_GC = 133888, G_BETA = 134400;
#define PRW(r) ((r) + ((r) >> 3))
constexpr size_t GOP_BYTES = 32768;
__device__ __forceinline__ int natidx(int dir, int i) { return dir ? 63 - i : i; }

constexpr int G_TI = G_RB1;
__device__ __forceinline__ void gdn_tinv(LAS unsigned char* lds, int tid) {
    const int dir = tid >> 6, blk = (tid >> 4) & 3, col = tid & 15;
    const LAS float* ld = (const LAS float*)(lds + G_LD4) + (dir * 4 + blk) * 256;
    float sol[16];
#pragma unroll
    for (int r = 0; r < 16; ++r) sol[r] = (r == col) ? 1.f : 0.f;
#pragma unroll
    for (int r = 1; r < 16; ++r) {
#pragma unroll
        for (int j4 = 0; j4 < (r + 3) / 4; ++j4) { const f32x4 lv = *(const LAS f32x4*)(ld + r * 16 + j4 * 4);
#pragma unroll
            for (int jj = 0; jj < 4; ++jj) if (j4 * 4 + jj < r) sol[r] -= lv[jj] * sol[j4 * 4 + jj]; } }
    LAS bf16_t* ti = (LAS bf16_t*)(lds + G_TI) + (dir * 4 + blk) * 256 + col;
#pragma unroll
    for (int r = 0; r < 16; ++r) ti[r * 16] = (bf16_t)f2bf(sol[r]);
}
template <int BLK>
__device__ __forceinline__ void gdn_solve_blk(const LAS bf16_t* lzb, const LAS bf16_t* tib, LAS bf16_t* utr, int g) {
    constexpr int NKS = (BLK * 16 + 31) / 32;
    f32x4 acc = (f32x4){0.f, 0.f, 0.f, 0.f};
#pragma unroll
    for (int ks = 0; ks < (BLK > 0 ? NKS : 0); ++ks) acc = MFMA16(*(const LAS bf16x8*)(lzb + BLK * 16 * G_LD + ks * 32), *(const LAS bf16x8*)(utr + ks * 32 + g * 8), acc);
    const u32x2 rw = *(const LAS u32x2*)(utr + BLK * 16 + g * 4);
    const u32x2 tw = *(const LAS u32x2*)(tib + BLK * 256);
    u32x4 bx; bx.x = pk2(bflo(rw.x) - acc[0], bfhi(rw.x) - acc[1]); bx.y = pk2(bflo(rw.y) - acc[2], bfhi(rw.y) - acc[3]); bx.z = 0u; bx.w = 0u;
    u32x4 at; at.x = tw.x; at.y = tw.y; at.z = 0u; at.w = 0u;
    const f32x4 so = MFMA16(__builtin_bit_cast(bf16x8, at), __builtin_bit_cast(bf16x8, bx), ((f32x4){0.f, 0.f, 0.f, 0.f}));
    u32x2 w; w.x = pk2(so[0], so[1]); w.y = pk2(so[2], so[3]);
    *(LAS u32x2*)(utr + BLK * 16 + g * 4) = w;
    asm volatile("" ::: "memory");
}
__device__ __forceinline__ void gdn_solve_wave(LAS unsigned char* lds, int wave, int lane) {
    const int dir = wave >> 2, q = wave & 3, g = lane >> 4, ql = lane & 15;
    const LAS bf16_t* lzb = (const LAS bf16_t*)(lds + G_LZ) + (dir * 64 + ql) * G_LD + g * 8;
    const LAS bf16_t* tib = (const LAS bf16_t*)(lds + G_TI) + dir * 4 * 256 + ql * 16 + g * 4;
#pragma unroll
    for (int cc = 0; cc < 2; ++cc) { const int ct = q * 2 + cc;
        LAS bf16_t* utr = (LAS bf16_t*)(lds + G_UT) + (dir * 144 + ct * 18 + PRW(ql)) * G_LD;
        gdn_solve_blk<0>(lzb, tib, utr, g); gdn_solve_blk<1>(lzb, tib, utr, g); gdn_solve_blk<2>(lzb, tib, utr, g); gdn_solve_blk<3>(lzb, tib, utr, g); }
}

__device__ __forceinline__ void gdn_g1_item(Frame& F, const GAS bf16_t* proj, const GAS float* ab, const GAS float* convw, const GAS float* alog, const GAS float* dtb, GAS unsigned char* gop, int item) {
    int tid = F.tid; asm volatile("" : "+v"(tid));
    const int lane = tid & 63, g = lane >> 4, ql = lane & 15, wave = F.wave;
    const int n = item & 127, h = (item >> 7) & 3, b = item >> 9; const size_t tb = (size_t)b * SEQ; const int s0 = n * 64;
    LAS bf16_t* Ks = (LAS bf16_t*)(F.lds + G_K); LAS bf16_t* Qs = (LAS bf16_t*)(F.lds + G_Q);
    LAS float* GC = (LAS float*)(F.lds + G_GC); LAS float* BETA = (LAS float*)(F.lds + G_BETA);
    u32x4 xin[4][3];
    {   const int i = tid >> 3, p = tid & 7, s = s0 + i;
#pragma unroll
        for (int tap = 0; tap < 4; ++tap) { const int s2 = s + tap - 2; const bool ok = (s2 >= 0 && s2 < SEQ);
#pragma unroll
            for (int part = 0; part < 3; ++part) { xin[tap][part] = (u32x4){0u, 0u, 0u, 0u}; if (ok) xin[tap][part] = *(const GAS u32x4*)(proj + PJ(tb + s2, 2048 + part * 256 + h * 64 + 8 * p)); } } }
    if (tid < 128) { const int dir = tid >> 6, i = tid & 63; const size_t t = tb + s0 + i;
        const float a = ab[t * 16 + dir * 4 + h], bb = ab[t * 16 + 8 + dir * 4 + h];
        float v = -__expf(alog[dir * 4 + h]) * softplus_f(a + dtb[dir * 4 + h]);
#pragma unroll
        for (int off = 1; off < 64; off <<= 1) { const int srcl = dir ? lane + off : lane - off;
            const float o = __builtin_bit_cast(float, __builtin_amdgcn_ds_bpermute((srcl & 63) << 2, __builtin_bit_cast(int, v))); if (srcl >= 0 && srcl < 64) v += o; }
        GC[dir * 64 + i] = v; BETA[dir * 64 + i] = sigmoid_f(bb); }
    {   const int i = tid >> 3, p = tid & 7;
        float u[3][8];
#pragma unroll
        for (int part = 0; part < 3; ++part)
#pragma unroll
            for (int j = 0; j < 8; ++j) u[part][j] = 0.f;
#pragma unroll
        for (int tap = 0; tap < 4; ++tap) {
#pragma unroll
            for (int part = 0; part < 3; ++part) { const u32x4 x = xin[tap][part];
                const GAS float* wp = convw + tap * 768 + part * 256 + h * 64 + 8 * p; const f32x4 w0 = *(const GAS f32x4*)wp, w1 = *(const GAS f32x4*)(wp + 4);
                u[part][0] += w0[0] * bflo(x.x); u[part][1] += w0[1] * bfhi(x.x); u[part][2] += w0[2] * bflo(x.y); u[part][3] += w0[3] * bfhi(x.y);
                u[part][4] += w1[0] * bflo(x.z); u[part][5] += w1[1] * bfhi(x.z); u[part][6] += w1[2] * bflo(x.w); u[part][7] += w1[3] * bfhi(x.w); } }
        float ssq[2] = {0.f, 0.f};
#pragma unroll
        for (int part = 0; part < 3; ++part)
#pragma unroll
            for (int j = 0; j < 8; ++j) { u[part][j] = silu_f(u[part][j]); if (part < 2) ssq[part] += u[part][j] * u[part][j]; }
#pragma unroll
        for (int part = 0; part < 2; ++part) { float q = ssq[part];
#pragma unroll
            for (int m = 1; m < 8; m <<= 1) q += __builtin_bit_cast(float, __builtin_amdgcn_ds_bpermute((lane ^ m) << 2, __builtin_bit_cast(int, q)));
            ssq[part] = rsqrtf(q + EPS); }
        const float qs = ssq[0] * 0.125f, ks = ssq[1];
        __syncthreads();
        u32x4 o;
        o.x = pk2(u[0][0] * qs, u[0][1] * qs); o.y = pk2(u[0][2] * qs, u[0][3] * qs); o.z = pk2(u[0][4] * qs, u[0][5] * qs); o.w = pk2(u[0][6] * qs, u[0][7] * qs); *(LAS u32x4*)(Qs + i * G_LD + 8 * p) = o;
        o.x = pk2(u[1][0] * ks, u[1][1] * ks); o.y = pk2(u[1][2] * ks, u[1][3] * ks); o.z = pk2(u[1][4] * ks, u[1][5] * ks); o.w = pk2(u[1][6] * ks, u[1][7] * ks); *(LAS u32x4*)(Ks + i * G_LD + 8 * p) = o;
#pragma unroll
        for (int dir = 0; dir < 2; ++dir) { const float gci = GC[dir * 64 + i], bi = BETA[dir * 64 + i];
            const float sc = ks * __expf(GC[dir * 64 + (dir ? 0 : 63)] - gci), sw = ks * bi * __expf(gci); const int ip = natidx(dir, i);
            LAS bf16_t* kst = (LAS bf16_t*)(F.lds + G_KST) + dir * 72 * G_LD; LAS bf16_t* ut = (LAS bf16_t*)(F.lds + G_UT) + dir * 144 * G_LD;
#pragma unroll
            for (int j = 0; j < 8; ++j) { kst[(9 * p + j) * G_LD + ip] = (bf16_t)f2bf(u[1][j] * sc); ut[(9 * p + j) * G_LD + ip] = (bf16_t)f2bf(u[2][j] * bi); ut[(72 + 9 * p + j) * G_LD + ip] = (bf16_t)f2bf(u[1][j] * sw); } }
    }
    __syncthreads();
    {   const int dir = wave >> 2, it = wave & 3;
        const LAS float* gc = GC + dir * 64; const LAS float* be = BETA + dir * 64;
        LAS float* Ld = (LAS float*)(F.lds + G_LD4) + (dir * 4 + it) * 256; LAS bf16_t* Lz = (LAS bf16_t*)(F.lds + G_LZ) + dir * 64 * G_LD; LAS bf16_t* At = (LAS bf16_t*)(F.lds + G_ATT) + dir * 64 * G_LD;
        const int ra = natidx(dir, it * 16 + ql);
        bf16x8 ka[2], qa[2];
#pragma unroll
        for (int ks = 0; ks < 2; ++ks) { ka[ks] = *(const LAS bf16x8*)(Ks + ra * G_LD + ks * 32 + g * 8); qa[ks] = *(const LAS bf16x8*)(Qs + ra * G_LD + ks * 32 + g * 8); }
#pragma unroll
        for (int jt = 0; jt < 4; ++jt) { const int rb = natidx(dir, jt * 16 + ql);
            f32x4 kk = (f32x4){0.f, 0.f, 0.f, 0.f}, qk = kk;
#pragma unroll
            for (int ks = 0; ks < 2; ++ks) { const bf16x8 kb = *(const LAS bf16x8*)(Ks + rb * G_LD + ks * 32 + g * 8); kk = MFMA16(ka[ks], kb, kk); qk = MFMA16(qa[ks], kb, qk); }
            const int jp = jt * 16 + ql; const float gj = gc[natidx(dir, jp)];
#pragma unroll
            for (int jj = 0; jj < 4; ++jj) { const int ip = it * 16 + g * 4 + jj, ni = natidx(dir, ip); const float dec = (ip >= jp) ? __expf(gc[ni] - gj) : 0.f;
                const float lval = (ip > jp) ? be[ni] * kk[jj] * dec : 0.f;
                if (jt == it) Ld[(g * 4 + jj) * 16 + ql] = lval;
                Lz[ip * G_LD + jp] = (bf16_t)((jt < it) ? f2bf(lval) : 0u);
                At[ip * G_LD + jp] = (bf16_t)f2bf(qk[jj] * dec); } }
    }
    __syncthreads();
    if (tid < 128) gdn_tinv(F.lds, tid);
    __syncthreads();
    gdn_solve_wave(F.lds, wave, lane);
    __syncthreads();
    {   const int dir = wave >> 2, prod = wave & 3;
        const LAS float* gc = GC + dir * 64;
        const LAS bf16_t* At = (const LAS bf16_t*)(F.lds + G_ATT) + dir * 64 * G_LD; const LAS bf16_t* kst = (const LAS bf16_t*)(F.lds + G_KST) + dir * 72 * G_LD;
        const LAS bf16_t* UT = (const LAS bf16_t*)(F.lds + G_UT) + dir * 144 * G_LD; const LAS bf16_t* WT = UT + 72 * G_LD;
        const int arow = PRW(ql), brow = (prod >= 2) ? PRW(ql) : ql, bstep = (prod >= 2) ? 18 : 16;
        GAS unsigned char* outp = gop + ((size_t)item * 2 + dir) * GOP_BYTES;
        const LAS bf16_t* Am = (prod == 0) ? UT : (prod == 3) ? kst : WT;
        const LAS bf16_t* Bm = (prod == 3) ? UT : (prod == 2) ? kst : At;
        f32x4 acc[4][4];
#pragma unroll
        for (int x = 0; x < 4; ++x)
#pragma unroll
            for (int y = 0; y < 4; ++y) acc[x][y] = (f32x4){0.f, 0.f, 0.f, 0.f};
#pragma unroll
        for (int ks = 0; ks < 2; ++ks) { bf16x8 bf[4];
#pragma unroll
            for (int y = 0; y < 4; ++y) bf[y] = *(const LAS bf16x8*)(Bm + (y * bstep + brow) * G_LD + ks * 32 + g * 8);
#pragma unroll
            for (int x = 0; x < 4; ++x) { const bf16x8 af = *(const LAS bf16x8*)(Am + (x * 18 + arow) * G_LD + ks * 32 + g * 8);
#pragma unroll
                for (int y = 0; y < 4; ++y) acc[x][y] = MFMA16(af, bf[y], acc[x][y]); } }
        if (prod == 0 || prod == 3) {
            GAS unsigned char* o = outp + (prod == 0 ? 16384 : 24576);
#pragma unroll
            for (int x = 0; x < 4; ++x)
#pragma unroll
                for (int y = 0; y < 4; ++y) { u32x2 w; w.x = pk2(acc[x][y][0], acc[x][y][1]); w.y = pk2(acc[x][y][2], acc[x][y][3]); *(GAS u32x2*)(o + ((size_t)(((prod == 0) ? (x * 4 + y) : (y * 4 + x)) * 64 + lane)) * 8) = w; }
        } else {
            const float a_last = __expf(gc[dir ? 0 : 63]);
#pragma unroll
            for (int y = 0; y < 4; ++y) { float val[4][4];
                const int col = y * 16 + ql;
#pragma unroll
                for (int x = 0; x < 4; ++x) {
                    if (prod == 1) { const int ni = natidx(dir, col); const float eg = __expf(gc[ni]); const u32x2 qv = *(const LAS u32x2*)(Qs + ni * G_LD + x * 16 + g * 4);
                        val[x][0] = bflo(qv.x) * eg - acc[x][y][0]; val[x][1] = bfhi(qv.x) * eg - acc[x][y][1]; val[x][2] = bflo(qv.y) * eg - acc[x][y][2]; val[x][3] = bfhi(qv.y) * eg - acc[x][y][3]; }
                    else {
#pragma unroll
                        for (int jj = 0; jj < 4; ++jj) val[x][jj] = ((x * 16 + g * 4 + jj == col) ? a_last : 0.f) - acc[x][y][jj]; } }
#pragma unroll
                for (int ks = 0; ks < 2; ++ks) { u32x4 w; w.x = pk2(val[2 * ks][0], val[2 * ks][1]); w.y = pk2(val[2 * ks][2], val[2 * ks][3]); w.z = pk2(val[2 * ks + 1][0], val[2 * ks + 1][1]); w.w = pk2(val[2 * ks + 1][2], val[2 * ks + 1][3]);
                    *(GAS u32x4*)(outp + (prod == 1 ? 0 : 8192) + ((size_t)((y * 2 + ks) * 64 + lane)) * 16) = w; } }
        }
    }
    __syncthreads();
}

constexpr int GS_SLOT = 20480, GS_NSLOT = 6;
struct GdnStage { u32x4 a[5]; };
__device__ __forceinline__ const GAS unsigned char* gdn_src_piece(const GAS unsigned char* src, int sl, int p) {
    const int off = p * 16;
    return src + (off < 16384 ? off : (off < 18432 ? off + sl * 2048 : 24576 + sl * 2048 + (off - 18432)));
}
__device__ __forceinline__ void gdn_ld_stage(GdnStage& R, const GAS unsigned char* src, int sl, int lw, int lane) {
#pragma unroll
    for (int j = 0; j < 5; ++j) R.a[j] = *(const GAS u32x4*)gdn_src_piece(src, sl, lw * 320 + j * 64 + lane);
}
__device__ __forceinline__ void gdn_st_stage(const GdnStage& R, LAS unsigned char* slot, int lw, int lane) {
#pragma unroll
    for (int j = 0; j < 5; ++j) *(LAS u32x4*)(slot + (lw * 320 + j * 64 + lane) * 16) = R.a[j];
}
__device__ __forceinline__ void gdn_compute(const LAS unsigned char* slot, f32x4 (&S)[4], GAS bf16_t* orow0, int dir, int ql, int lane) {
    bf16x8 qf[8]; u32x2 o0[4], b0[4];
#pragma unroll
    for (int i = 0; i < 8; ++i) qf[i] = *(const LAS bf16x8*)(slot + (i * 64 + lane) * 16);
#pragma unroll
    for (int x = 0; x < 4; ++x) { o0[x] = *(const LAS u32x2*)(slot + 16384 + (x * 64 + lane) * 8); b0[x] = *(const LAS u32x2*)(slot + 18432 + (x * 64 + lane) * 8); }
    bf16x8 sf[2];
#pragma unroll
    for (int ks = 0; ks < 2; ++ks) { u32x4 w; w.x = pk2(S[2 * ks][0], S[2 * ks][1]); w.y = pk2(S[2 * ks][2], S[2 * ks][3]); w.z = pk2(S[2 * ks + 1][0], S[2 * ks + 1][1]); w.w = pk2(S[2 * ks + 1][2], S[2 * ks + 1][3]); sf[ks] = __builtin_bit_cast(bf16x8, w); }
    asm volatile("s_waitcnt lgkmcnt(0)" : "+v"(qf[0]), "+v"(qf[1]), "+v"(qf[2]), "+v"(qf[3]), "+v"(qf[4]), "+v"(qf[5]), "+v"(qf[6]), "+v"(qf[7]), "+v"(o0[0]), "+v"(o0[1]), "+v"(o0[2]), "+v"(o0[3]), "+v"(b0[0]), "+v"(b0[1]), "+v"(b0[2]), "+v"(b0[3]));
    bf16x8 mf[8];
#pragma unroll
    for (int i = 0; i < 8; ++i) mf[i] = *(const LAS bf16x8*)(slot + 8192 + (i * 64 + lane) * 16);
#pragma unroll
    for (int x = 0; x < 4; ++x) { f32x4 o = (f32x4){bflo(o0[x].x), bfhi(o0[x].x), bflo(o0[x].y), bfhi(o0[x].y)};
        o = MFMA16(sf[0], qf[x * 2], o); o = MFMA16(sf[1], qf[x * 2 + 1], o);
        u32x2 w; w.x = pk2(o[0], o[1]); w.y = pk2(o[2], o[3]); *(GAS u32x2*)(orow0 + (size_t)natidx(dir, x * 16 + ql) * 256) = w; }
    asm volatile("s_waitcnt lgkmcnt(0)" : "+v"(mf[0]), "+v"(mf[1]), "+v"(mf[2]), "+v"(mf[3]), "+v"(mf[4]), "+v"(mf[5]), "+v"(mf[6]), "+v"(mf[7]));
#pragma unroll
    for (int x = 0; x < 4; ++x) { f32x4 n = (f32x4){bflo(b0[x].x), bfhi(b0[x].x), bflo(b0[x].y), bfhi(b0[x].y)};
        n = MFMA16(mf[x * 2], sf[0], n); n = MFMA16(mf[x * 2 + 1], sf[1], n); S[x] = n; }
}
__device__ __forceinline__ void gdn_scan_block(Frame& F, const GAS unsigned char* gop, GAS bf16_t* Og, int chain) {
    const int lane = F.lane, g = lane >> 4, ql = lane & 15, wave = F.wave, sl = chain & 3, dir = (chain >> 2) & 1, bh = chain >> 3, h = bh & 3, b = bh >> 2;
    const bool loader = (wave >= 1 && wave <= 4), comp = (wave == 0); const int lw = wave - 1;
    f32x4 S[4];
#pragma unroll
    for (int x = 0; x < 4; ++x) S[x] = (f32x4){0.f, 0.f, 0.f, 0.f};
    const GAS unsigned char* base = gop + ((size_t)bh * 128 * 2 + dir) * GOP_BYTES;
    GAS bf16_t* obase = Og + ((size_t)dir * NTOK + (size_t)b * SEQ) * 256 + h * 64 + sl * 16 + g * 4;
    LAS unsigned char* ring = F.lds;
#define GDN_BAR() do { asm volatile("s_waitcnt lgkmcnt(0)" ::: "memory"); __builtin_amdgcn_s_barrier(); asm volatile("" ::: "memory"); } while (0)
#define GDN_SRC(st) (base + (size_t)(dir ? 127 - (st) : (st)) * 2 * GOP_BYTES)
    if (loader) {
        GdnStage R0, R1, R2, R3;
        gdn_ld_stage(R0, GDN_SRC(0), sl, lw, lane); gdn_ld_stage(R1, GDN_SRC(1), sl, lw, lane); gdn_ld_stage(R2, GDN_SRC(2), sl, lw, lane); gdn_ld_stage(R3, GDN_SRC(3), sl, lw, lane);
        gdn_st_stage(R0, ring + 0 * GS_SLOT, lw, lane); gdn_st_stage(R1, ring + 1 * GS_SLOT, lw, lane); gdn_st_stage(R2, ring + 2 * GS_SLOT, lw, lane); gdn_st_stage(R3, ring + 3 * GS_SLOT, lw, lane);
        gdn_ld_stage(R0, GDN_SRC(4), sl, lw, lane); gdn_ld_stage(R1, GDN_SRC(5), sl, lw, lane); gdn_ld_stage(R2, GDN_SRC(6), sl, lw, lane); gdn_ld_stage(R3, GDN_SRC(7), sl, lw, lane);
        GDN_BAR();
        int sw = 4;
#define GDN_STEP(stv, RN) do { const int _st = (stv); gdn_st_stage(RN, ring + sw * GS_SLOT, lw, lane); gdn_ld_stage(RN, GDN_SRC(min(_st + 8, 127)), sl, lw, lane); \
        GDN_BAR(); sw = (sw == GS_NSLOT - 1) ? 0 : sw + 1; } while (0)
        GDN_STEP(0, R0); GDN_STEP(1, R1); GDN_STEP(2, R2); GDN_STEP(3, R3);
        for (int st = 4; st < 128; st += 4) { GDN_STEP(st, R0); GDN_STEP(st + 1, R1); GDN_STEP(st + 2, R2); GDN_STEP(st + 3, R3); }
    } else if (comp) {
        GDN_BAR();
        int s0 = 0;
        for (int st = 0; st < 128; ++st) { gdn_compute(ring + s0 * GS_SLOT, S, obase + (size_t)(dir ? 127 - st : st) * 64 * 256, dir, ql, lane); GDN_BAR(); s0 = (s0 == GS_NSLOT - 1) ? 0 : s0 + 1; }
    } else {
        GDN_BAR();
        for (int st = 0; st < 128; ++st) GDN_BAR();
    }
#undef GDN_STEP
#undef GDN_SRC
#undef GDN_BAR
}

__device__ __forceinline__ void gdn_finalize(Frame& F, const GAS bf16_t* proj, const GAS bf16_t* Og, const GAS float* gdng, GAS bf16_t* ycat, int gw, int ngw) {
    const int lane = F.lane, sub = lane >> 4, e4 = (lane & 15) * 4;
    const f32x4 gn = *(const GAS f32x4*)(gdng + e4);
    for (int base = gw * 16; base < NTOK * 4; base += ngw * 16) {
#pragma unroll
        for (int u = 0; u < 4; ++u) { const int pair = base + u * 4 + sub, t = pair >> 2, h = pair & 3; const size_t o = (size_t)t * 256 + h * 64 + e4;
            const u32x2 a = *(const GAS u32x2*)(Og + o), b = *(const GAS u32x2*)(Og + (size_t)NTOK * 256 + o), gt = *(const GAS u32x2*)(proj + PJ((size_t)t, 2816 + h * 64 + e4));
            const float x0 = bflo(a.x) + bflo(b.x), x1 = bfhi(a.x) + bfhi(b.x), x2 = bflo(a.y) + bflo(b.y), x3 = bfhi(a.y) + bfhi(b.y);
            float ms = (x0 * x0 + x1 * x1) + (x2 * x2 + x3 * x3);
            ms += shfl_xor_f(ms, 1); ms += shfl_xor_f(ms, 2); ms += shfl_xor_f(ms, 4); ms += shfl_xor_f(ms, 8);
            const float rs = rsqrtf(ms * (1.0f / 64.0f) + EPS);
            u32x2 w; w.x = pk2(x0 * rs * gn[0] * silu_f(bflo(gt.x)), x1 * rs * gn[1] * silu_f(bfhi(gt.x))); w.y = pk2(x2 * rs * gn[2] * silu_f(bflo(gt.y)), x3 * rs * gn[3] * silu_f(bfhi(gt.y)));
            *(GAS u32x2*)(ycat + (size_t)t * DM + 768 + h * 64 + e4) = w; }
    }
}

__device__ __forceinline__ void router_phase(Frame& F, int l) {
    GAS unsigned char* ws = F.ws; const int lane = F.lane, g = lane >> 4;
    const GAS bf16_t* X = (const GAS bf16_t*)(ws + WS_XB); const GAS float* ssq = (const GAS float*)(ws + WS_SSQ);
    const GAS bf16x8* fh = (const GAS bf16x8*)(ws + WS_TAB + TAB_RFR + (size_t)l * 196608); const GAS bf16x8* fl = fh + 6144;
    GAS int* toke = (GAS int*)(ws + WS_TAB + TAB_TOKE); GAS float* tokw = (GAS float*)(ws + WS_TAB + TAB_TOKW);
    LAS float* lg = (LAS float*)(F.lds + F.wave * 4096);
    LAS int* hist = (LAS int*)(F.lds + LDS_MISC + 256);
    if (F.tid < NEXP) hist[F.tid] = 0;
    __syncthreads();
    const GAS float* bg = F.inp(I_BGRP) + l * 4; const GAS float* br = F.inp(I_BRT) + l * 32;
    for (int tile = F.gw; tile < NTOK / 16; tile += F.ngw) {
        const int t0 = tile * 16; const GAS bf16_t* xr = X + (size_t)(t0 + (lane & 15)) * DM + g * 8;
        f32x4 acc[3];
#pragma unroll
        for (int ct = 0; ct < 3; ++ct) acc[ct] = (f32x4){0.f, 0.f, 0.f, 0.f};
#pragma unroll 1
        for (int kb = 0; kb < 8; ++kb) {
            bf16x8 xa[4]; bf16x8 wh[4][3], wl[4][3];
#pragma unroll
            for (int i = 0; i < 4; ++i) { const int ks = kb * 4 + i; xa[i] = *(const GAS bf16x8*)(xr + ks * 32);
#pragma unroll
                for (int ct = 0; ct < 3; ++ct) { wh[i][ct] = fh[(ks * 3 + ct) * 64 + lane]; wl[i][ct] = fl[(ks * 3 + ct) * 64 + lane]; } }
            asm volatile("" : "+v"(xa[0]), "+v"(xa[1]), "+v"(xa[2]), "+v"(xa[3]),
                              "+v"(wh[0][0]), "+v"(wh[0][1]), "+v"(wh[0][2]), "+v"(wh[1][0]), "+v"(wh[1][1]), "+v"(wh[1][2]), "+v"(wh[2][0]), "+v"(wh[2][1]), "+v"(wh[2][2]), "+v"(wh[3][0]), "+v"(wh[3][1]), "+v"(wh[3][2]));
#pragma unroll
            for (int i = 0; i < 4; ++i)
#pragma unroll
                for (int ct = 0; ct < 3; ++ct) { acc[ct] = MFMA16(wh[i][ct], xa[i], acc[ct]); acc[ct] = MFMA16(wl[i][ct], xa[i], acc[ct]); }
        }
#pragma unroll
        for (int ct = 0; ct < 3; ++ct)
#pragma unroll
            for (int j = 0; j < 4; ++j) lg[(lane & 15) * 48 + ct * 16 + g * 4 + j] = acc[ct][j];
        LDS_WAIT(); asm volatile("" ::: "memory");
        if (lane < 16) {
            const int t = t0 + lane; const float rs = row_rstd(ssq, t); const LAS float* L = lg + lane * 48;
            int gi = 0; float gm = L[32] * rs + bg[0];
            float gl[4]; gl[0] = gm;
#pragma unroll
            for (int j = 1; j < 4; ++j) { gl[j] = L[32 + j] * rs + bg[j]; if (gl[j] > gm) { gm = gl[j]; gi = j; } }
            float gs = 0.f;
#pragma unroll
            for (int j = 0; j < 4; ++j) gs += __expf(gl[j] - gm);
            const float gp = 1.0f / gs;
            int e1 = 0, e2 = 0; float l1 = -3.0e38f, l2 = -3.0e38f;
            for (int j = 0; j < 8; ++j) { const float v = L[gi * 8 + j] * rs + br[gi * 8 + j];
                if (v > l1) { l2 = l1; e2 = e1; l1 = v; e1 = j; } else if (v > l2) { l2 = v; e2 = j; } }
            const float p2 = __expf(l2 - l1), w1 = gp / (1.0f + p2), w2 = gp * p2 / (1.0f + p2);
            const int x1 = gi * 8 + e1, x2 = gi * 8 + e2;
            toke[t * 2] = x1; toke[t * 2 + 1] = x2; tokw[t * 2] = w1; tokw[t * 2 + 1] = w2;
            __hip_atomic_fetch_add(hist + x1, 1, __ATOMIC_RELAXED, __HIP_MEMORY_SCOPE_WORKGROUP); __hip_atomic_fetch_add(hist + x2, 1, __ATOMIC_RELAXED, __HIP_MEMORY_SCOPE_WORKGROUP);
        }
        LDS_WAIT(); asm volatile("" ::: "memory");
    }
    __syncthreads();
    if (F.tid < NEXP) __hip_atomic_fetch_add((GAS unsigned*)(ws + WS_CTL) + CW_CNT + l * 32 + F.tid, (unsigned)hist[F.tid], __ATOMIC_RELAXED, __HIP_MEMORY_SCOPE_AGENT);
}

__device__ __forceinline__ int moe_pad_table(Frame& F, int l, LAS int* pad_end) {
    if (F.tid == 0) { const GAS unsigned* cnt = (const GAS unsigned*)(F.ws + WS_CTL) + CW_CNT + l * 32; int acc = 0;
        for (int e = 0; e < NEXP; ++e) { const unsigned c = __hip_atomic_load(cnt + e, __ATOMIC_RELAXED, __HIP_MEMORY_SCOPE_AGENT); acc += (int)((c + 255u) & ~255u); pad_end[e] = acc; } }
    __syncthreads();
    return pad_end[NEXP - 1];
}

__device__ __forceinline__ void assign_gather_phase(Frame& F, int l) {
    GAS unsigned char* ws = F.ws;
    LAS int* pad_end = (LAS int*)(F.lds + LDS_MISC + 64);
    LAS int* lhist = (LAS int*)(F.lds + LDS_MISC + 256);
    LAS int* lbase = (LAS int*)(F.lds + LDS_MISC + 512);
    LAS int* aslot = (LAS int*)(F.lds);
    LAS int* atok = (LAS int*)(F.lds + 1024);
    moe_pad_table(F, l, pad_end);
    if ((int)blockIdx.x < NEXP) {
        const int e = blockIdx.x; const unsigned cnt = __hip_atomic_load((const GAS unsigned*)(ws + WS_CTL) + CW_CNT + l * 32 + e, __ATOMIC_RELAXED, __HIP_MEMORY_SCOPE_AGENT);
        const int p0 = (e ? pad_end[e - 1] : 0) + (int)cnt, p1 = pad_end[e];
        for (int sl = p0 + F.tid; sl < p1; sl += NTHREADS) { ((GAS int*)(ws + WS_SLOT + SL_TOK))[sl] = 0; ((GAS float*)(ws + WS_SLOT + SL_W))[sl] = 0.f; ((GAS float*)(ws + WS_SLOT + SL_RSTD))[sl] = 0.f; } }
    const GAS int* toke = (const GAS int*)(ws + WS_TAB + TAB_TOKE); const GAS float* tokw = (const GAS float*)(ws + WS_TAB + TAB_TOKW);
    GAS int* slot_tok = (GAS int*)(ws + WS_SLOT + SL_TOK); GAS float* slot_w = (GAS float*)(ws + WS_SLOT + SL_W); GAS float* slot_rstd = (GAS float*)(ws + WS_SLOT + SL_RSTD); GAS int* tok_slot = (GAS int*)(ws + WS_SLOT + SL_TSLOT);
    const GAS float* ssq = (const GAS float*)(ws + WS_SSQ);
    const GAS bf16_t* xb = (const GAS bf16_t*)(ws + WS_XB); GAS bf16_t* sa = (GAS bf16_t*)(ws + WS_SORTA);
    GAS unsigned* cur = (GAS unsigned*)(ws + WS_CTL) + CW_CUR + l * 32;
    for (int ch = blockIdx.x; ch < NTOK / 128; ch += F.G) {
        if (F.tid < NEXP) lhist[F.tid] = 0;
        __syncthreads();
        int e = 0, pos = 0, t = 0;
        if (F.tid < 256) { t = ch * 128 + (F.tid >> 1); e = toke[t * 2 + (F.tid & 1)]; pos = __hip_atomic_fetch_add(lhist + e, 1, __ATOMIC_RELAXED, __HIP_MEMORY_SCOPE_WORKGROUP); }
        __syncthreads();
        if (F.tid < NEXP) lbase[F.tid] = (int)__hip_atomic_fetch_add(cur + F.tid, (unsigned)lhist[F.tid], __ATOMIC_RELAXED, __HIP_MEMORY_SCOPE_AGENT);
        __syncthreads();
        if (F.tid < 256) { const int slot = (e ? pad_end[e - 1] : 0) + lbase[e] + pos;
            slot_tok[slot] = t; slot_w[slot] = tokw[t * 2 + (F.tid & 1)]; slot_rstd[slot] = row_rstd(ssq, t); tok_slot[t * 2 + (F.tid & 1)] = slot;
            aslot[F.tid] = slot; atok[F.tid] = t; }
        __syncthreads();
        __syncthreads();
    }
}

__device__ __forceinline__ void combine_phase(Frame& F, int l) {
    GAS unsigned char* ws = F.ws; const int lane = F.lane;
    const GAS int* tok_slot = (const GAS int*)(ws + WS_SLOT + SL_TSLOT); const GAS bf16_t* Y = (const GAS bf16_t*)(ws + WS_SORTA);
    GAS bf16_t* xb = (GAS bf16_t*)(ws + WS_XB); GAS float* ssq = (GAS float*)(ws + WS_SSQ);
    const GAS f32x4* fing = (const GAS f32x4*)F.inp(I_FING);
    for (int t0 = F.gw * 4; t0 < NTOK; t0 += F.ngw * 4) {
        int sl0[4], sl1[4];
#pragma unroll
        for (int k = 0; k < 4; ++k) { sl0[k] = tok_slot[(t0 + k) * 2]; sl1[k] = tok_slot[(t0 + k) * 2 + 1]; }
        f32x4 v[4][4]; u32x2 xa[4][4], ya[4][4], yb[4][4];
#pragma unroll
        for (int k = 0; k < 4; ++k) { const GAS u32x2* xr = (const GAS u32x2*)(xb + (size_t)(t0 + k) * DM) + lane;
            const GAS u32x2* y0 = (const GAS u32x2*)(Y + (size_t)sl0[k] * DM) + lane; const GAS u32x2* y1 = (const GAS u32x2*)(Y + (size_t)sl1[k] * DM) + lane;
#pragma unroll
            for (int j = 0; j < 4; ++j) { xa[k][j] = xr[64 * j]; ya[k][j] = y0[64 * j]; yb[k][j] = y1[64 * j]; } }
#pragma unroll
        for (int k = 0; k < 4; ++k) { const int t = t0 + k; float s = 0.f; u32x2 w[4];
#pragma unroll
            for (int j = 0; j < 4; ++j) { const u32x2 x = xa[k][j], a = ya[k][j], b = yb[k][j];
                v[k][j].x = bflo(x.x) + bflo(a.x) + bflo(b.x); v[k][j].y = bfhi(x.x) + bfhi(a.x) + bfhi(b.x); v[k][j].z = bflo(x.y) + bflo(a.y) + bflo(b.y); v[k][j].w = bfhi(x.y) + bfhi(a.y) + bfhi(b.y);
                if (l == DEPTH - 1) s += (v[k][j].x * v[k][j].x + v[k][j].y * v[k][j].y) + (v[k][j].z * v[k][j].z + v[k][j].w * v[k][j].w);
                else { w[j].x = pk2(v[k][j].x, v[k][j].y); w[j].y = pk2(v[k][j].z, v[k][j].w); const float r0 = bflo(w[j].x), r1 = bfhi(w[j].x), r2 = bflo(w[j].y), r3 = bfhi(w[j].y); s += (r0 * r0 + r1 * r1) + (r2 * r2 + r3 * r3); } }
            s = wave_sum(s);
            if (l == DEPTH - 1) { const float rs = rsqrtf(s * (1.0f / DM) + EPS); GAS f32x4* orow = (GAS f32x4*)(F.out + (size_t)t * DM) + lane;
#pragma unroll
                for (int j = 0; j < 4; ++j) orow[64 * j] = v[k][j] * rs * fing[lane + 64 * j];
            } else {
                GAS u32x2* o8 = (GAS u32x2*)(xb + (size_t)t * DM) + lane;
#pragma unroll
                for (int j = 0; j < 4; ++j) o8[64 * j] = w[j];
                if (lane < 16) ssq[(size_t)t * 16 + lane] = (lane == 0) ? s : 0.f;
                if (lane == 0) ((GAS float*)(ws + WS_TAB + TAB_RSTD))[t] = rsqrtf(s * (1.0f / DM) + EPS);
            } }
    }
}

__device__ __forceinline__ void ab_phase(Frame& F, int l) {
    const int lane = lane_now(), g = lane >> 4, ql = lane & 15;
    const GAS bf16_t* xb = (const GAS bf16_t*)(F.ws + WS_XB); const GAS float* ssq = (const GAS float*)(F.ws + WS_SSQ); GAS float* ab = (GAS float*)(F.ws + WS_AB);
    const GAS bf16x8* fr = (const GAS bf16x8*)(F.ws + WS_TAB + TAB_ABF) + (size_t)l * 2048;
    for (int tile = F.gw; tile < NTOK / 16; tile += F.ngw) {
        const int t = tile * 16 + ql; const GAS bf16_t* xr = xb + (size_t)t * DM + g * 8;
        f32x4 acc = (f32x4){0.f, 0.f, 0.f, 0.f};
#pragma unroll
        for (int kb = 0; kb < 2; ++kb) { bf16x8 a[16], x[16];
#pragma unroll
            for (int i = 0; i < 16; ++i) { a[i] = fr[(kb * 16 + i) * 64 + lane]; x[i] = *(const GAS bf16x8*)(xr + (kb * 16 + i) * 32); }
            asm volatile("" : "+v"(x[0]), "+v"(x[1]), "+v"(x[2]), "+v"(x[3]), "+v"(x[4]), "+v"(x[5]), "+v"(x[6]), "+v"(x[7]), "+v"(x[8]), "+v"(x[9]), "+v"(x[10]), "+v"(x[11]), "+v"(x[12]), "+v"(x[13]), "+v"(x[14]), "+v"(x[15]),
                              "+v"(a[0]), "+v"(a[2]), "+v"(a[4]), "+v"(a[6]), "+v"(a[8]), "+v"(a[10]), "+v"(a[12]), "+v"(a[14]));
#pragma unroll
            for (int i = 0; i < 16; ++i) acc = MFMA16(a[i], x[i], acc); }
        const float rs = ((const GAS float*)(F.ws + WS_TAB + TAB_RSTD))[t];
        *(GAS f32x4*)(ab + (size_t)t * 16 + g * 4) = acc * rs;
    }
}

constexpr int PH_PRO = 0, PH_KV = 1, PH_FOLD = 2, PH_L0 = 3, PPL = 12, NPH = PH_L0 + DEPTH * PPL;
enum { LP_INPROJ = 0, LP_MIX, LP_MIX2, LP_FIN, LP_OUTPROJ, LP_SCORES, LP_PV, LP_ROUTER, LP_ASSIGN, LP_GATEUP, LP_DOWN, LP_COMBINE };

struct Args { const float* in[28]; float* out; unsigned char* ws; int ph_lo, ph_hi, mode, pad; };

__global__ void __launch_bounds__(NTHREADS, 2) fwd_kernel(Args args) {
    extern __shared__ __attribute__((aligned(16))) unsigned char lds_raw[];
    Frame F;
    F.lds = (LAS unsigned char*)lds_raw;
    F.tid = threadIdx.x; F.lane = F.tid & 63; F.wave = __builtin_amdgcn_readfirstlane(F.tid >> 6);
    F.G = gridDim.x; F.gw = blockIdx.x * NWAVES + F.wave; F.ngw = F.G * NWAVES;
    F.ka = (const CAS unsigned char*)__builtin_amdgcn_kernarg_segment_ptr();
    F.out = (GAS float*)args.out; F.ws = (GAS unsigned char*)args.ws;
    GAS unsigned char* ws0 = (GAS unsigned char*)args.ws;
    for (int u = F.tid; u < (LDS_BYTES - LDS_MISC) / 4; u += NTHREADS) ((LAS unsigned*)(F.lds + LDS_MISC))[u] = 0u;
    __syncthreads();
    const int lo = args.ph_lo, hi = args.ph_hi;
    XcdBarrier bar; bar.bar = (GAS unsigned*)(ws0 + WS_CTL) + CW_BAR; bar.x = 0; bar.st = (volatile LAS unsigned*)(F.lds + LDS_MISC);
    if (hi - lo > 1) bar = xcd_barrier_post((GAS unsigned*)(ws0 + WS_CTL) + CW_BAR, (volatile LAS unsigned*)(F.lds + LDS_MISC), F.tid == 0);
#ifndef LPMASK
#define LPMASK 0xfff
#endif
#ifndef PMASK
#define PMASK 7
#endif
#define IN(k) (lo <= (k) && (k) < hi)
#define INP(k) (((PMASK >> (k)) & 1) && IN(k))
#define INL(k) (((LPMASK >> (k)) & 1) && IN(pb + (k)))
#define SEAM(k) do { if (IN(k) && IN((k) + 1)) { unsigned _z = 0u; asm volatile("" : "+v"(_z));   \
        xcd_barrier(bar, F.wave == 0 && __builtin_amdgcn_mbcnt_hi(~0u, __builtin_amdgcn_mbcnt_lo(~0u, _z)) == 0u); } } while (0)
#define PH_ENTER() int c_id; GAS unsigned char* ws; do { unsigned _z0 = 0u; asm volatile("" : "+v"(_z0)); int _t = F.wave * 64 + (int)__builtin_amdgcn_mbcnt_hi(~0u, __builtin_amdgcn_mbcnt_lo(~0u, _z0)); asm volatile("" : "+v"(_t)); F.tid = _t; F.lane = _t & 63; GAS unsigned char* _w = (GAS unsigned char*)args.ws; asm volatile("" : "+s"(_w)); F.ws = _w; ws = _w; \
        GAS float* _o = (GAS float*)args.out; asm volatile("" : "+s"(_o)); F.out = _o;     int _c = blockIdx.x; asm volatile("" : "+s"(_c)); c_id = _c; F.gw = _c * NWAVES + F.wave; } while (0)

    if (INP(PH_PRO)) { PH_ENTER(); (void)c_id; (void)ws; p0_prologue(F); }
    SEAM(PH_PRO);

    for (int l = 0; l < DEPTH; ++l) {
        const int pb = PH_L0 + l * PPL;
        if (INL(LP_INPROJ)) { PH_ENTER();
            OrdInProj S{(const GAS char*)(ws + WS_XB), (const GAS char*)(ws + WS_WIN) + (size_t)l * PINP * DM * 2, (size_t)256 * DM * 2, NTOK / 256, PINP / 256, F.G, c_id};
            EpiProj E{(GAS bf16_t*)(ws + WS_PROJ), (GAS float*)(ws + WS_AB), (const GAS float*)(ws + WS_TAB + TAB_RSTD), (GAS bf16_t*)(ws + WS_VTA)};
            pg8::gemm_phase<EpiProj, OrdInProj>(F.lds, F.tid, pg8::Gemm{DM, DM, DM}, S, E);
            ab_phase(F, l);
            if (l == 0) { PH_ENTER();
                OrdKV S{(const GAS char*)(ws + WS_MEMN), (const GAS char*)(ws + WS_WKV), F.G, c_id};
                EpiBf E{(GAS bf16_t*)(ws + WS_KV), 2048};
                pg8::gemm_phase<EpiBf, OrdKV>(F.lds, F.tid, pg8::Gemm{DM, DM, DM}, S, E); }
        }
        SEAM(pb + LP_INPROJ);
        if (INL(LP_MIX) && l == 0) {
            { PH_ENTER(); OrdKq S{(const GAS char*)(ws + WS_KV), (const GAS char*)(ws + WS_WQB), F.G, c_id}; EpiBf E{(GAS bf16_t*)(ws + WS_KQT), DM};
              int kf = 256; asm volatile("" : "+s"(kf)); pg8::gemm_phase<EpiBf, OrdKq>(F.lds, F.tid, pg8::Gemm{2048, DM, kf}, S, E); }
            { PH_ENTER(); OrdVo S{(const GAS char*)(ws + WS_KV), (const GAS char*)(ws + WS_WOT), F.G, (c_id + 128) % F.G}; EpiBf E{(GAS bf16_t*)(ws + WS_VOT), DM};
              int kf = 256; asm volatile("" : "+s"(kf)); pg8::gemm_phase<EpiBf, OrdVo>(F.lds, F.tid, pg8::Gemm{DM, 2048, kf}, S, E); }
        }
        if (INL(LP_MIX)) { PH_ENTER();
            GAS bf16_t* proj = (GAS bf16_t*)(ws + WS_PROJ); GAS bf16_t* ycat = (GAS bf16_t*)(ws + WS_YCAT);
            const GAS float* rope = (const GAS float*)(ws + WS_TAB + TAB_ROPE);
            if (args.mode != 2 && args.mode != 4) {   const GAS bf16_t* pt = (const GAS bf16_t*)(ws + WS_TAB + TAB_POOL) + (size_t)l * 4 * 64 * 64;
                const GAS float* rpb = F.inp(I_RPB) + (size_t)l * 4 * 15 * 31;
                LAS float* rpbs = (LAS float*)(F.lds);
                for (int i = F.tid; i < 4 * 465; i += NTHREADS) rpbs[i] = rpb[i];
                __syncthreads();
                const int gws = ((F.G & 7) == 0 ? (c_id & 7) * (F.G >> 3) + (c_id >> 3) : c_id) * NWAVES + F.wave;
                if (args.mode == 0 && F.G == 256) {
                    na_rounds(F, proj, (const GAS bf16_t*)(ws + WS_VTA), rpbs, ycat, (c_id & 7) * 32 + (c_id >> 3));
                    pool_item(F, proj, pt, ycat, gws);
                } else
                for (int it = gws; it < 8192 + NTOK / 16; it += F.ngw) {
                    if (it < 8192) { if (args.mode != 3) na_item(F, proj, (const GAS bf16_t*)(ws + WS_VTA), rpbs, ycat, it); } else if (args.mode != 1) pool_item(F, proj, pt, ycat, it - 8192);
                }
                __syncthreads(); }
            if (args.mode == 0) for (int item = blockIdx.x; item < 1024; item += F.G) ret_r1_item(F, proj, rope, (GAS bf16_t*)(ws + WS_RET), item);
            const GAS float* convw = F.inp(I_CONVW) + (size_t)l * 4 * 768; const GAS float* alog = F.inp(I_ALOG) + l * 8; const GAS float* dtb = F.inp(I_DTB) + l * 8;
            if (args.mode != 1 && args.mode != 3 && args.mode != 4) for (int item = blockIdx.x; item < 2048; item += F.G) gdn_g1_item(F, proj, (const GAS float*)(ws + WS_AB), convw, alog, dtb, ws + WS_MIXS, item);
        }
        SEAM(pb + LP_MIX);
        if (INL(LP_MIX2)) { PH_ENTER(); (void)c_id;
            const int nsc = (F.G >= 256) ? 128 : 0;
            if (nsc == 0) { for (int ch = blockIdx.x; ch < 128; ch += F.G) gdn_scan_block(F, ws + WS_MIXS, (GAS bf16_t*)((GAS unsigned char*)F.out + 16 * MiB), ch);
                ret_r2_scan(F, (const GAS bf16_t*)(ws + WS_RET), (GAS bf16_t*)F.out, (size_t)blockIdx.x * NTHREADS + F.tid, (size_t)F.G * NTHREADS); }
            else if ((int)blockIdx.x < nsc) { const int cb = blockIdx.x, chain = (((cb & 7) * 4 + (cb >> 5)) * 4) + ((cb >> 3) & 3);
                gdn_scan_block(F, ws + WS_MIXS, (GAS bf16_t*)((GAS unsigned char*)F.out + 16 * MiB), chain); __syncthreads(); }
            else { const int wb = (int)blockIdx.x - nsc, nwb = F.G - nsc;
                ret_r2_scan(F, (const GAS bf16_t*)(ws + WS_RET), (GAS bf16_t*)F.out, (size_t)wb * NTHREADS + F.tid, (size_t)nwb * NTHREADS); }
            convert_experts_queue(F, l);
        }
        SEAM(pb + LP_MIX2);
        if (INL(LP_FIN)) { PH_ENTER(); (void)c_id;
            const GAS float* retg = F.inp(I_RETG) + l * 256; const GAS float* gdng = F.inp(I_GDNG) + l * 64;
            for (int item = blockIdx.x; item < 1024; item += F.G) ret_r3_item(F, (const GAS bf16_t*)(ws + WS_PROJ), (const GAS bf16_t*)F.out, retg, (GAS bf16_t*)(ws + WS_YCAT), item);
            gdn_finalize(F, (const GAS bf16_t*)(ws + WS_PROJ), (const GAS bf16_t*)((GAS unsigned char*)F.out + 16 * MiB), gdng, (GAS bf16_t*)(ws + WS_YCAT), F.gw, F.ngw);
        }
        SEAM(pb + LP_FIN);
        if (INL(LP_OUTPROJ)) { PH_ENTER();
            OrdStd S{(const GAS char*)(ws + WS_YCAT), (const GAS char*)(ws + WS_WOUT) + (size_t)l * DM * DM * 2, (size_t)256 * DM * 2, (size_t)256 * DM * 2, 0, NTOK / 256, 4, F.G, c_id};
            EpiResid E{(GAS bf16_t*)(ws + WS_XB), (GAS float*)(ws + WS_SSQ)};
            pg8::gemm_phase<EpiResid, OrdStd>(F.lds, F.tid, pg8::Gemm{DM, DM, DM}, S, E);
        }
        SEAM(pb + LP_OUTPROJ);
        if (INL(LP_SCORES)) { PH_ENTER();
            OrdStd S{(const GAS char*)(ws + WS_XB), (const GAS char*)(ws + WS_KQT) + (size_t)l * 4 * DM * DM * 2, (size_t)256 * DM * 2, (size_t)256 * DM * 2, (size_t)DM * DM * 2, NTOK / 256, 4, F.G, c_id};
            EpiSoftmax E{(GAS bf16_t*)(ws + WS_P), (const GAS float*)(ws + WS_SSQ), (LAS float*)(F.lds + LDS_EX)};
            pg8::gemm_phase<EpiSoftmax, OrdStd>(F.lds, F.tid, pg8::Gemm{DM, DM, DM}, S, E);
        }
        SEAM(pb + LP_SCORES);
        if (INL(LP_PV)) { PH_ENTER();
            OrdStd S{(const GAS char*)(ws + WS_P), (const GAS char*)(ws + WS_VOT) + (size_t)l * 4 * DM * DM * 2, (size_t)256 * DM * 2, (size_t)256 * DM * 2, (size_t)DM * DM * 2, NTOK / 256, 4, F.G, c_id};
            EpiResid E{(GAS bf16_t*)(ws + WS_XB), (GAS float*)(ws + WS_SSQ)};
            pg8::gemm_phase<EpiResid, OrdStd, false, true>(F.lds, F.tid, pg8::Gemm{DM, DM, DM}, S, E);
        }
        SEAM(pb + LP_PV);
        if (INL(LP_ROUTER)) { PH_ENTER(); (void)c_id; (void)ws; router_phase(F, l); }
        SEAM(pb + LP_ROUTER);
        if (INL(LP_ASSIGN)) { PH_ENTER(); (void)c_id; (void)ws; assign_gather_phase(F, l); }
        SEAM(pb + LP_ASSIGN);
        if (INL(LP_GATEUP)) { PH_ENTER();
            LAS int* pad_end = (LAS int*)(F.lds + LDS_MISC + 64);
            const int total = moe_pad_table(F, l, pad_end);
            int cs = ((F.G & 7) == 0) ? (c_id & 7) * (F.G >> 3) + (c_id >> 3) : c_id; asm volatile("" : "+s"(cs));
            OrdMoE S{(const GAS char*)(ws + WS_XB), (const GAS char*)(ws + WS_WGU), (size_t)0, (size_t)1024 * DM * 2, (size_t)256 * DM * 2, (total / 256) * 4, pad_end, F.G, cs, (const GAS int*)(ws + WS_SLOT + SL_TOK), (GAS unsigned*)(ws + WS_CTL) + CW_PAN + l * 320 * 16, 0};
            EpiGateUp E{(GAS bf16_t*)(ws + WS_HMID), (const GAS float*)(ws + WS_SLOT + SL_RSTD)};
            pg8::gemm_phase<EpiGateUp, OrdMoE, true, false, true>(F.lds, F.tid, pg8::Gemm{DM, DM, DM}, S, E);
        }
        if (INL(LP_DOWN)) { PH_ENTER();
            LAS int* pad_end = (LAS int*)(F.lds + LDS_MISC + 64);
            const int total = moe_pad_table(F, l, pad_end);
            int cs = ((F.G & 7) == 0) ? (c_id & 7) * (F.G >> 3) + (c_id >> 3) : c_id; const int nu = (total / 256) * 4, rem = nu % F.G; cs -= rem; if (cs < 0) cs += F.G; cs = __builtin_amdgcn_readfirstlane(cs); const int bal = __builtin_amdgcn_readfirstlane((3 * rem <= F.G && nu >= 2 * F.G) ? 1 : 0);
            OrdMoE S{(const GAS char*)(ws + WS_HMID), (const GAS char*)(ws + WS_WD), (size_t)256 * DEXP * 2, (size_t)1024 * DEXP * 2, (size_t)256 * DEXP * 2, (total / 256) * 4, pad_end, F.G, cs, nullptr, (GAS unsigned*)(ws + WS_CTL) + CW_PAN + l * 320 * 16, bal};
            EpiDown E{(GAS bf16_t*)(ws + WS_SORTA), (const GAS float*)(ws + WS_SLOT + SL_W)};
            pg8::gemm_phase<EpiDown, OrdMoE, false, true, true>(F.lds, F.tid, pg8::Gemm{DEXP, DEXP, DEXP}, S, E);
        }
        SEAM(pb + LP_DOWN);
        if (INL(LP_COMBINE)) { PH_ENTER(); (void)c_id; (void)ws; combine_phase(F, l); }
        SEAM(pb + LP_COMBINE);
    }
#undef IN
#undef SEAM
}

extern "C" void kernel_launch(void* const* d_in, const int* in_sizes, int n_in, void* d_out, int out_size, void* d_ws, size_t ws_size, hipStream_t stream) {
    static int grid = 0;
    if (grid == 0) {
        if (n_in != 28 || out_size != NTOK * DM || ws_size < WS_END) { fprintf(stderr, "kernel_launch: unexpected shapes (n_in %d out %d ws %zu need %zu)\n", n_in, out_size, ws_size, (size_t)WS_END); grid = -1; return; }
        int dev = 0, cus = 0;
        if (hipGetDevice(&dev) != hipSuccess || hipDeviceGetAttribute(&cus, hipDeviceAttributeMultiprocessorCount, dev) != hipSuccess) { grid = -1; return; }
        if (hipFuncSetAttribute((const void*)fwd_kernel, hipFuncAttributeMaxDynamicSharedMemorySize, LDS_BYTES) != hipSuccess) { grid = -1; return; }
        int per_cu = 0;
        if (hipOccupancyMaxActiveBlocksPerMultiprocessor(&per_cu, (const void*)fwd_kernel, NTHREADS, LDS_BYTES) != hipSuccess || per_cu < 1) { fprintf(stderr, "occupancy query: %d\n", per_cu); }
        (void)hipGetLastError();
        grid = cus;
    }
    if (grid < 0) return;
    (void)hipMemsetAsync((char*)d_ws + WS_CTL, 0, CTL_ZERO_BYTES, stream);
    Args a{};
    for (int i = 0; i < 28; ++i) a.in[i] = (const float*)d_in[i];
    a.out = (float*)d_out; a.ws = (unsigned char*)d_ws;
#if MK_ONE_LAUNCH
    a.ph_lo = 0; a.ph_hi = NPH;
    hipLaunchKernelGGL(fwd_kernel, dim3(grid), dim3(NTHREADS), LDS_BYTES, stream, a);
#else
#ifndef PROBE_PH
#define PROBE_PH -1
#endif
#ifndef PROBE_REPS
#define PROBE_REPS 1
#endif
    for (int p = 0; p < NPH; ++p) { a.ph_lo = p; a.ph_hi = p + 1; const int reps = (PROBE_PH >= 0 && (p == PROBE_PH || p == PROBE_PH + PPL)) ? 1 + PROBE_REPS : 1;
#ifndef PROBE_MODE
#define PROBE_MODE 0
#endif
        for (int r = 0; r < reps; ++r) { a.mode = (r > 0) ? PROBE_MODE : 0; hipLaunchKernelGGL(fwd_kernel, dim3(grid), dim3(NTHREADS), LDS_BYTES, stream, a); } a.mode = 0; }
#endif
}
```

```cpp
#include <hip/hip_runtime.h>
#include <stdint.h>
#include <stdio.h>

#define LAS __attribute__((address_space(3)))
#define GAS __attribute__((address_space(1)))
typedef unsigned short bf16_t;
typedef short bf16x8 __attribute__((ext_vector_type(8)));
typedef float f32x4 __attribute__((ext_vector_type(4)));
typedef float f32x2 __attribute__((ext_vector_type(2)));
typedef unsigned u32x4 __attribute__((ext_vector_type(4)));
typedef unsigned u32x2 __attribute__((ext_vector_type(2)));

#ifndef MK_ONE_LAUNCH
#define MK_ONE_LAUNCH 1
#endif

constexpr int NB = 4, SEQ = 8192, DM = 1024, NTOK = NB * SEQ, NMEM = 256, DEPTH = 2;
constexpr int PINP = 3072;
constexpr int NEXP = 32, DEXP = 512;
constexpr int CAP = NTOK * 2 + NEXP * 256;
constexpr float EPS = 1e-6f;
constexpr int NWAVES = 8, NTHREADS = 512;

constexpr size_t MiB = 1u << 20;
constexpr size_t WS_CTL   = 0;
constexpr size_t WS_WIN   = 1 * MiB;
constexpr size_t WS_WOUT  = 14 * MiB;
constexpr size_t WS_WQB   = 18 * MiB;
constexpr size_t WS_WKV   = 22 * MiB;
constexpr size_t WS_WOT   = 30 * MiB;
constexpr size_t WS_MEMN  = 34 * MiB;
constexpr size_t WS_KV    = 38 * MiB;
constexpr size_t WS_KQT   = 46 * MiB;
constexpr size_t WS_VOT   = 62 * MiB;
constexpr size_t WS_SSQ   = 78 * MiB;
constexpr size_t WS_TAB   = 80 * MiB;
constexpr size_t WS_XB    = 84 * MiB;
constexpr size_t WS_STAGE = 148 * MiB;
constexpr size_t WS_PROJ  = WS_STAGE;
constexpr size_t WS_VTA   = WS_PROJ + 32 * MiB;
constexpr size_t WS_WD    = WS_PROJ;
constexpr size_t WS_P     = WS_PROJ + 48 * MiB;
constexpr size_t WS_WGU   = WS_PROJ + 112 * MiB;
constexpr size_t WS_AB    = WS_PROJ + 192 * MiB;
constexpr size_t WS_YCAT  = WS_AB + 2 * MiB;
constexpr size_t WS_MIXS  = WS_YCAT + 64 * MiB;
constexpr size_t WS_RET   = WS_MIXS + 128 * MiB;
constexpr size_t WS_MIX_END = WS_RET + 16 * MiB;
constexpr size_t WS_SORTA = WS_AB;
constexpr size_t WS_HMID  = WS_SORTA + 144 * MiB;
constexpr size_t WS_SLOT  = WS_HMID + 72 * MiB;
constexpr size_t WS_MOE_END = WS_SLOT + 2 * MiB;
constexpr size_t WS_END = WS_MIX_END > WS_MOE_END ? WS_MIX_END : WS_MOE_END;
static_assert(WS_END <= 580 * MiB, "workspace budget");
constexpr size_t TAB_ROPE = 0;
constexpr size_t TAB_RFR  = 2 * MiB;
constexpr size_t TAB_POOL = 3 * MiB;
constexpr size_t SL_TOK = 0, SL_W = 512 * 1024, SL_RSTD = 1024 * 1024, SL_TSLOT = 1536 * 1024;
constexpr size_t TAB_TOKE = 3 * MiB + 256 * 1024;
constexpr size_t TAB_TOKW = 3 * MiB + 512 * 1024;
constexpr size_t TAB_RSTD = 3 * MiB + 832 * 1024;
constexpr size_t TAB_ABF  = 3 * MiB + 768 * 1024;
constexpr int CW_BAR = 4096;
constexpr int CW_CNT = 16384;
constexpr int CW_CUR = 16384 + 64;
constexpr int CW_PAN = 16384 + 1024;
constexpr int CW_CQ = 16384 + 256;
constexpr size_t CTL_ZERO_BYTES = 1 * MiB;

constexpr int LDS_RING = 0, LDS_RING_BYTES = 131072;
constexpr int LDS_EX = 131072;
constexpr int LDS_MISC = 131072 + 8192;
constexpr int LDS_BYTES = 147456;

typedef __bf16 bf16v2_t __attribute__((ext_vector_type(2)));
__device__ __forceinline__ unsigned pk2(float lo, float hi) { const f32x2 v = (f32x2){lo, hi}; const bf16v2_t r = __builtin_convertvector(v, bf16v2_t); return __builtin_bit_cast(unsigned, r); }
__device__ __forceinline__ unsigned f2bf(float f) { return pk2(f, f) & 0xffffu; }
__device__ __forceinline__ float bflo(unsigned w) { return __builtin_bit_cast(float, w << 16); }
__device__ __forceinline__ float bfhi(unsigned w) { return __builtin_bit_cast(float, w & 0xffff0000u); }
__device__ __forceinline__ float bf2f(bf16_t b) { return __builtin_bit_cast(float, ((unsigned)b) << 16); }
__device__ __forceinline__ int lane_now() { unsigned z = 0u; asm volatile("" : "+v"(z)); return (int)__builtin_amdgcn_mbcnt_hi(~0u, __builtin_amdgcn_mbcnt_lo(~0u, z)); }
__device__ __forceinline__ float shfl_xor_f(float v, int m) { return __builtin_bit_cast(float, __builtin_amdgcn_ds_bpermute((lane_now() ^ m) << 2, __builtin_bit_cast(int, v))); }
__device__ __forceinline__ float shfl_f(float v, int src) { return __builtin_bit_cast(float, __builtin_amdgcn_ds_bpermute(src << 2, __builtin_bit_cast(int, v))); }
__device__ __forceinline__ float wave_sum(float v) {
#pragma unroll
    for (int o = 1; o < 64; o <<= 1) v += shfl_xor_f(v, o);
    return v;
}
__device__ __forceinline__ float wave_max(float v) {
#pragma unroll
    for (int o = 1; o < 64; o <<= 1) v = fmaxf(v, shfl_xor_f(v, o));
    return v;
}
__device__ __forceinline__ float silu_f(float x) { return x * __builtin_amdgcn_rcpf(1.f + __expf(-x)); }
__device__ __forceinline__ float sigmoid_f(float x) { return __builtin_amdgcn_rcpf(1.f + __expf(-x)); }
__device__ __forceinline__ float softplus_f(float x) { const float e = __expf(x); return x > 15.f ? x : (x < -15.f ? e : __logf(1.0f + e)); }
#define LDS_WAIT() asm volatile("s_waitcnt lgkmcnt(0)" ::: "memory")
#define VM_WAIT() asm volatile("s_waitcnt vmcnt(0)" ::: "memory")

#define XB_TMO      128
#define XB_XCNT(j)  (256  + 64 * (j))
#define XB_XSUB(j)  (1280 + 64 * (j))
#define XB_XGEN(j)  (2304 + 64 * (j))
#define XB_TOP      3328
#define XB_TOPGEN   3392
#define XCD_BAR_WORDS 3456
#define XB_SPIN_CAP (1u << 22)

__device__ __forceinline__ unsigned xb_ld(GAS unsigned* p)              { return __hip_atomic_load(p, __ATOMIC_RELAXED, __HIP_MEMORY_SCOPE_AGENT); }
__device__ __forceinline__ unsigned xb_add(GAS unsigned* p, unsigned v) { return __hip_atomic_fetch_add(p, v, __ATOMIC_RELAXED, __HIP_MEMORY_SCOPE_AGENT); }
__device__ __forceinline__ unsigned xb_xcc_id() { return (unsigned)__builtin_amdgcn_s_getreg((3 << 11) | 20) & 0xFu; }
#define XB_SPIN(cond, bar) do { unsigned _sp = 0; while (cond) { __builtin_amdgcn_s_sleep(1); \
    if ((++_sp & 255u) == 0u) { if (xb_ld(&(bar)[XB_TMO])) break; if (_sp > XB_SPIN_CAP) { xb_add(&(bar)[XB_TMO], 1u); break; } } } } while (0)

struct XcdBarrier { GAS unsigned* bar; unsigned x; volatile LAS unsigned* st; };

__device__ __forceinline__ XcdBarrier xcd_barrier_post(GAS unsigned* bar, volatile LAS unsigned* st, const bool leader) {
    XcdBarrier b; b.bar = bar; b.x = xb_xcc_id(); b.st = st;
    if (leader) (void)xb_add(&bar[XB_XCNT(b.x)], 1u);
    return b;
}
__device__ __forceinline__ void xcd_barrier_complete(GAS unsigned* bar, unsigned x, unsigned& nloc, unsigned& nx) {
    const unsigned G = gridDim.x * gridDim.y * gridDim.z;
    unsigned sum, cnt, mine, sp = 0u;
    for (;;) {
        sum = 0u; cnt = 0u; mine = 0u;
#pragma unroll
        for (unsigned j = 0; j < 16; ++j) { const unsigned c = xb_ld(&bar[XB_XCNT(j)]); sum += c; cnt += (c > 0u) ? 1u : 0u; mine = (j == x) ? c : mine; }
        if (sum == G) break;
        __builtin_amdgcn_s_sleep(1);
        if ((++sp & 255u) == 0u) { if (xb_ld(&bar[XB_TMO])) break; if (sp > XB_SPIN_CAP) { xb_add(&bar[XB_TMO], 1u); break; } }
    }
    nloc = mine > 0u ? mine : 1u; nx = cnt > 0u ? cnt : 1u;
}
__device__ __forceinline__ void xcd_barrier(const XcdBarrier& b, const bool leader) {
    asm volatile("s_waitcnt vmcnt(0)" ::: "memory");
    __syncthreads();
    if (leader) {
        GAS unsigned* bar = b.bar;
        __builtin_amdgcn_s_waitcnt(0);
        unsigned nloc = b.st[0], nx = b.st[1];
        if (nloc == 0u) { xcd_barrier_complete(bar, b.x, nloc, nx); b.st[0] = nloc; b.st[1] = nx; }
        const unsigned old = xb_add(&bar[XB_XSUB(b.x)], 1u);
        const unsigned gen = old / nloc;
        if (old + 1u == (gen + 1u) * nloc) {
            __builtin_amdgcn_fence(__ATOMIC_RELEASE, "agent");
            asm volatile("s_waitcnt vmcnt(0)" ::: "memory");
            const unsigned og = xb_add(&bar[XB_TOP], 1u);
            const unsigned tg = og / nx;
            if (og + 1u == (tg + 1u) * nx) xb_add(&bar[XB_TOPGEN], 1u);
            else XB_SPIN(xb_ld(&bar[XB_TOPGEN]) == tg, bar);
            __builtin_amdgcn_fence(__ATOMIC_ACQUIRE, "agent");
            xb_add(&bar[XB_XGEN(b.x)], 1u);
            asm volatile("s_waitcnt vmcnt(0)" ::: "memory");
        } else {
            XB_SPIN(xb_ld(&bar[XB_XGEN(b.x)]) == gen, bar);
            __builtin_amdgcn_fence(__ATOMIC_ACQUIRE, "agent");
            asm volatile("s_waitcnt vmcnt(0)" ::: "memory");
        }
    }
    __syncthreads();
}

namespace pg8 {
constexpr int BM = 256, BK = 64, HALF = 128, HTB = HALF * BK * 2, STAGE_BYTES = 8 * HTB, NXCD = 8, WGM = 8;
__host__ __device__ __forceinline__ int lds_byte(int r, int c) { const int st = (r >> 4) * 2 + (c >> 5), rr = r & 15, cc = c & 31, ob = rr * 64 + cc * 2; return st * 1024 + (ob ^ (((ob >> 9) & 1) << 5)); }
__host__ __device__ __forceinline__ void stage_rc(int b, int& R, int& C) { const int st = b / 1024, sb = b % 1024, swz = sb ^ (((sb >> 9) & 1) << 5); R = (st >> 1) * 16 + swz / 64; C = (st & 1) * 32 + (swz % 64) / 2; }
__host__ __device__ __forceinline__ int perm32(int rho) { const int n = rho >> 4, i = rho & 15; return 8 * (i >> 2) + 4 * n + (i & 3); }

struct Unit { int pm, pn, z; };
struct Gemm { int lda, ldb, K; };

__device__ __forceinline__ void static_map(int wgid, int nM, int nN, int& pm, int& pn) {
    const int nwg = nM * nN;
    { const int q = nwg / NXCD, r = nwg % NXCD, xcd = wgid % NXCD, off = wgid / NXCD; wgid = (xcd < r ? xcd * (q + 1) : r * (q + 1) + (xcd - r) * q) + off; }
    const int nig = WGM * nN, gid = wgid / nig, fm = gid * WGM, gsz = (nM - fm) < WGM ? (nM - fm) : WGM;
    pm = fm + ((wgid % nig) % gsz); pn = (wgid % nig) / gsz;
}

__device__ __forceinline__ unsigned cvt_pk_bf16(float lo, float hi) { unsigned r; asm volatile("v_cvt_pk_bf16_f32 %0, %1, %2" : "=v"(r) : "v"(lo), "v"(hi)); return r; }

template <class Epi, class Sched, bool GATHER = false, bool ABLK = false, bool HOOKS = false>
__device__ __forceinline__ void gemm_phase(LAS unsigned char* lds, const int tid, const Gemm g, const Sched& S, const Epi& E) {
    const int wid = __builtin_amdgcn_readfirstlane(tid >> 6), lane = tid & 63, wr = wid >> 2, wc = wid & 3, fr = lane & 15, fq = lane >> 4;
    const int K = g.K, nt = K / BK;
    unsigned voffA[2], voffB[2];
#pragma unroll
    for (int i = 0; i < 2; ++i) { int R, C; stage_rc(tid * 16 + i * 8192, R, C); const int Rb = Epi::PERM ? ((R & ~31) + perm32(R & 31)) : R;
        voffA[i] = ABLK ? (unsigned)((R >> 4) * 16 * g.lda) * 2u + (unsigned)(((C >> 5) * 4 + (lane >> 4)) * 256 + (lane & 15) * 16) : (unsigned)(R * g.lda + C) * 2u; voffB[i] = (unsigned)(Rb * g.ldb + C) * 2u; }
    unsigned voA[2][2]; int gr[2][2];
#define PG8_GROWS(u) do { _Pragma("unroll") for (int _h = 0; _h < 2; ++_h) _Pragma("unroll") for (int _i = 0; _i < 2; ++_i) { int _R, _C; stage_rc(tid * 16 + _i * 8192, _R, _C); gr[_h][_i] = S.row_of((u), _h * HALF + _R); } } while (0)
#define PG8_GOFFS(dst) do { _Pragma("unroll") for (int _h = 0; _h < 2; ++_h) _Pragma("unroll") for (int _i = 0; _i < 2; ++_i) { int _R, _C; stage_rc(tid * 16 + _i * 8192, _R, _C); (dst)[_h][_i] = (unsigned)(gr[_h][_i] * g.lda + _C) * 2u; } } while (0)
    const size_t kstep = (size_t)(BK * 2), kstepA = ABLK ? (size_t)2048 : kstep;
    const size_t hstepA = (size_t)HALF * g.lda * 2, hstepB = (size_t)HALF * g.ldb * 2;
    const unsigned ldsw = (unsigned)wid * 1024u;
    const int aoff = ABLK ? wr * 8192 + fq * 256 + fr * 16 : lds_byte(wr * 64 + fr, fq * 8), boff = lds_byte(wc * 32 + fr, fq * 8);
#define PG8_SA(b, h) (((b) * 2 + (h)) * HTB)
#define PG8_SB(b, h) ((4 + (b) * 2 + (h)) * HTB)
#define PG8_STAGE(bufoff, gbase, voff) do { _Pragma("unroll") for (int _i = 0; _i < 2; ++_i) \
        __builtin_amdgcn_global_load_lds((const GAS unsigned*)((const GAS char*)(gbase) + (voff)[_i]), (LAS unsigned*)(lds + (bufoff) + ldsw + _i * 8192), 16, 0, 0); } while (0)
#define PG8_LDA(dst, b, h) do { _Pragma("unroll") for (int m = 0; m < 4; ++m) _Pragma("unroll") for (int k = 0; k < 2; ++k) dst[m][k] = *(const LAS bf16x8*)(lds + PG8_SA(b, h) + aoff + m * 2048 + k * 1024); } while (0)
#define PG8_LDB(dst, b, h) do { _Pragma("unroll") for (int n = 0; n < 2; ++n) _Pragma("unroll") for (int k = 0; k < 2; ++k) dst[n][k] = *(const LAS bf16x8*)(lds + PG8_SB(b, h) + boff + n * 2048 + k * 1024); } while (0)
#define PG8_MMA(ai, bj, At, Bt) do { __builtin_amdgcn_s_setprio(1); _Pragma("unroll") for (int m = 0; m < 4; ++m) _Pragma("unroll") for (int n = 0; n < 2; ++n) _Pragma("unroll") for (int k = 0; k < 2; ++k) \
        acc[ai][bj][m][n] = __builtin_amdgcn_mfma_f32_16x16x32_bf16(Bt[n][k], At[m][k], acc[ai][bj][m][n], 0, 0, 0); __builtin_amdgcn_s_setprio(0); } while (0)
#define PG8_WAIT_V(n) asm volatile("s_waitcnt vmcnt(" #n ")" ::: "memory")
#define PG8_WAIT_L(n) asm volatile("s_waitcnt lgkmcnt(" #n ")" ::: "memory")
#define PG8_BAR __builtin_amdgcn_s_barrier()
#define PG8_SCHED __builtin_amdgcn_sched_barrier(0)
    Unit cur, nxt; int ui = 0;
    if (!S.next(0, cur)) return;
    if constexpr (HOOKS) S.a_ready(cur, wid);
    f32x4 acc[2][2][4][2];
#pragma unroll
    for (int a = 0; a < 2; ++a)
#pragma unroll
        for (int b = 0; b < 2; ++b)
#pragma unroll
            for (int m = 0; m < 4; ++m)
#pragma unroll
                for (int n = 0; n < 2; ++n) acc[a][b][m][n] = (f32x4){0.f, 0.f, 0.f, 0.f};
    bf16x8 At[4][2], B0[2][2], B1[2][2];
    const GAS char* cA = S.a_ptr(cur); const GAS char* cB = S.b_ptr(cur);
    {
        if constexpr (GATHER) { PG8_GROWS(cur); PG8_GOFFS(voA); }
        else { _Pragma("unroll") for (int _i = 0; _i < 2; ++_i) { voA[0][_i] = voffA[_i]; voA[1][_i] = voffA[_i] + (unsigned)hstepA; } }
        PG8_STAGE(PG8_SB(0, 0), cB, voffB); PG8_STAGE(PG8_SB(0, 1), cB + hstepB, voffB); PG8_STAGE(PG8_SA(0, 0), cA, voA[0]); PG8_STAGE(PG8_SA(0, 1), cA, voA[1]);
        if (wr == 1) PG8_BAR;
        PG8_WAIT_V(2); PG8_BAR;
        PG8_STAGE(PG8_SB(1, 0), cB + kstep, voffB); PG8_STAGE(PG8_SA(1, 0), cA + kstepA, voA[0]); PG8_STAGE(PG8_SB(1, 1), cB + hstepB + kstep, voffB);
        PG8_WAIT_V(6); PG8_BAR;
    }
    for (;;) {
        const bool has_next = S.next(ui + 1, nxt);
        const GAS char* nA = has_next ? S.a_ptr(nxt) : cA; const GAS char* nB = has_next ? S.b_ptr(nxt) : cB;
        if constexpr (HOOKS) { if (has_next) S.a_ready(nxt, wid); }
        if constexpr (GATHER) { if (has_next) PG8_GROWS(nxt); }
        for (int t = 0; t < nt; t += 2) {
            const bool last = (t == nt - 2);
            const GAS char* a1 = cA + (size_t)(t + 1) * kstepA;
            const GAS char* a2 = last ? nA : cA + (size_t)(t + 2) * kstepA; const GAS char* b2 = last ? nB : cB + (size_t)(t + 2) * kstep;
            const GAS char* a3 = a2 + kstepA; const GAS char* b3 = b2 + kstep;
            PG8_LDB(B0, 0, 0); PG8_LDB(B1, 0, 1); PG8_SCHED; PG8_LDA(At, 0, 0); PG8_STAGE(PG8_SA(1, 1), a1, voA[1]);
            if constexpr (GATHER) { if (last && has_next) { asm volatile("" : "+v"(gr[0][0]), "+v"(gr[0][1]), "+v"(gr[1][0]), "+v"(gr[1][1])); PG8_GOFFS(voA); } }
            PG8_WAIT_V(8); PG8_WAIT_L(0); PG8_BAR; PG8_MMA(0, 0, At, B0); PG8_MMA(0, 1, At, B1); PG8_BAR; PG8_SCHED;
            PG8_LDA(At, 0, 1); PG8_STAGE(PG8_SB(0, 0), b2, voffB); PG8_STAGE(PG8_SB(0, 1), b2 + hstepB, voffB); PG8_STAGE(PG8_SA(0, 0), a2, voA[0]);
            PG8_WAIT_V(8); PG8_WAIT_L(0); PG8_BAR; PG8_MMA(1, 0, At, B0); PG8_MMA(1, 1, At, B1); PG8_BAR; PG8_SCHED;
            PG8_LDB(B0, 1, 0); PG8_LDB(B1, 1, 1); PG8_SCHED; PG8_LDA(At, 1, 0); PG8_STAGE(PG8_SA(0, 1), a2, voA[1]);
            PG8_WAIT_V(8); PG8_WAIT_L(0); PG8_BAR; PG8_MMA(0, 0, At, B0); PG8_MMA(0, 1, At, B1); PG8_BAR; PG8_SCHED;
            PG8_LDA(At, 1, 1); PG8_STAGE(PG8_SB(1, 0), b3, voffB); PG8_STAGE(PG8_SB(1, 1), b3 + hstepB, voffB); PG8_STAGE(PG8_SA(1, 0), a3, voA[0]);
            PG8_WAIT_V(8); PG8_WAIT_L(0); PG8_BAR; PG8_MMA(1, 0, At, B0); PG8_MMA(1, 1, At, B1); PG8_BAR; PG8_SCHED;
        }
        if (wr == 0) PG8_BAR;
        E(acc, cur, wr, wc, fr, fq);
        if constexpr (HOOKS) S.done(cur);
        if (!has_next) break;
#pragma unroll
        for (int a = 0; a < 2; ++a)
#pragma unroll
            for (int b = 0; b < 2; ++b)
#pragma unroll
                for (int m = 0; m < 4; ++m)
#pragma unroll
                    for (int n = 0; n < 2; ++n) acc[a][b][m][n] = (f32x4){0.f, 0.f, 0.f, 0.f};
        cur = nxt; cA = nA; cB = nB; ++ui;
        if (wr == 1) PG8_BAR;
    }
    PG8_WAIT_V(0);
    PG8_BAR;
#undef PG8_GROWS
#undef PG8_GOFFS
#undef PG8_SA
#undef PG8_SB
#undef PG8_STAGE
#undef PG8_LDA
#undef PG8_LDB
#undef PG8_MMA
#undef PG8_WAIT_V
#undef PG8_WAIT_L
#undef PG8_BAR
#undef PG8_SCHED
}
}

struct OrdStd {
    const GAS char* A; const GAS char* B; size_t a_tile, b_tile, b_batch; int nM, nN, G, c;
    __device__ __forceinline__ bool next(int i, pg8::Unit& u) const {
        const long L = (long)i * G + c; if (L >= (long)nM * nN) return false;
        pg8::static_map((int)L, nM, nN, u.pm, u.pn); u.z = 0; return true; }
    __device__ __forceinline__ const GAS char* a_ptr(const pg8::Unit& u) const { return A + (size_t)u.pm * a_tile; }
    __device__ __forceinline__ const GAS char* b_ptr(const pg8::Unit& u) const { return B + (size_t)(u.pm >> 5) * b_batch + (size_t)u.pn * b_tile; }
};
struct OrdInProj {
    const GAS char* A; const GAS char* B; size_t tile; int nM, nN, G, c;
    __device__ __forceinline__ bool next(int i, pg8::Unit& u) const {
        const long L = (long)i * G + c; if (L >= (long)nM * nN) return false;
        pg8::static_map((int)L, nM, nN, u.pm, u.pn); u.z = 0; return true; }
    __device__ __forceinline__ const GAS char* a_ptr(const pg8::Unit& u) const { return u.pn == 2 ? B + (size_t)u.pn * tile : A + (size_t)u.pm * tile; }
    __device__ __forceinline__ const GAS char* b_ptr(const pg8::Unit& u) const { return u.pn == 2 ? A + (size_t)u.pm * tile : B + (size_t)u.pn * tile; }
};
struct OrdKV {
    const GAS char* memn; const GAS char* wkv; int G, c;
    __device__ __forceinline__ bool next(int i, pg8::Unit& u) const { const int L = i * G + c; if (L >= 64) return false; u.pm = L >> 3; u.pn = L & 7; u.z = 0; return true; }
    __device__ __forceinline__ const GAS char* a_ptr(const pg8::Unit& u) const { return memn + (size_t)u.pm * 256 * 1024 * 2; }
    __device__ __forceinline__ const GAS char* b_ptr(const pg8::Unit& u) const { return wkv + ((size_t)(u.pm >> 2) * 2048 + (size_t)u.pn * 256) * 1024 * 2; }
};
struct OrdKq {
    const GAS char* kv; const GAS char* wqb; int G, c;
    __device__ __forceinline__ bool next(int i, pg8::Unit& u) const { const int L = i * G + c; if (L >= 128) return false;
        const int l = L >> 6, b = (L >> 4) & 3, h = (L >> 2) & 3, q = L & 3; u.pm = (l * 4 + b) * 4 + h; u.pn = q; u.z = L; return true; }
    __device__ __forceinline__ const GAS char* a_ptr(const pg8::Unit& u) const { const int L = u.z, l = L >> 6, b = (L >> 4) & 3, h = (L >> 2) & 3;
        return kv + (((size_t)l * 1024 + b * 256) * 2048 + h * 256) * 2; }
    __device__ __forceinline__ const GAS char* b_ptr(const pg8::Unit& u) const { const int L = u.z, l = L >> 6, h = (L >> 2) & 3, q = L & 3;
        return wqb + ((size_t)l * 1048576 + (size_t)q * 256 * 1024 + h * 256) * 2; }
};
struct OrdVo {
    const GAS char* kv; const GAS char* wot; int G, c;
    __device__ __forceinline__ bool next(int i, pg8::Unit& u) const { const int L = i * G + c; if (L >= 128) return false;
        const int l = L >> 6, b = (L >> 4) & 3, h = (L >> 2) & 3, q = L & 3; u.pm = (l * 4 + b) * 4 + q; u.pn = h; u.z = L; return true; }
    __device__ __forceinline__ const GAS char* a_ptr(const pg8::Unit& u) const { const int L = u.z, l = L >> 6, h = (L >> 2) & 3, q = L & 3;
        return wot + ((size_t)l * 1048576 + (size_t)q * 256 * 1024 + h * 256) * 2; }
    __device__ __forceinline__ const GAS char* b_ptr(const pg8::Unit& u) const { const int L = u.z, l = L >> 6, b = (L >> 4) & 3, h = (L >> 2) & 3;
        return kv + (((size_t)l * 1024 + b * 256) * 2048 + 1024 + h * 256) * 2; }
};
struct OrdMoE {
    const GAS char* A; const GAS char* B; size_t a_tile, b_exp, b_tile; int nunits; const LAS int* pad_end; int G, c; const GAS int* rowtab; GAS unsigned* pan; int bal;
    __device__ __forceinline__ bool next(int i, pg8::Unit& u) const {
        long L = (long)i * G + c;
        if (bal) {
            const int fr = nunits / G, rem = nunits - fr * G;
            if (i == fr - 1) { if (c >= G - rem) return false; }
            else if (i == fr) { if (c >= 2 * rem) return false; L = (long)fr * G - rem + c; }
            else if (i > fr) return false;
        }
        if (L >= nunits) return false;
        u.pm = (int)(L >> 2); u.pn = (int)(L & 3); int e = 0; const int r0 = u.pm * 256;
        const LAS int* pe = pad_end; asm volatile("" : "+v"(pe));
        for (int j = 0; j < NEXP; ++j) e += (pe[j] <= r0) ? 1 : 0;
        e = __builtin_amdgcn_readfirstlane(e);
        u.z = e < NEXP ? e : NEXP - 1; return true; }
    __device__ __forceinline__ const GAS char* a_ptr(const pg8::Unit& u) const { return A + (size_t)u.pm * a_tile; }
    __device__ __forceinline__ const GAS char* b_ptr(const pg8::Unit& u) const { return B + (size_t)u.z * b_exp + (size_t)u.pn * b_tile; }
    __device__ __forceinline__ int row_of(const pg8::Unit& u, int r) const { return rowtab[u.pm * 256 + r]; }
    __device__ __forceinline__ void done(const pg8::Unit& u) const {
        if (rowtab == nullptr) return;
        asm volatile("s_waitcnt vmcnt(0)" ::: "memory");
        if (lane_now() == 0) __hip_atomic_fetch_add(pan + 16 * u.pm, 1u, __ATOMIC_RELAXED, __HIP_MEMORY_SCOPE_AGENT);
    }
    __device__ __forceinline__ void a_ready(const pg8::Unit& u, int wid) const {
        if (rowtab != nullptr) return;
        if (wid == 0) { GAS unsigned* p = pan + 16 * u.pm; unsigned sp = 0;
            while (xb_ld(p) < 32u) { __builtin_amdgcn_s_sleep(1); if (++sp > XB_SPIN_CAP) break; }
            __builtin_amdgcn_fence(__ATOMIC_ACQUIRE, "agent"); asm volatile("s_waitcnt vmcnt(0)" ::: "memory"); }
        asm volatile("" ::: "memory"); __builtin_amdgcn_s_barrier(); asm volatile("" ::: "memory");
    }
};

typedef const f32x4 (&AccRef)[2][2][4][2];
__device__ __forceinline__ float row_rstd(const GAS float* ssq, int row) {
    const GAS f32x4* p = (const GAS f32x4*)(ssq + (size_t)row * 16);
    const f32x4 a = p[0], b = p[1], c = p[2], d = p[3];
    const float s = ((a.x + a.y) + (a.z + a.w)) + ((b.x + b.y) + (b.z + b.w)) + ((c.x + c.y) + (c.z + c.w)) + ((d.x + d.y) + (d.z + d.w));
    return rsqrtf(s * (1.0f / DM) + EPS);
}
__device__ __forceinline__ u32x4 pack8(f32x4 v0, f32x4 v1) {
    u32x4 w; w.x = pg8::cvt_pk_bf16(v0[0], v0[1]); w.y = pg8::cvt_pk_bf16(v0[2], v0[3]); w.z = pg8::cvt_pk_bf16(v1[0], v1[1]); w.w = pg8::cvt_pk_bf16(v1[2], v1[3]); return w; }

__device__ __forceinline__ void epi_row_scalars(float (&rsv)[2][4], const GAS float* tab, int row0, int fr, int fq) {
    float own[2];
#pragma unroll
    for (int ai = 0; ai < 2; ++ai) own[ai] = tab[row0 + ai * 128 + fq * 16];
#pragma unroll
    for (int ai = 0; ai < 2; ++ai)
#pragma unroll
        for (int m = 0; m < 4; ++m) rsv[ai][m] = __builtin_bit_cast(float, __builtin_amdgcn_ds_bpermute((m * 16 + fr) << 2, __builtin_bit_cast(int, own[ai])));
}
struct EpiBf {
    static constexpr bool PERM = true; GAS bf16_t* O; int ldc;
    __device__ __forceinline__ void operator()(AccRef acc, const pg8::Unit& u, int wr, int wc, int fr, int fq) const {
        { const int _l = lane_now(); fr = _l & 15; fq = _l >> 4; }
        const int row0 = u.pm * 256 + wr * 64 + fr, col0 = u.pn * 256 + wc * 32 + 8 * fq;
#pragma unroll
        for (int ai = 0; ai < 2; ++ai)
#pragma unroll
            for (int m = 0; m < 4; ++m) { asm volatile("" ::: "memory"); GAS bf16_t* rowp = O + (size_t)(row0 + ai * 128 + m * 16) * ldc + col0;
#pragma unroll
                for (int bj = 0; bj < 2; ++bj) *(GAS u32x4*)(rowp + bj * 128) = pack8(acc[ai][bj][m][0], acc[ai][bj][m][1]); }
    }
};
struct EpiProj {
    static constexpr bool PERM = true; GAS bf16_t* proj; GAS float* ab; const GAS float* ssq; GAS bf16_t* vta;
    __device__ __forceinline__ void operator()(AccRef acc, const pg8::Unit& u, int wr, int wc, int fr, int fq) const {
        { const int _l = lane_now(); fr = _l & 15; fq = _l >> 4; }
        if (u.pn == 2) {
            const int tok0 = u.pm * 256 + wc * 32 + 8 * fq;
#pragma unroll
            for (int bj = 0; bj < 2; ++bj) { float rs[8];
                { const f32x4 ra = *(const GAS f32x4*)(ssq + tok0 + bj * 128), rb = *(const GAS f32x4*)(ssq + tok0 + bj * 128 + 4); rs[0] = ra[0]; rs[1] = ra[1]; rs[2] = ra[2]; rs[3] = ra[3]; rs[4] = rb[0]; rs[5] = rb[1]; rs[6] = rb[2]; rs[7] = rb[3]; }
                const int tk = tok0 + bj * 128; GAS bf16_t* vb = vta + ((size_t)(tk >> 6) * 128 + ((tk & 63) >> 3)) * 128 + fr * 8;
#pragma unroll
                for (int ai = 0; ai < 2; ++ai)
#pragma unroll
                    for (int m = 0; m < 4; ++m) { const f32x4 a0 = acc[ai][bj][m][0], a1 = acc[ai][bj][m][1];
                        const f32x4 s0 = (f32x4){a0[0] * rs[0], a0[1] * rs[1], a0[2] * rs[2], a0[3] * rs[3]}, s1 = (f32x4){a1[0] * rs[4], a1[1] * rs[5], a1[2] * rs[6], a1[3] * rs[7]};
                        *(GAS u32x4*)(vb + (size_t)(((2 * ai + wr) * 4 + m) * 8) * 128) = pack8(s0, s1); } }
            return; }
        const int row0 = u.pm * 256 + wr * 64 + fr;
        float rsv[2][4];
        epi_row_scalars(rsv, ssq, row0, fr, fq);
#pragma unroll
        for (int ai = 0; ai < 2; ++ai)
#pragma unroll
            for (int m = 0; m < 4; ++m) { asm volatile("" ::: "memory"); const int row = row0 + ai * 128 + m * 16; const float rs = rsv[ai][m];
                const bool blk = (0xdb >> u.pn) & 1;
                GAS bf16_t* rowp = blk ? proj + ((size_t)u.pn * NTOK + (row & ~15)) * 256 + (wc * 4 + fq) * 128 + (row & 15) * 8
                                              : proj + ((size_t)u.pn * NTOK + row) * 256 + wc * 32 + 8 * fq;
                const int bjs = blk ? 16 * 128 : 128;
#pragma unroll
                for (int bj = 0; bj < 2; ++bj) *(GAS u32x4*)(rowp + bj * bjs) = pack8(acc[ai][bj][m][0] * rs, acc[ai][bj][m][1] * rs);
            }
    }
};
struct EpiResid {
    static constexpr bool PERM = true; GAS bf16_t* xb; GAS float* ssq;
    __device__ __forceinline__ void operator()(AccRef acc, const pg8::Unit& u, int wr, int wc, int fr, int fq) const {
        { const int _l = lane_now(); fr = _l & 15; fq = _l >> 4; }
        const int row0 = u.pm * 256 + wr * 64 + fr, col0 = u.pn * 256 + wc * 32 + 8 * fq;
#pragma unroll
        for (int ai = 0; ai < 2; ++ai) { asm volatile("" ::: "memory");
            u32x4 xo[4][2];
#pragma unroll
            for (int m = 0; m < 4; ++m)
#pragma unroll
                for (int bj = 0; bj < 2; ++bj) xo[m][bj] = *(const GAS u32x4*)(xb + (size_t)(row0 + ai * 128 + m * 16) * DM + col0 + bj * 128);
            float sv[4];
#pragma unroll
            for (int m = 0; m < 4; ++m) { const int row = row0 + ai * 128 + m * 16; float s = 0.f;
#pragma unroll
                for (int bj = 0; bj < 2; ++bj) { const size_t o = (size_t)row * DM + col0 + bj * 128; const u32x4 x = xo[m][bj];
                    const f32x4 v0 = acc[ai][bj][m][0] + (f32x4){bflo(x.x), bfhi(x.x), bflo(x.y), bfhi(x.y)}, v1 = acc[ai][bj][m][1] + (f32x4){bflo(x.z), bfhi(x.z), bflo(x.w), bfhi(x.w)};
                    const u32x4 w = pack8(v0, v1); *(GAS u32x4*)(xb + o) = w;
                    const float r0 = bflo(w.x), r1 = bfhi(w.x), r2 = bflo(w.y), r3 = bfhi(w.y), r4 = bflo(w.z), r5 = bfhi(w.z), r6 = bflo(w.w), r7 = bfhi(w.w);
                    s += (r0 * r0 + r1 * r1) + (r2 * r2 + r3 * r3) + (r4 * r4 + r5 * r5) + (r6 * r6 + r7 * r7); }
                s += shfl_xor_f(s, 16); s += shfl_xor_f(s, 32); sv[m] = s; }
            { const float ssel = (fq == 0) ? sv[0] : (fq == 1) ? sv[1] : (fq == 2) ? sv[2] : sv[3]; ssq[(size_t)(row0 + ai * 128 + fq * 16) * 16 + u.pn * 4 + wc] = ssel; } }
    }
};
struct EpiSoftmax {
    static constexpr bool PERM = true; GAS bf16_t* P; const GAS float* ssq; LAS float* ex;
    __device__ __forceinline__ void operator()(AccRef acc, const pg8::Unit& u, int wr, int wc, int fr, int fq) const {
        { const int _l = lane_now(); fr = _l & 15; fq = _l >> 4; }
        const int rl0 = wr * 64 + fr, col0 = u.pn * 256 + wc * 32 + 8 * fq;
        LAS float* exm = ex; LAS float* exs = ex + 1024; LAS float* exr = ex + 2048 + 256;
#pragma unroll
        for (int ai = 0; ai < 2; ++ai)
#pragma unroll
            for (int m = 0; m < 4; ++m) { const int rl = rl0 + ai * 128 + m * 16;
                float mx = -3.0e38f;
#pragma unroll
                for (int bj = 0; bj < 2; ++bj)
#pragma unroll
                    for (int n = 0; n < 2; ++n) { const f32x4 v = acc[ai][bj][m][n]; mx = fmaxf(mx, fmaxf(fmaxf(v[0], v[1]), fmaxf(v[2], v[3]))); }
                mx = fmaxf(mx, shfl_xor_f(mx, 16)); mx = fmaxf(mx, shfl_xor_f(mx, 32));
                if (fq == 0) exm[rl * 4 + wc] = mx; }
        if (wr == 0) { const int rl = wc * 64 + fq * 16 + fr; exr[rl] = row_rstd(ssq, u.pm * 256 + rl); }
        asm volatile("s_waitcnt lgkmcnt(0)" ::: "memory"); __builtin_amdgcn_s_barrier(); asm volatile("" ::: "memory");
#pragma unroll
        for (int ai = 0; ai < 2; ++ai)
#pragma unroll
            for (int m = 0; m < 4; ++m) { asm volatile("" ::: "memory"); const int rl = rl0 + ai * 128 + m * 16; const f32x4 q = *(const LAS f32x4*)(exm + rl * 4); const float rs = exr[rl];
                const float mx = fmaxf(fmaxf(q[0], q[1]), fmaxf(q[2], q[3])) * rs; float s = 0.f;
#pragma unroll
                for (int bj = 0; bj < 2; ++bj)
#pragma unroll
                    for (int n = 0; n < 2; ++n) { const f32x4 v = acc[ai][bj][m][n] * rs - mx; s += (__expf(v[0]) + __expf(v[1])) + (__expf(v[2]) + __expf(v[3])); }
                s += shfl_xor_f(s, 16); s += shfl_xor_f(s, 32);
                if (fq == 0) exs[rl * 4 + wc] = s; }
        asm volatile("s_waitcnt lgkmcnt(0)" ::: "memory"); __builtin_amdgcn_s_barrier(); asm volatile("" ::: "memory");
#pragma unroll
        for (int ai = 0; ai < 2; ++ai)
#pragma unroll
            for (int m = 0; m < 4; ++m) { asm volatile("" ::: "memory"); const int rl = rl0 + ai * 128 + m * 16; const f32x4 q = *(const LAS f32x4*)(exs + rl * 4), qm = *(const LAS f32x4*)(exm + rl * 4);
                const float rs = exr[rl];
                const float inv = 1.0f / ((q[0] + q[1]) + (q[2] + q[3])); const float mx = fmaxf(fmaxf(qm[0], qm[1]), fmaxf(qm[2], qm[3])) * rs;
                GAS bf16_t* rowp = P + (size_t)(u.pm * 256 + (rl & ~15)) * DM + (col0 >> 3) * 128 + (rl & 15) * 8;
#pragma unroll
                for (int bj = 0; bj < 2; ++bj) { f32x4 v0 = acc[ai][bj][m][0] * rs - mx, v1 = acc[ai][bj][m][1] * rs - mx;
#pragma unroll
                    for (int j = 0; j < 4; ++j) { v0[j] = __expf(v0[j]) * inv; v1[j] = __expf(v1[j]) * inv; }
                    *(GAS u32x4*)(rowp + bj * 2048) = pack8(v0, v1); } }
        asm volatile("s_waitcnt lgkmcnt(0)" ::: "memory");
    }
};
struct EpiGateUp {
    static constexpr bool PERM = true; GAS bf16_t* hmid; const GAS float* slot_rstd;
    __device__ __forceinline__ void operator()(AccRef acc, const pg8::Unit& u, int wr, int wc, int fr, int fq) const {
        { const int _l = lane_now(); fr = _l & 15; fq = _l >> 4; }
        const int row0 = u.pm * 256 + wr * 64 + fr, col0 = u.pn * 128 + wc * 16 + 4 * fq;
        float rsv[2][4];
        epi_row_scalars(rsv, slot_rstd, row0, fr, fq);
#pragma unroll
        for (int ai = 0; ai < 2; ++ai)
#pragma unroll
            for (int m = 0; m < 4; ++m) { const int row = row0 + ai * 128 + m * 16; const float rs = rsv[ai][m];
                u32x2 w[2];
#pragma unroll
                for (int bj = 0; bj < 2; ++bj) { const f32x4 v0 = acc[ai][bj][m][0] * rs, v1 = acc[ai][bj][m][1] * rs;
                    w[bj].x = pg8::cvt_pk_bf16(silu_f(v0[0]) * v0[1], silu_f(v0[2]) * v0[3]); w[bj].y = pg8::cvt_pk_bf16(silu_f(v1[0]) * v1[1], silu_f(v1[2]) * v1[3]); }
                const auto r0 = __builtin_amdgcn_permlane16_swap(w[0].x, w[1].x, false, false), r1 = __builtin_amdgcn_permlane16_swap(w[0].y, w[1].y, false, false);
                u32x4 v; v.x = r0[0]; v.y = r1[0]; v.z = r0[1]; v.w = r1[1];
                GAS bf16_t* hp = hmid + (size_t)(row & ~15) * DEXP + ((col0 >> 3) + (fq & 1) * 8) * 128 + (row & 15) * 8;
                asm volatile("global_store_dwordx4 %0, %1, off sc1\n\ts_nop 1" :: "v"(hp), "v"(v) : "memory"); }
    }
};
struct EpiDown {
    static constexpr bool PERM = true; GAS bf16_t* Y; const GAS float* slot_w;
    __device__ __forceinline__ void operator()(AccRef acc, const pg8::Unit& u, int wr, int wc, int fr, int fq) const {
        { const int _l = lane_now(); fr = _l & 15; fq = _l >> 4; }
        const int row0 = u.pm * 256 + wr * 64 + fr, col0 = u.pn * 256 + wc * 32 + 8 * fq;
        float gwv[2][4];
        epi_row_scalars(gwv, slot_w, row0, fr, fq);
#pragma unroll
        for (int ai = 0; ai < 2; ++ai)
#pragma unroll
            for (int m = 0; m < 4; ++m) { const int row = row0 + ai * 128 + m * 16; const float gw = gwv[ai][m]; GAS bf16_t* rowp = Y + (size_t)row * DM + col0;
#pragma unroll
                for (int bj = 0; bj < 2; ++bj) *(GAS u32x4*)(rowp + bj * 128) = pack8(acc[ai][bj][m][0] * gw, acc[ai][bj][m][1] * gw); }
    }
};

#define CAS __attribute__((address_space(4)))
#if defined(__HIP_DEVICE_COMPILE__)
#define ASSUME_GLOBAL(p) do { __builtin_assume(!__builtin_amdgcn_is_shared((const __attribute__((address_space(0))) GAS void*)(p))); __builtin_assume(!__builtin_amdgcn_is_private((const __attribute__((address_space(0))) GAS void*)(p))); } while (0)
#else
#define ASSUME_GLOBAL(p) do { } while (0)
#endif
struct Frame {
    LAS unsigned char* lds; int tid, lane, wave, G, gw, ngw;
    const CAS unsigned char* ka; GAS float* out; GAS unsigned char* ws;
    __device__ __forceinline__ const GAS float* inp(int i) const { const CAS unsigned char* p = ka; asm volatile("" : "+s"(p)); const GAS float* r = (const GAS float*)(((const float* const CAS*)p)[i]); return r; }
};
enum { I_X = 0, I_MEM, I_MIXG, I_WIN, I_RPB, I_RETG, I_POOLW, I_POOLS, I_CONVW, I_ALOG, I_DTB, I_GDNG, I_WOUT, I_MQG, I_MKVG, I_WQ, I_WK, I_WV, I_WO, I_FFNG, I_WGRP, I_BGRP, I_WRT, I_BRT, I_WGATE, I_WUP, I_WDOWN, I_FING };

__device__ __forceinline__ void tr_item(const GAS float* W, int ldw, int nvalid, const GAS float* gain, float scale, GAS bf16_t* WT, int ldt, int row_off, int row_mul,
                                        LAS float* scr, int kb, int nb, int lane) {
    const int k0 = 64 * kb, n0 = 32 * nb, n4 = (lane & 7) * 4, kr = lane >> 3;
    f32x4 v[8];
    const bool full = (n0 + n4 + 3 < nvalid);
#pragma unroll
    for (int i = 0; i < 8; ++i) { const int kk = 8 * i + kr; const GAS float* p = W + (size_t)(k0 + kk) * ldw + n0 + n4;
        if (full) v[i] = *(const GAS f32x4*)p;
        else { v[i] = (f32x4){0.f, 0.f, 0.f, 0.f};
#pragma unroll
            for (int j = 0; j < 4; ++j) if (n0 + n4 + j < nvalid) v[i][j] = p[j]; } }
#pragma unroll
    for (int i = 0; i < 8; ++i) { const int kk = 8 * i + kr; const float sc = gain ? gain[k0 + kk] * scale : scale;
#pragma unroll
        for (int j = 0; j < 4; ++j) scr[kk * 33 + n4 + j] = v[i][j] * sc; }
    LDS_WAIT(); asm volatile("" ::: "memory");
    const int c = lane & 7;
#pragma unroll
    for (int j = 0; j < 4; ++j) { const int n = (lane >> 3) + 8 * j; const LAS float* s = scr + (8 * c) * 33 + n;
        u32x4 o; o.x = pk2(s[0 * 33], s[1 * 33]); o.y = pk2(s[2 * 33], s[3 * 33]); o.z = pk2(s[4 * 33], s[5 * 33]); o.w = pk2(s[6 * 33], s[7 * 33]);
        *(GAS u32x4*)(WT + (size_t)(row_off + (n0 + n) * row_mul) * ldt + k0 + 8 * c) = o; }
    LDS_WAIT(); asm volatile("" ::: "memory");
}

__device__ __forceinline__ float row_to_bf16(const GAS float* xrow, GAS bf16_t* orow, const GAS float* gain, bool norm, int lane) {
    const GAS f32x4* xr = (const GAS f32x4*)xrow + lane;
    f32x4 v[4]; float s = 0.f;
#pragma unroll
    for (int j = 0; j < 4; ++j) { v[j] = xr[64 * j]; s += (v[j].x * v[j].x + v[j].y * v[j].y) + (v[j].z * v[j].z + v[j].w * v[j].w); }
    s = wave_sum(s);
    if (norm) { const float rs = rsqrtf(s * (1.0f / DM) + EPS);
#pragma unroll
        for (int j = 0; j < 4; ++j) { const f32x4 g = ((const GAS f32x4*)gain)[lane + 64 * j]; v[j] = v[j] * rs * g; } }
    GAS u32x2* o8 = (GAS u32x2*)orow + lane;
#pragma unroll
    for (int j = 0; j < 4; ++j) { u32x2 w; w.x = pk2(v[j].x, v[j].y); w.y = pk2(v[j].z, v[j].w); o8[64 * j] = w; }
    return s;
}

__device__ __forceinline__ void p0_prologue(Frame& F) {
    GAS unsigned char* ws = F.ws;
    LAS float* scr = (LAS float*)(F.lds + F.wave * 16384);
    constexpr int I_IN = 16 * 96, I_SQ = 16 * 32;
    constexpr int PER_L = I_IN + 4 * I_SQ;
    for (int it = F.gw; it < 2 * PER_L; it += F.ngw) {
        const int l = it / PER_L; int r = it % PER_L;
        if (r < I_IN) { tr_item(F.inp(I_WIN) + (size_t)l * DM * 3088, 3088, 3088, F.inp(I_MIXG) + l * DM, 1.f, (GAS bf16_t*)(ws + WS_WIN) + (size_t)l * PINP * DM, DM, 0, 1, scr, r / 96, r % 96, F.lane); continue; }
        r -= I_IN;
        if (r < I_SQ) { tr_item(F.inp(I_WOUT) + (size_t)l * DM * DM, DM, DM, nullptr, 1.f, (GAS bf16_t*)(ws + WS_WOUT) + (size_t)l * DM * DM, DM, 0, 1, scr, r / 32, r % 32, F.lane); continue; }
        r -= I_SQ;
        if (r < I_SQ) { tr_item(F.inp(I_WK) + (size_t)l * DM * DM, DM, DM, nullptr, 1.f, (GAS bf16_t*)(ws + WS_WKV) + (size_t)l * 2048 * DM, DM, 0, 1, scr, r / 32, r % 32, F.lane); continue; }
        r -= I_SQ;
        if (r < I_SQ) { tr_item(F.inp(I_WV) + (size_t)l * DM * DM, DM, DM, nullptr, 1.f, (GAS bf16_t*)(ws + WS_WKV) + (size_t)l * 2048 * DM, DM, 1024, 1, scr, r / 32, r % 32, F.lane); continue; }
        r -= I_SQ;
        tr_item(F.inp(I_WO) + (size_t)l * DM * DM, DM, DM, nullptr, 1.f, (GAS bf16_t*)(ws + WS_WOT) + (size_t)l * DM * DM, DM, 0, 1, scr, r / 32, r % 32, F.lane);
    }
    {   const GAS float* X = F.inp(I_X); GAS bf16_t* xbp = (GAS bf16_t*)(ws + WS_XB); GAS float* ssqp = (GAS float*)(ws + WS_SSQ);
        for (int m0 = F.gw * 4; m0 < NTOK; m0 += F.ngw * 4) {
            f32x4 v[4][4];
#pragma unroll
            for (int k = 0; k < 4; ++k)
#pragma unroll
                for (int j = 0; j < 2; ++j) { const GAS f32x4* xp = (const GAS f32x4*)(X + (size_t)(m0 + k) * DM) + F.lane * 2 + 128 * j; v[k][2 * j] = xp[0]; v[k][2 * j + 1] = xp[1]; }
#pragma unroll
            for (int k = 0; k < 4; ++k) { float sq = 0.f; GAS u32x4* o16 = (GAS u32x4*)(xbp + (size_t)(m0 + k) * DM) + F.lane;
#pragma unroll
                for (int j = 0; j < 2; ++j) { const f32x4 a = v[k][2 * j], b = v[k][2 * j + 1];
                    sq += ((a.x * a.x + a.y * a.y) + (a.z * a.z + a.w * a.w)) + ((b.x * b.x + b.y * b.y) + (b.z * b.z + b.w * b.w));
                    u32x4 w; w.x = pk2(a.x, a.y); w.y = pk2(a.z, a.w); w.z = pk2(b.x, b.y); w.w = pk2(b.z, b.w); o16[64 * j] = w; }
                sq = wave_sum(sq);
                if (F.lane < 16) ssqp[(size_t)(m0 + k) * 16 + F.lane] = (F.lane == 0) ? sq : 0.f;
                if (F.lane == 0) ((GAS float*)(ws + WS_TAB + TAB_RSTD))[m0 + k] = rsqrtf(sq * (1.0f / DM) + EPS); } }
        for (int r = F.gw; r < 2048; r += F.ngw) { const int l = r >> 10;
            row_to_bf16(F.inp(I_MEM) + (size_t)(r & 1023) * DM, (GAS bf16_t*)(ws + WS_MEMN) + (size_t)r * DM, F.inp(I_MKVG) + l * DM, true, F.lane); }
    }
    const size_t gt = (size_t)blockIdx.x * NTHREADS + F.tid, ngt = (size_t)F.G * NTHREADS;
    {
        GAS bf16_t* o = (GAS bf16_t*)(ws + WS_WQB);
        for (size_t i = gt; i < (size_t)2 * DM * DM / 4; i += ngt) { const size_t e = i * 4; const int l = (int)(e >> 20), k = (int)((e >> 10) & 1023);
            const f32x4 w = *(const GAS f32x4*)(F.inp(I_WQ) + e); const float g = F.inp(I_MQG)[l * DM + k] * 0.0625f;
            u32x2 p; p.x = pk2(w.x * g, w.y * g); p.y = pk2(w.z * g, w.w * g); *(GAS u32x2*)(o + e) = p; }
    }
    {
        GAS float* tab = (GAS float*)(ws + WS_TAB + TAB_ROPE);
        for (size_t i = gt; i < (size_t)SEQ * 32; i += ngt) { const int pos = (int)(i >> 5), j = (int)(i & 31);
            const float inv = exp2f(-(float)j * (13.287712379549449f / 32.0f)); const float ang = (float)pos * inv;
            const double rev = (double)ang * 0.15915494309189535; const float fr = (float)(rev - floor(rev));
            tab[i * 2] = __builtin_amdgcn_cosf(fr); tab[i * 2 + 1] = __builtin_amdgcn_sinf(fr); }
    }
    {
        GAS bf16_t* fr = (GAS bf16_t*)(ws + WS_TAB + TAB_RFR);
        for (size_t i = gt; i < (size_t)2 * 49152; i += ngt) { const int l = (int)(i / 49152), r = (int)(i % 49152), j = r & 7, ln = (r >> 3) & 63, ct = (r >> 9) % 3, ks = r / 1536;
            const int k = 32 * ks + 8 * (ln >> 4) + j, o = 16 * ct + (ln & 15);
            float w = 0.f; if (o < 32) w = F.inp(I_WRT)[(size_t)l * DM * 32 + (size_t)k * 32 + o]; else if (o < 36) w = F.inp(I_WGRP)[(size_t)l * DM * 4 + (size_t)k * 4 + (o - 32)];
            w *= F.inp(I_FFNG)[l * DM + k];
            const unsigned hi = f2bf(w); const float lo = w - __builtin_bit_cast(float, hi << 16);
            fr[(size_t)l * 98304 + r] = (bf16_t)hi; fr[(size_t)l * 98304 + 49152 + r] = (bf16_t)f2bf(lo); }
    }
    {
        GAS bf16_t* fr = (GAS bf16_t*)(ws + WS_TAB + TAB_ABF);
        for (size_t i = gt; i < (size_t)2 * 16384; i += ngt) { const int l = (int)(i >> 14), r = (int)(i & 16383), j = r & 7, ln = (r >> 3) & 63, ks = r >> 9;
            const int k = 32 * ks + 8 * (ln >> 4) + j, o = ln & 15;
            fr[i] = (bf16_t)f2bf(F.inp(I_WIN)[(size_t)l * DM * 3088 + (size_t)k * 3088 + 3072 + o] * F.inp(I_MIXG)[l * DM + k]); }
    }
    {
        GAS bf16_t* pt = (GAS bf16_t*)(ws + WS_TAB + TAB_POOL);
        for (size_t i = gt; i < (size_t)2 * 4 * 64 * 64; i += ngt) { const int c = (int)(i & 63), e = (int)((i >> 6) & 63), gi = (int)((i >> 12) & 3), l = (int)(i >> 14);
            pt[(i & ~(size_t)4095) + ((e >> 4) * 8 + (c >> 3)) * 128 + (e & 15) * 8 + (c & 7)] = (bf16_t)f2bf(F.inp(I_POOLW)[(((size_t)l * 4 + gi) * 64 + c) * 64 + e] * F.inp(I_POOLS)[l * 256 + gi * 64 + e]); }
    }
}

__device__ __forceinline__ void convert_experts_queue(Frame& F, int l) {
    GAS unsigned char* ws = F.ws;
    LAS float* scr = (LAS float*)(F.lds + F.wave * 16384);
    constexpr int IG = 16 * 16, ID = 8 * 32, PER_E = 2 * IG + ID;
    GAS unsigned* q = (GAS unsigned*)(ws + WS_CTL) + CW_CQ + l * 64;
    const GAS float* wg = F.inp(I_WGATE); const GAS float* wu = F.inp(I_WUP); const GAS float* wd = F.inp(I_WDOWN); const GAS float* gn = F.inp(I_FFNG) + l * DM;
    LAS unsigned* qs = (LAS unsigned*)(F.lds + LDS_MISC + 2048);
    for (;;) {
        __syncthreads();
        if (F.tid == 0) *qs = __hip_atomic_fetch_add(q, 64u, __ATOMIC_RELAXED, __HIP_MEMORY_SCOPE_AGENT);
        __syncthreads();
        const unsigned qb = *qs;
        if (qb >= (unsigned)(NEXP * PER_E)) break;
    for (int it = (int)qb + F.wave; it < (int)qb + 64 && it < NEXP * PER_E; it += NWAVES) {
        const int e = (int)it / PER_E; int r = (int)it % PER_E; const size_t le = (size_t)l * NEXP + e;
        if (r < IG) { tr_item(wg + le * DM * DEXP, DEXP, DEXP, gn, 1.f, (GAS bf16_t*)(ws + WS_WGU) + (size_t)e * 1024 * DM, DM, 0, 2, scr, r / 16, r % 16, F.lane); continue; }
        r -= IG;
        if (r < IG) { tr_item(wu + le * DM * DEXP, DEXP, DEXP, gn, 1.f, (GAS bf16_t*)(ws + WS_WGU) + (size_t)e * 1024 * DM, DM, 1, 2, scr, r / 16, r % 16, F.lane); continue; }
        r -= IG;
        tr_item(wd + le * DEXP * DM, DM, DM, nullptr, 1.f, (GAS bf16_t*)(ws + WS_WD) + (size_t)e * DM * DEXP, DEXP, 0, 1, scr, r / 32, r % 32, F.lane);
    }
    }
}

__device__ __forceinline__ size_t PJ(size_t t, int c) { return ((size_t)(c >> 8) * NTOK + t) * 256 + (c & 255); }
#define MFMA16(a, b, c) __builtin_amdgcn_mfma_f32_16x16x32_bf16((a), (b), (c), 0, 0, 0)

__device__ __forceinline__ void pool_item(Frame& F, const GAS bf16_t* proj, const GAS bf16_t* pt, GAS bf16_t* ycat, int item) {
    const int lane = lane_now();
    const int g = lane >> 4, t = item * 16 + (lane & 15), s = t & (SEQ - 1);
    const GAS bf16_t* base = proj + ((size_t)7 * NTOK + (t - s)) * 256;
#pragma unroll
    for (int gi = 0; gi < 4; ++gi) {
        const int half = 1 << gi; const int lo = max(s - half, 0), hi = min(s + half, SEQ); const float inv = 1.0f / (float)(hi - lo);
        f32x4 acc[4];
#pragma unroll
        for (int et = 0; et < 4; ++et) acc[et] = (f32x4){0.f, 0.f, 0.f, 0.f};
        bf16x8 wf[8];
#pragma unroll
        for (int ks = 0; ks < 2; ++ks)
#pragma unroll
            for (int et = 0; et < 4; ++et) wf[ks * 4 + et] = *(const GAS bf16x8*)(pt + (size_t)gi * 4096 + (et * 8 + ks * 4 + g) * 128 + (lane & 15) * 8);
#pragma unroll
        for (int ks = 0; ks < 2; ++ks) {
            const int cb = (gi * 8 + ks * 4 + g) * 128;
            float sum[8];
#pragma unroll
            for (int j = 0; j < 8; ++j) sum[j] = 0.f;
#pragma unroll
            for (int w2 = 0; w2 < 2 * half; ++w2) { const int s2 = s - half + w2; const bool ok = (s2 >= 0) && (s2 < SEQ);
                u32x4 v = (u32x4){0u, 0u, 0u, 0u}; if (ok) v = *(const GAS u32x4*)((const GAS char*)base + (unsigned)((s2 & ~15) * 512 + cb * 2 + (s2 & 15) * 16));
                sum[0] += bflo(v.x); sum[1] += bfhi(v.x); sum[2] += bflo(v.y); sum[3] += bfhi(v.y); sum[4] += bflo(v.z); sum[5] += bfhi(v.z); sum[6] += bflo(v.w); sum[7] += bfhi(v.w); }
            const u32x4 c = *(const GAS u32x4*)((const GAS char*)base + (unsigned)((s & ~15) * 512 + cb * 2 + (s & 15) * 16));
            u32x4 dd; dd.x = pk2(sum[0] * inv - bflo(c.x), sum[1] * inv - bfhi(c.x)); dd.y = pk2(sum[2] * inv - bflo(c.y), sum[3] * inv - bfhi(c.y));
            dd.z = pk2(sum[4] * inv - bflo(c.z), sum[5] * inv - bfhi(c.z)); dd.w = pk2(sum[6] * inv - bflo(c.w), sum[7] * inv - bfhi(c.w));
            const bf16x8 bfrag = __builtin_bit_cast(bf16x8, dd);
            if (ks == 0) asm volatile("" : "+v"(wf[0]), "+v"(wf[1]), "+v"(wf[2]), "+v"(wf[3]), "+v"(wf[4]), "+v"(wf[5]), "+v"(wf[6]), "+v"(wf[7]));
#pragma unroll
            for (int et = 0; et < 4; ++et) acc[et] = MFMA16(wf[ks * 4 + et], bfrag, acc[et]);
        }
#pragma unroll
        for (int et = 0; et < 4; ++et) { u32x2 w; w.x = pk2(acc[et][0], acc[et][1]); w.y = pk2(acc[et][2], acc[et][3]);
            *(GAS u32x2*)(ycat + (size_t)t * DM + 512 + gi * 64 + et * 16 + g * 4) = w; }
    }
}

__device__ __forceinline__ void na_item(Frame& F, const GAS bf16_t* proj, const GAS bf16_t* vta, const LAS float* rpbs, GAS bf16_t* ycat, int item) {
    const int lane = F.lane, g = lane >> 4, ql = lane & 15;
    const int n = item & 3, r = (item >> 2) & 127, h = (item >> 9) & 3, b = item >> 11; const size_t tb = (size_t)b * SEQ;
    const int kr0 = min(max(r - 4, 0), 120), band = min(max(n * 16 - 8, 0), 32), qc = n * 16 + ql, win = min(max(qc - 8, 0), 48);
    const GAS bf16_t* qrow = proj + (tb + r * 64 + n * 16) * 256 + (h * 8 + g) * 128 + ql * 8;
    const bf16x8 q0 = *(const GAS bf16x8*)qrow, q1 = *(const GAS bf16x8*)(qrow + 4 * 128);
    f32x4 S[16];
    const int kcl = band + 8 * (ql >> 2) + (ql & 3);
#pragma unroll
    for (int tb8 = 0; tb8 < 2; ++tb8) { bf16x8 kf[16];
#pragma unroll
        for (int tt = 0; tt < 8; ++tt) { const int t = tb8 * 8 + tt, i = t >> 1, hf = t & 1; const int kc = kcl + 4 * hf;
            const GAS bf16_t* krow = proj + ((size_t)NTOK + tb + (size_t)(kr0 + i) * 64 + (kc & ~15)) * 256 + (h * 8 + g) * 128 + (kc & 15) * 8;
            kf[2 * tt] = *(const GAS bf16x8*)krow; kf[2 * tt + 1] = *(const GAS bf16x8*)(krow + 4 * 128); }
        asm volatile("" : "+v"(kf[0]), "+v"(kf[1]), "+v"(kf[2]), "+v"(kf[3]), "+v"(kf[4]), "+v"(kf[5]), "+v"(kf[6]), "+v"(kf[7]), "+v"(kf[8]), "+v"(kf[9]), "+v"(kf[10]), "+v"(kf[11]), "+v"(kf[12]), "+v"(kf[13]), "+v"(kf[14]), "+v"(kf[15]));
#pragma unroll
        for (int tt = 0; tt < 8; ++tt) { f32x4 a = (f32x4){0.f, 0.f, 0.f, 0.f}; a = MFMA16(kf[2 * tt], q0, a); a = MFMA16(kf[2 * tt + 1], q1, a); S[tb8 * 8 + tt] = a; } }
    float mx = -3.0e38f;
#pragma unroll
    for (int t = 0; t < 16; ++t) { const int i = t >> 1, hf = t & 1; const LAS float* rp = rpbs + h * 465 + (kr0 + i - r + 7) * 31;
#pragma unroll
        for (int jj = 0; jj < 4; ++jj) { const int kc = band + g * 8 + hf * 4 + jj; const bool ok = (kc >= win) && (kc < win + 16);
            const float sc = ok ? S[t][jj] * 0.125f + rp[ok ? kc - qc + 15 : 0] : -3.0e38f; S[t][jj] = sc; mx = fmaxf(mx, sc); } }
    mx = fmaxf(mx, shfl_xor_f(mx, 16)); mx = fmaxf(mx, shfl_xor_f(mx, 32));
    float sum = 0.f;
#pragma unroll
    for (int t = 0; t < 16; ++t)
#pragma unroll
        for (int jj = 0; jj < 4; ++jj) { const float p = __expf(S[t][jj] - mx); S[t][jj] = p; sum += p; }
    sum += shfl_xor_f(sum, 16); sum += shfl_xor_f(sum, 32);
    const float inv = 1.0f / sum;
    f32x4 O[4];
#pragma unroll
    for (int dt = 0; dt < 4; ++dt) O[dt] = (f32x4){0.f, 0.f, 0.f, 0.f};
#pragma unroll
    for (int vb4 = 0; vb4 < 2; ++vb4) { bf16x8 vl[16];
#pragma unroll
        for (int ii = 0; ii < 4; ++ii) { const int i = vb4 * 4 + ii;
            const GAS bf16_t* vb = vta + ((((size_t)(b * 128 + kr0 + i) * 4 + h) * 4) * 8 + (band >> 3) + g) * 128 + ql * 8;
#pragma unroll
            for (int dt = 0; dt < 4; ++dt) vl[ii * 4 + dt] = *(const GAS bf16x8*)(vb + (size_t)dt * 8 * 128); }
        asm volatile("" : "+v"(vl[0]), "+v"(vl[1]), "+v"(vl[2]), "+v"(vl[3]), "+v"(vl[4]), "+v"(vl[5]), "+v"(vl[6]), "+v"(vl[7]), "+v"(vl[8]), "+v"(vl[9]), "+v"(vl[10]), "+v"(vl[11]), "+v"(vl[12]), "+v"(vl[13]), "+v"(vl[14]), "+v"(vl[15]));
#pragma unroll
        for (int ii = 0; ii < 4; ++ii) { const int i = vb4 * 4 + ii;
            u32x4 pw; pw.x = pk2(S[2 * i][0], S[2 * i][1]); pw.y = pk2(S[2 * i][2], S[2 * i][3]); pw.z = pk2(S[2 * i + 1][0], S[2 * i + 1][1]); pw.w = pk2(S[2 * i + 1][2], S[2 * i + 1][3]);
            const bf16x8 pf = __builtin_bit_cast(bf16x8, pw);
#pragma unroll
            for (int dt = 0; dt < 4; ++dt) O[dt] = MFMA16(pf, vl[ii * 4 + dt], O[dt]); } }
#pragma unroll
    for (int jj = 0; jj < 4; ++jj) { const float iq = shfl_f(inv, g * 4 + jj); GAS bf16_t* orow = ycat + (tb + r * 64 + n * 16 + g * 4 + jj) * DM + h * 64 + ql;
#pragma unroll
        for (int dt = 0; dt < 4; ++dt) orow[dt * 16] = (bf16_t)f2bf(O[dt][jj] * iq); }
}

constexpr int NA_TILE = 8192;
#define NA_BAR() do { asm volatile("s_waitcnt lgkmcnt(0)" ::: "memory"); __builtin_amdgcn_s_barrier(); asm volatile("" ::: "memory"); } while (0)
__device__ __forceinline__ void na_rounds(Frame& F, const GAS bf16_t* proj, const GAS bf16_t* vta, const LAS float* rpbs, GAS bf16_t* ycat, int cs) {
    int tid = F.tid; asm volatile("" : "+v"(tid));
    int wave = F.wave; asm volatile("" : "+s"(wave));
    const int lane = tid & 63, g = lane >> 4, ql = lane & 15;
    const int n = wave & 3, r0 = (cs * 2) & 127, r = r0 + (wave >> 2), h = (cs >> 6) & 3;
    const int kb = min(max(r0 - 4, 0), 120), kr0 = min(max(r - 4, 0), 120), lr0 = kr0 - kb;
    const int band = min(max(n * 16 - 8, 0), 32), qc = n * 16 + ql, win = min(max(qc - 8, 0), 48);
    const int kcl = band + 8 * (ql >> 2) + (ql & 3);
    LAS unsigned char* tile = F.lds + NA_TILE;
    u32x4 pre[9];
#pragma unroll
    for (int p = 0; p < 9; ++p) { const int row = min(kb + p, 127); pre[p] = *(const GAS u32x4*)(proj + ((size_t)NTOK + (size_t)row * 64 + (tid >> 7) * 16) * 256 + h * 8 * 128 + (tid & 127) * 8); }
    for (int b = 0; b < 4; ++b) { const size_t tb = (size_t)b * SEQ;
#pragma unroll
        for (int p = 0; p < 9; ++p) *(LAS u32x4*)(tile + p * 8192 + tid * 16) = pre[p];
        NA_BAR();
#pragma unroll
        for (int p = 0; p < 9; ++p) { const int row = min(kb + p, 127); pre[p] = *(const GAS u32x4*)(vta + ((size_t)(b * 128 + row) * 4 + h) * 4096 + tid * 8); }
        const GAS bf16_t* qrow = proj + (tb + r * 64 + n * 16) * 256 + (h * 8 + g) * 128 + ql * 8;
        const bf16x8 q0 = *(const GAS bf16x8*)qrow, q1 = *(const GAS bf16x8*)(qrow + 4 * 128);
        f32x4 S[16];
#pragma unroll
        for (int tb8 = 0; tb8 < 2; ++tb8) { bf16x8 kf[16];
#pragma unroll
            for (int tt = 0; tt < 8; ++tt) { const int t = tb8 * 8 + tt, i = t >> 1, hf = t & 1; const int kc = kcl + 4 * hf;
                const LAS unsigned char* kp = tile + (lr0 + i) * 8192 + (kc >> 4) * 2048 + g * 256 + (kc & 15) * 16;
                kf[2 * tt] = *(const LAS bf16x8*)kp; kf[2 * tt + 1] = *(const LAS bf16x8*)(kp + 4 * 256); }
            asm volatile("s_waitcnt lgkmcnt(0)" : "+v"(kf[0]), "+v"(kf[1]), "+v"(kf[2]), "+v"(kf[3]), "+v"(kf[4]), "+v"(kf[5]), "+v"(kf[6]), "+v"(kf[7]), "+v"(kf[8]), "+v"(kf[9]), "+v"(kf[10]), "+v"(kf[11]), "+v"(kf[12]), "+v"(kf[13]), "+v"(kf[14]), "+v"(kf[15]));
#pragma unroll
            for (int tt = 0; tt < 8; ++tt) { f32x4 a = (f32x4){0.f, 0.f, 0.f, 0.f}; a = MFMA16(kf[2 * tt], q0, a); a = MFMA16(kf[2 * tt + 1], q1, a); S[tb8 * 8 + tt] = a; } }
        float mx = -3.0e38f;
#pragma unroll
        for (int t = 0; t < 16; ++t) { const int i = t >> 1, hf = t & 1; const LAS float* rp = rpbs + h * 465 + (kr0 + i - r + 7) * 31;
#pragma unroll
            for (int jj = 0; jj < 4; ++jj) { const int kc = band + g * 8 + hf * 4 + jj; const bool ok = (kc >= win) && (kc < win + 16);
                const float sc = ok ? S[t][jj] * 0.125f + rp[ok ? kc - qc + 15 : 0] : -3.0e38f; S[t][jj] = sc; mx = fmaxf(mx, sc); } }
        mx = fmaxf(mx, shfl_xor_f(mx, 16)); mx = fmaxf(mx, shfl_xor_f(mx, 32));
        float sum = 0.f;
#pragma unroll
        for (int t = 0; t < 16; ++t)
#pragma unroll
            for (int jj = 0; jj < 4; ++jj) { const float p = __expf(S[t][jj] - mx); S[t][jj] = p; sum += p; }
        sum += shfl_xor_f(sum, 16); sum += shfl_xor_f(sum, 32);
        const float inv = 1.0f / sum;
        NA_BAR();
#pragma unroll
        for (int p = 0; p < 9; ++p) *(LAS u32x4*)(tile + p * 8192 + tid * 16) = pre[p];
        NA_BAR();
        if (b < 3) {
#pragma unroll
            for (int p = 0; p < 9; ++p) { const int row = min(kb + p, 127); pre[p] = *(const GAS u32x4*)(proj + ((size_t)NTOK + tb + SEQ + (size_t)row * 64 + (tid >> 7) * 16) * 256 + h * 8 * 128 + (tid & 127) * 8); } }
        f32x4 O[4];
#pragma unroll
        for (int dt = 0; dt < 4; ++dt) O[dt] = (f32x4){0.f, 0.f, 0.f, 0.f};
#pragma unroll
        for (int vb4 = 0; vb4 < 2; ++vb4) { bf16x8 vl[16];
#pragma unroll
            for (int ii = 0; ii < 4; ++ii) { const int i = vb4 * 4 + ii; const LAS unsigned char* vp = tile + (lr0 + i) * 8192 + ((band >> 3) + g) * 256 + ql * 16;
#pragma unroll
                for (int dt = 0; dt < 4; ++dt) vl[ii * 4 + dt] = *(const LAS bf16x8*)(vp + dt * 2048); }
            asm volatile("s_waitcnt lgkmcnt(0)" : "+v"(vl[0]), "+v"(vl[1]), "+v"(vl[2]), "+v"(vl[3]), "+v"(vl[4]), "+v"(vl[5]), "+v"(vl[6]), "+v"(vl[7]), "+v"(vl[8]), "+v"(vl[9]), "+v"(vl[10]), "+v"(vl[11]), "+v"(vl[12]), "+v"(vl[13]), "+v"(vl[14]), "+v"(vl[15]));
#pragma unroll
            for (int ii = 0; ii < 4; ++ii) { const int i = vb4 * 4 + ii;
                u32x4 pw; pw.x = pk2(S[2 * i][0], S[2 * i][1]); pw.y = pk2(S[2 * i][2], S[2 * i][3]); pw.z = pk2(S[2 * i + 1][0], S[2 * i + 1][1]); pw.w = pk2(S[2 * i + 1][2], S[2 * i + 1][3]);
                const bf16x8 pf = __builtin_bit_cast(bf16x8, pw);
#pragma unroll
                for (int dt = 0; dt < 4; ++dt) O[dt] = MFMA16(pf, vl[ii * 4 + dt], O[dt]); } }
#pragma unroll
        for (int jj = 0; jj < 4; ++jj) { const float iq = shfl_f(inv, g * 4 + jj); GAS bf16_t* orow = ycat + (tb + r * 64 + n * 16 + g * 4 + jj) * DM + h * 64 + ql;
#pragma unroll
            for (int dt = 0; dt < 4; ++dt) orow[dt * 16] = (bf16_t)f2bf(O[dt][jj] * iq); }
        NA_BAR();
    }
}

constexpr int RT_LD = 136;
__device__ __forceinline__ void ret_r1_item(Frame& F, GAS bf16_t* proj, const GAS float* rope, GAS bf16_t* KVT, int item) {
    int tid = F.wave * 64 + lane_now();
    const int lane = tid & 63, g = lane >> 4, ql = lane & 15;
    const int c = item & 63, h = (item >> 6) & 3, b = item >> 8;
    const float lgf = log2f(1.0f - exp2f(-5.0f - (float)h)), lgb = log2f(1.0f - exp2f(-5.0f - (float)(3 - h)));
    LAS bf16_t* KT = (LAS bf16_t*)F.lds; LAS bf16_t* VTF = KT + 64 * RT_LD; LAS bf16_t* VTB = VTF + 64 * RT_LD;
    u32x4 va, vb;
    {   const int i = tid >> 2, p = tid & 3; const GAS bf16_t* vrow = proj + PJ((size_t)b * SEQ + c * 128 + i, 1280 + h * 64 + 16 * p);
        va = *(const GAS u32x4*)(vrow); vb = *(const GAS u32x4*)(vrow + 8); }
    {
        constexpr size_t TS = (size_t)NTOK * 256;
        const int i = (tid >> 6) * 16 + (tid & 15), p = (tid >> 4) & 3, s = c * 128 + i; const size_t t = (size_t)b * SEQ + s;
        GAS bf16_t* row = proj + ((size_t)3 * NTOK + (t & ~(size_t)15)) * 256 + (h * 8 + p) * 128 + (i & 15) * 8;
        const u32x4 q1 = *(const GAS u32x4*)(row), q2 = *(const GAS u32x4*)(row + 512), k1 = *(const GAS u32x4*)(row + TS), k2 = *(const GAS u32x4*)(row + TS + 512);
        const GAS f32x4* cs = (const GAS f32x4*)(rope + ((size_t)s * 32 + 8 * p) * 2);
        float qa[8], qb[8], ka[8], kb[8];
        qa[0] = bflo(q1.x); qa[1] = bfhi(q1.x); qa[2] = bflo(q1.y); qa[3] = bfhi(q1.y); qa[4] = bflo(q1.z); qa[5] = bfhi(q1.z); qa[6] = bflo(q1.w); qa[7] = bfhi(q1.w);
        qb[0] = bflo(q2.x); qb[1] = bfhi(q2.x); qb[2] = bflo(q2.y); qb[3] = bfhi(q2.y); qb[4] = bflo(q2.z); qb[5] = bfhi(q2.z); qb[6] = bflo(q2.w); qb[7] = bfhi(q2.w);
        ka[0] = bflo(k1.x); ka[1] = bfhi(k1.x); ka[2] = bflo(k1.y); ka[3] = bfhi(k1.y); ka[4] = bflo(k1.z); ka[5] = bfhi(k1.z); ka[6] = bflo(k1.w); ka[7] = bfhi(k1.w);
        kb[0] = bflo(k2.x); kb[1] = bfhi(k2.x); kb[2] = bflo(k2.y); kb[3] = bfhi(k2.y); kb[4] = bflo(k2.z); kb[5] = bfhi(k2.z); kb[6] = bflo(k2.w); kb[7] = bfhi(k2.w);
        float qo1[8], qo2[8], ko1[8], ko2[8];
#pragma unroll
        for (int m = 0; m < 4; ++m) { const f32x4 w = cs[m];
            { const int j = 2 * m; const float cc = w.x, sn = w.y; qo1[j] = qa[j] * cc - qb[j] * sn; qo2[j] = qa[j] * sn + qb[j] * cc; ko1[j] = (ka[j] * cc - kb[j] * sn) * 0.125f; ko2[j] = (ka[j] * sn + kb[j] * cc) * 0.125f; }
            { const int j = 2 * m + 1; const float cc = w.z, sn = w.w; qo1[j] = qa[j] * cc - qb[j] * sn; qo2[j] = qa[j] * sn + qb[j] * cc; ko1[j] = (ka[j] * cc - kb[j] * sn) * 0.125f; ko2[j] = (ka[j] * sn + kb[j] * cc) * 0.125f; } }
        u32x4 o;
        o.x = pk2(qo1[0], qo1[1]); o.y = pk2(qo1[2], qo1[3]); o.z = pk2(qo1[4], qo1[5]); o.w = pk2(qo1[6], qo1[7]); *(GAS u32x4*)(row) = o;
        o.x = pk2(qo2[0], qo2[1]); o.y = pk2(qo2[2], qo2[3]); o.z = pk2(qo2[4], qo2[5]); o.w = pk2(qo2[6], qo2[7]); *(GAS u32x4*)(row + 512) = o;
        u32x4 ok1, ok2;
        ok1.x = pk2(ko1[0], ko1[1]); ok1.y = pk2(ko1[2], ko1[3]); ok1.z = pk2(ko1[4], ko1[5]); ok1.w = pk2(ko1[6], ko1[7]); *(GAS u32x4*)(row + TS) = ok1;
        ok2.x = pk2(ko2[0], ko2[1]); ok2.y = pk2(ko2[2], ko2[3]); ok2.z = pk2(ko2[4], ko2[5]); ok2.w = pk2(ko2[6], ko2[7]); *(GAS u32x4*)(row + TS + 512) = ok2;
        const unsigned kw1[4] = {ok1.x, ok1.y, ok1.z, ok1.w}, kw2[4] = {ok2.x, ok2.y, ok2.z, ok2.w};
#pragma unroll
        for (int j = 0; j < 8; ++j) { KT[(8 * p + j) * RT_LD + i] = (bf16_t)((kw1[j >> 1] >> ((j & 1) * 16)) & 0xffffu); KT[(32 + 8 * p + j) * RT_LD + i] = (bf16_t)((kw2[j >> 1] >> ((j & 1) * 16)) & 0xffffu); }
    }
    {   const int i = tid >> 2, p = tid & 3;
        const unsigned vw[8] = {va.x, va.y, va.z, va.w, vb.x, vb.y, vb.z, vb.w};
        const float wf = exp2f((float)(127 - i) * lgf), wb = exp2f((float)i * lgb);
#pragma unroll
        for (int j = 0; j < 16; ++j) { const float v = (j & 1) ? bfhi(vw[j >> 1]) : bflo(vw[j >> 1]);
            VTF[(16 * p + j) * RT_LD + i] = (bf16_t)f2bf(v * wf); VTB[(16 * p + j) * RT_LD + i] = (bf16_t)f2bf(v * wb); }
    }
    NA_BAR();
    {
        const int dir = F.wave >> 2, et = F.wave & 3; const LAS bf16_t* VT = dir ? VTB : VTF;
        f32x4 acc[4];
#pragma unroll
        for (int dt = 0; dt < 4; ++dt) acc[dt] = (f32x4){0.f, 0.f, 0.f, 0.f};
#pragma unroll
        for (int ks = 0; ks < 4; ++ks) { const bf16x8 a = *(const LAS bf16x8*)(VT + (et * 16 + ql) * RT_LD + ks * 32 + g * 8);
#pragma unroll
            for (int dt = 0; dt < 4; ++dt) { const bf16x8 bb = *(const LAS bf16x8*)(KT + (dt * 16 + ql) * RT_LD + ks * 32 + g * 8); acc[dt] = MFMA16(a, bb, acc[dt]); } }
        GAS bf16_t* out = KVT + ((size_t)item * 2 + dir) * 4096;
#pragma unroll
        for (int dt = 0; dt < 4; ++dt)
#pragma unroll
            for (int jj = 0; jj < 4; ++jj) out[et * 1024 + (dt * 2 + (ql >> 3)) * 128 + (g * 4 + jj) * 8 + (ql & 7)] = (bf16_t)f2bf(acc[dt][jj]);
    }
    NA_BAR();
}
__device__ __forceinline__ void ret_r2_scan(Frame& F, const GAS bf16_t* KVT, GAS bf16_t* ST, size_t gt, size_t ngt) {
    for (size_t idx = gt; idx < (size_t)32 * 512; idx += ngt) {
        const int chain = (int)(idx >> 9), el = (int)(idx & 511) * 8, bh = chain >> 1, dir = chain & 1, h = bh & 3, hh = dir ? 3 - h : h;
        const float gC = exp2f(128.0f * log2f(1.0f - exp2f(-5.0f - (float)hh)));
        float S[8];
#pragma unroll
        for (int j = 0; j < 8; ++j) S[j] = 0.f;
        const long step = dir ? -8192 : 8192;
        const size_t o0 = ((size_t)(bh * 64) * 2 + dir) * 4096 + el + (dir ? (size_t)63 * 8192 : 0);
#pragma unroll
        for (int half = 0; half < 8; ++half) { u32x4 kv[8];
#pragma unroll
            for (int cc = 0; cc < 8; ++cc) kv[cc] = *(const GAS u32x4*)(KVT + (long)o0 + (half * 8 + cc) * step);
#pragma unroll
            for (int cc = 0; cc < 8; ++cc) {
                u32x4 w; w.x = pk2(S[0], S[1]); w.y = pk2(S[2], S[3]); w.z = pk2(S[4], S[5]); w.w = pk2(S[6], S[7]); *(GAS u32x4*)(ST + (long)o0 + (half * 8 + cc) * step) = w;
                const u32x4 k = kv[cc];
                S[0] = S[0] * gC + bflo(k.x); S[1] = S[1] * gC + bfhi(k.x); S[2] = S[2] * gC + bflo(k.y); S[3] = S[3] * gC + bfhi(k.y);
                S[4] = S[4] * gC + bflo(k.z); S[5] = S[5] * gC + bfhi(k.z); S[6] = S[6] * gC + bflo(k.w); S[7] = S[7] * gC + bfhi(k.w); } }
    }
}
__device__ __forceinline__ void ret_r3_item(Frame& F, const GAS bf16_t* proj, const GAS bf16_t* ST, const GAS float* retg, GAS bf16_t* ycat, int item) {
    int tid = F.tid; asm volatile("" : "+v"(tid));
    const int lane = tid & 63, g = lane >> 4, ql = lane & 15;
    const int c = item & 63, h = (item >> 6) & 3, b = item >> 8;
    const float lgf = log2f(1.0f - exp2f(-5.0f - (float)h)), lgb = log2f(1.0f - exp2f(-5.0f - (float)(3 - h)));
    LAS bf16_t* VT = (LAS bf16_t*)F.lds;
    const size_t t0 = (size_t)b * SEQ + c * 128;
    {   const int i = tid >> 2, p = tid & 3; const GAS bf16_t* row = proj + PJ(t0 + i, 1280 + h * 64 + 16 * p);
        const u32x4 va = *(const GAS u32x4*)(row), vb = *(const GAS u32x4*)(row + 8);
        const unsigned vw[8] = {va.x, va.y, va.z, va.w, vb.x, vb.y, vb.z, vb.w};
#pragma unroll
        for (int j = 0; j < 16; ++j) VT[(16 * p + j) * RT_LD + i] = (bf16_t)((vw[j >> 1] >> ((j & 1) * 16)) & 0xffffu); }
    LAS unsigned char* KL = F.lds + 17408; LAS unsigned char* SL = F.lds + 33792;
    {   u32x4 kk[2], ss[2];
#pragma unroll
        for (int j = 0; j < 2; ++j) { const int q = tid + 512 * j; kk[j] = *(const GAS u32x4*)(proj + ((size_t)4 * NTOK + t0 + (q >> 7) * 16) * 256 + h * 8 * 128 + (q & 127) * 8); ss[j] = *(const GAS u32x4*)(ST + ((size_t)item * 2) * 4096 + (size_t)q * 8); }
#pragma unroll
        for (int j = 0; j < 2; ++j) { const int q = tid + 512 * j; *(LAS u32x4*)(KL + q * 16) = kk[j]; *(LAS u32x4*)(SL + q * 16) = ss[j]; } }
    NA_BAR();
    {
        const int qi = F.wave * 16 + ql; const size_t tq = t0 + qi;
        u32x2 gtv[4]; f32x4 gnv[4];
#pragma unroll
        for (int et = 0; et < 4; ++et) { gtv[et] = *(const GAS u32x2*)(proj + ((size_t)6 * NTOK + t0 + F.wave * 16) * 256 + (h * 8 + et * 2 + (g >> 1)) * 128 + ql * 8 + (g & 1) * 4); gnv[et] = *(const GAS f32x4*)(retg + h * 64 + et * 16 + g * 4); }
        const GAS bf16_t* qrow = proj + ((size_t)3 * NTOK + t0 + F.wave * 16) * 256 + (h * 8 + g) * 128 + ql * 8;
        bf16x8 qf[2]; qf[0] = *(const GAS bf16x8*)(qrow); qf[1] = *(const GAS bf16x8*)(qrow + 512);
        f32x4 st[8];
        {   bf16x8 kf[16];
#pragma unroll
            for (int kt = 0; kt < 8; ++kt) { const LAS unsigned char* kp = KL + kt * 2048 + g * 256 + ql * 16; kf[2 * kt] = *(const LAS bf16x8*)(kp); kf[2 * kt + 1] = *(const LAS bf16x8*)(kp + 1024); }
            asm volatile("" : "+v"(kf[0]), "+v"(kf[1]), "+v"(kf[2]), "+v"(kf[3]), "+v"(kf[4]), "+v"(kf[5]), "+v"(kf[6]), "+v"(kf[7]), "+v"(kf[8]), "+v"(kf[9]), "+v"(kf[10]), "+v"(kf[11]), "+v"(kf[12]), "+v"(kf[13]), "+v"(kf[14]), "+v"(kf[15]));
#pragma unroll
            for (int kt = 0; kt < 8; ++kt) { f32x4 a = (f32x4){0.f, 0.f, 0.f, 0.f}; a = MFMA16(kf[2 * kt], qf[0], a); a = MFMA16(kf[2 * kt + 1], qf[1], a);
#pragma unroll
                for (int jj = 0; jj < 4; ++jj) { const int df = qi - (kt * 16 + g * 4 + jj); a[jj] *= (df >= 0) ? exp2f((float)df * lgf) : exp2f((float)(-df) * lgb); }
                st[kt] = a; } }
        f32x4 oi[4], of[4], ob[4];
#pragma unroll
        for (int et = 0; et < 4; ++et) { oi[et] = (f32x4){0.f, 0.f, 0.f, 0.f}; of[et] = oi[et]; ob[et] = oi[et]; }
#pragma unroll
        for (int kp = 0; kp < 4; ++kp) { u32x4 pw; pw.x = pk2(st[2 * kp][0], st[2 * kp][1]); pw.y = pk2(st[2 * kp][2], st[2 * kp][3]); pw.z = pk2(st[2 * kp + 1][0], st[2 * kp + 1][1]); pw.w = pk2(st[2 * kp + 1][2], st[2 * kp + 1][3]);
            const bf16x8 pf = __builtin_bit_cast(bf16x8, pw);
#pragma unroll
            for (int et = 0; et < 4; ++et) { const LAS bf16_t* vr = VT + (et * 16 + ql) * RT_LD + kp * 32 + g * 4;
                const u32x2 lo = *(const LAS u32x2*)(vr), hi = *(const LAS u32x2*)(vr + 16); u32x4 aw; aw.x = lo.x; aw.y = lo.y; aw.z = hi.x; aw.w = hi.y;
                oi[et] = MFMA16(__builtin_bit_cast(bf16x8, aw), pf, oi[et]); } }
        {   bf16x8 sfr[8], sbr[8];
#pragma unroll
            for (int et = 0; et < 4; ++et)
#pragma unroll
                for (int ks = 0; ks < 2; ++ks) { const int o = (et * 1024 + (ks * 4 + g) * 128 + ql * 8) * 2; sfr[et * 2 + ks] = *(const LAS bf16x8*)(SL + o); sbr[et * 2 + ks] = *(const LAS bf16x8*)(SL + 8192 + o); }
            asm volatile("" : "+v"(sfr[0]), "+v"(sfr[1]), "+v"(sfr[2]), "+v"(sfr[3]), "+v"(sfr[4]), "+v"(sfr[5]), "+v"(sfr[6]), "+v"(sfr[7]), "+v"(sbr[0]), "+v"(sbr[1]), "+v"(sbr[2]), "+v"(sbr[3]), "+v"(sbr[4]), "+v"(sbr[5]), "+v"(sbr[6]), "+v"(sbr[7]));
#pragma unroll
            for (int et = 0; et < 4; ++et)
#pragma unroll
                for (int ks = 0; ks < 2; ++ks) { of[et] = MFMA16(sfr[et * 2 + ks], qf[ks], of[et]); ob[et] = MFMA16(sbr[et * 2 + ks], qf[ks], ob[et]); } }
        const float af = exp2f((float)(qi + 1) * lgf), abw = exp2f((float)(128 - qi) * lgb);
        float sum = 0.f;
#pragma unroll
        for (int et = 0; et < 4; ++et) { oi[et] = oi[et] + of[et] * af + ob[et] * abw; sum += (oi[et][0] + oi[et][1]) + (oi[et][2] + oi[et][3]); }
        sum += shfl_xor_f(sum, 16); sum += shfl_xor_f(sum, 32);
        const float mu = sum * (1.0f / 64.0f); float vs = 0.f;
#pragma unroll
        for (int et = 0; et < 4; ++et) { oi[et] = oi[et] - mu; vs += (oi[et][0] * oi[et][0] + oi[et][1] * oi[et][1]) + (oi[et][2] * oi[et][2] + oi[et][3] * oi[et][3]); }
        vs += shfl_xor_f(vs, 16); vs += shfl_xor_f(vs, 32);
        const float rs = rsqrtf(vs * (1.0f / 64.0f) + EPS);
#pragma unroll
        for (int et = 0; et < 4; ++et) { const int e = et * 16 + g * 4;
            const u32x2 gt = gtv[et]; const f32x4 gn = gnv[et];
            u32x2 w; w.x = pk2(oi[et][0] * rs * gn[0] * silu_f(bflo(gt.x)), oi[et][1] * rs * gn[1] * silu_f(bfhi(gt.x)));
            w.y = pk2(oi[et][2] * rs * gn[2] * silu_f(bflo(gt.y)), oi[et][3] * rs * gn[3] * silu_f(bfhi(gt.y)));
            *(GAS u32x2*)(ycat + tq * DM + 256 + h * 64 + e) = w; }
    }
    NA_BAR();
}

constexpr int G_LD = 72;
constexpr int G_K = 0, G_Q = 9216, G_KST = 18432, G_ATT = 39168, G_LD4 = 57600, G_LZ = 65792, G_UT = 84224, G_RB1 = 125696, G_GC = 133888, G_BETA = 134400;
#define PRW(r) ((r) + ((r) >> 3))
constexpr size_t GOP_BYTES = 32768;
__device__ __forceinline__ int natidx(int dir, int i) { return dir ? 63 - i : i; }

constexpr int G_TI = G_RB1;
__device__ __forceinline__ void gdn_tinv(LAS unsigned char* lds, int tid) {
    const int dir = tid >> 6, blk = (tid >> 4) & 3, col = tid & 15;
    const LAS float* ld = (const LAS float*)(lds + G_LD4) + (dir * 4 + blk) * 256;
    float sol[16];
#pragma unroll
    for (int r = 0; r < 16; ++r) sol[r] = (r == col) ? 1.f : 0.f;
#pragma unroll
    for (int r = 1; r < 16; ++r) {
#pragma unroll
        for (int j4 = 0; j4 < (r + 3) / 4; ++j4) { const f32x4 lv = *(const LAS f32x4*)(ld + r * 16 + j4 * 4);
#pragma unroll
            for (int jj = 0; jj < 4; ++jj) if (j4 * 4 + jj < r) sol[r] -= lv[jj] * sol[j4 * 4 + jj]; } }
    LAS bf16_t* ti = (LAS bf16_t*)(lds + G_TI) + (dir * 4 + blk) * 256 + col;
#pragma unroll
    for (int r = 0; r < 16; ++r) ti[r * 16] = (bf16_t)f2bf(sol[r]);
}
template <int BLK>
__device__ __forceinline__ void gdn_solve_blk(const LAS bf16_t* lzb, const LAS bf16_t* tib, LAS bf16_t* utr, int g) {
    constexpr int NKS = (BLK * 16 + 31) / 32;
    f32x4 acc = (f32x4){0.f, 0.f, 0.f, 0.f};
#pragma unroll
    for (int ks = 0; ks < (BLK > 0 ? NKS : 0); ++ks) acc = MFMA16(*(const LAS bf16x8*)(lzb + BLK * 16 * G_LD + ks * 32), *(const LAS bf16x8*)(utr + ks * 32 + g * 8), acc);
    const u32x2 rw = *(const LAS u32x2*)(utr + BLK * 16 + g * 4);
    const u32x2 tw = *(const LAS u32x2*)(tib + BLK * 256);
    u32x4 bx; bx.x = pk2(bflo(rw.x) - acc[0], bfhi(rw.x) - acc[1]); bx.y = pk2(bflo(rw.y) - acc[2], bfhi(rw.y) - acc[3]); bx.z = 0u; bx.w = 0u;
    u32x4 at; at.x = tw.x; at.y = tw.y; at.z = 0u; at.w = 0u;
    const f32x4 so = MFMA16(__builtin_bit_cast(bf16x8, at), __builtin_bit_cast(bf16x8, bx), ((f32x4){0.f, 0.f, 0.f, 0.f}));
    u32x2 w; w.x = pk2(so[0], so[1]); w.y = pk2(so[2], so[3]);
    *(LAS u32x2*)(utr + BLK * 16 + g * 4) = w;
    asm volatile("" ::: "memory");
}
__device__ __forceinline__ void gdn_solve_wave(LAS unsigned char* lds, int wave, int lane) {
    const int dir = wave >> 2, q = wave & 3, g = lane >> 4, ql = lane & 15;
    const LAS bf16_t* lzb = (const LAS bf16_t*)(lds + G_LZ) + (dir * 64 + ql) * G_LD + g * 8;
    const LAS bf16_t* tib = (const LAS bf16_t*)(lds + G_TI) + dir * 4 * 256 + ql * 16 + g * 4;
#pragma unroll
    for (int cc = 0; cc < 2; ++cc) { const int ct = q * 2 + cc;
        LAS bf16_t* utr = (LAS bf16_t*)(lds + G_UT) + (dir * 144 + ct * 18 + PRW(ql)) * G_LD;
        gdn_solve_blk<0>(lzb, tib, utr, g); gdn_solve_blk<1>(lzb, tib, utr, g); gdn_solve_blk<2>(lzb, tib, utr, g); gdn_solve_blk<3>(lzb, tib, utr, g); }
}

__device__ __forceinline__ void gdn_g1_item(Frame& F, const GAS bf16_t* proj, const GAS float* ab, const GAS float* convw, const GAS float* alog, const GAS float* dtb, GAS unsigned char* gop, int item, const LAS float* cwl) {
    int tid = F.wave * 64 + lane_now();
    const int lane = tid & 63, g = lane >> 4, ql = lane & 15, wave = F.wave;
    const int n = item & 127, h = (item >> 7) & 3, b = item >> 9; const size_t tb = (size_t)b * SEQ; const int s0 = n * 64;
    LAS bf16_t* Ks = (LAS bf16_t*)(F.lds + G_K); LAS bf16_t* Qs = (LAS bf16_t*)(F.lds + G_Q);
    LAS float* GC = (LAS float*)(F.lds + G_GC); LAS float* BETA = (LAS float*)(F.lds + G_BETA);
    u32x4 xin[4][3];
    {   const int i = tid >> 3, p = tid & 7, s = s0 + i;
#pragma unroll
        for (int tap = 0; tap < 4; ++tap) { const int s2 = s + tap - 2; const bool ok = (s2 >= 0 && s2 < SEQ);
#pragma unroll
            for (int part = 0; part < 3; ++part) { xin[tap][part] = (u32x4){0u, 0u, 0u, 0u}; if (ok) xin[tap][part] = *(const GAS u32x4*)(proj + PJ(tb + s2, 2048 + part * 256 + h * 64 + 8 * p)); } } }
    if (tid < 128) { const int dir = tid >> 6, i = tid & 63; const size_t t = tb + s0 + i;
        const float a = ab[t * 16 + dir * 4 + h], bb = ab[t * 16 + 8 + dir * 4 + h];
        float v = -__expf(alog[dir * 4 + h]) * softplus_f(a + dtb[dir * 4 + h]);
#pragma unroll
        for (int off = 1; off < 64; off <<= 1) { const int srcl = dir ? lane + off : lane - off;
            const float o = __builtin_bit_cast(float, __builtin_amdgcn_ds_bpermute((srcl & 63) << 2, __builtin_bit_cast(int, v))); if (srcl >= 0 && srcl < 64) v += o; }
        GC[dir * 64 + i] = v; BETA[dir * 64 + i] = sigmoid_f(bb); }
    {   const int i = tid >> 3, p = tid & 7;
        float u[3][8];
#pragma unroll
        for (int part = 0; part < 3; ++part)
#pragma unroll
            for (int j = 0; j < 8; ++j) u[part][j] = 0.f;
#pragma unroll
        for (int tap = 0; tap < 4; ++tap) {
#pragma unroll
            for (int part = 0; part < 3; ++part) { const u32x4 x = xin[tap][part];
                f32x4 w0, w1;
                if (cwl) { const LAS float* wl = cwl + (tap * 3 + part) * 64 + 8 * p; w0 = *(const LAS f32x4*)wl; w1 = *(const LAS f32x4*)(wl + 4); }
                else { const GAS float* wp = convw + tap * 768 + part * 256 + h * 64 + 8 * p; w0 = *(const GAS f32x4*)wp; w1 = *(const GAS f32x4*)(wp + 4); }
                u[part][0] += w0[0] * bflo(x.x); u[part][1] += w0[1] * bfhi(x.x); u[part][2] += w0[2] * bflo(x.y); u[part][3] += w0[3] * bfhi(x.y);
                u[part][4] += w1[0] * bflo(x.z); u[part][5] += w1[1] * bfhi(x.z); u[part][6] += w1[2] * bflo(x.w); u[part][7] += w1[3] * bfhi(x.w); } }
        float ssq[2] = {0.f, 0.f};
#pragma unroll
        for (int part = 0; part < 3; ++part)
#pragma unroll
            for (int j = 0; j < 8; ++j) { u[part][j] = silu_f(u[part][j]); if (part < 2) ssq[part] += u[part][j] * u[part][j]; }
#pragma unroll
        for (int part = 0; part < 2; ++part) { float q = ssq[part];
#pragma unroll
            for (int m = 1; m < 8; m <<= 1) q += __builtin_bit_cast(float, __builtin_amdgcn_ds_bpermute((lane ^ m) << 2, __builtin_bit_cast(int, q)));
            ssq[part] = rsqrtf(q + EPS); }
        const float qs = ssq[0] * 0.125f, ks = ssq[1];
        __syncthreads();
        u32x4 o;
        o.x = pk2(u[0][0] * qs, u[0][1] * qs); o.y = pk2(u[0][2] * qs, u[0][3] * qs); o.z = pk2(u[0][4] * qs, u[0][5] * qs); o.w = pk2(u[0][6] * qs, u[0][7] * qs); *(LAS u32x4*)(Qs + i * G_LD + 8 * p) = o;
        o.x = pk2(u[1][0] * ks, u[1][1] * ks); o.y = pk2(u[1][2] * ks, u[1][3] * ks); o.z = pk2(u[1][4] * ks, u[1][5] * ks); o.w = pk2(u[1][6] * ks, u[1][7] * ks); *(LAS u32x4*)(Ks + i * G_LD + 8 * p) = o;
#pragma unroll
        for (int dir = 0; dir < 2; ++dir) { const float gci = GC[dir * 64 + i], bi = BETA[dir * 64 + i];
            const float sc = ks * __expf(GC[dir * 64 + (dir ? 0 : 63)] - gci), sw = ks * bi * __expf(gci); const int ip = natidx(dir, i);
            LAS bf16_t* kst = (LAS bf16_t*)(F.lds + G_KST) + dir * 72 * G_LD; LAS bf16_t* ut = (LAS bf16_t*)(F.lds + G_UT) + dir * 144 * G_LD;
#pragma unroll
            for (int j = 0; j < 8; ++j) { kst[(9 * p + j) * G_LD + ip] = (bf16_t)f2bf(u[1][j] * sc); ut[(9 * p + j) * G_LD + ip] = (bf16_t)f2bf(u[2][j] * bi); ut[(72 + 9 * p + j) * G_LD + ip] = (bf16_t)f2bf(u[1][j] * sw); } }
    }
    __syncthreads();
    {   const int dir = wave >> 2, it = wave & 3;
        const LAS float* gc = GC + dir * 64; const LAS float* be = BETA + dir * 64;
        LAS float* Ld = (LAS float*)(F.lds + G_LD4) + (dir * 4 + it) * 256; LAS bf16_t* Lz = (LAS bf16_t*)(F.lds + G_LZ) + dir * 64 * G_LD; LAS bf16_t* At = (LAS bf16_t*)(F.lds + G_ATT) + dir * 64 * G_LD;
        const int ra = natidx(dir, it * 16 + ql);
        bf16x8 ka[2], qa[2];
#pragma unroll
        for (int ks = 0; ks < 2; ++ks) { ka[ks] = *(const LAS bf16x8*)(Ks + ra * G_LD + ks * 32 + g * 8); qa[ks] = *(const LAS bf16x8*)(Qs + ra * G_LD + ks * 32 + g * 8); }
#pragma unroll
        for (int jt = 0; jt < 4; ++jt) { const int rb = natidx(dir, jt * 16 + ql);
            f32x4 kk = (f32x4){0.f, 0.f, 0.f, 0.f}, qk = kk;
#pragma unroll
            for (int ks = 0; ks < 2; ++ks) { const bf16x8 kb = *(const LAS bf16x8*)(Ks + rb * G_LD + ks * 32 + g * 8); kk = MFMA16(ka[ks], kb, kk); qk = MFMA16(qa[ks], kb, qk); }
            const int jp = jt * 16 + ql; const float gj = gc[natidx(dir, jp)];
#pragma unroll
            for (int jj = 0; jj < 4; ++jj) { const int ip = it * 16 + g * 4 + jj, ni = natidx(dir, ip); const float dec = (ip >= jp) ? __expf(gc[ni] - gj) : 0.f;
                const float lval = (ip > jp) ? be[ni] * kk[jj] * dec : 0.f;
                if (jt == it) Ld[(g * 4 + jj) * 16 + ql] = lval;
                Lz[ip * G_LD + jp] = (bf16_t)((jt < it) ? f2bf(lval) : 0u);
                At[ip * G_LD + jp] = (bf16_t)f2bf(qk[jj] * dec); } }
    }
    __syncthreads();
    if (tid < 128) gdn_tinv(F.lds, tid);
    __syncthreads();
    gdn_solve_wave(F.lds, wave, lane);
    __syncthreads();
    {   const int dir = wave >> 2, prod = wave & 3;
        const LAS float* gc = GC + dir * 64;
        const LAS bf16_t* At = (const LAS bf16_t*)(F.lds + G_ATT) + dir * 64 * G_LD; const LAS bf16_t* kst = (const LAS bf16_t*)(F.lds + G_KST) + dir * 72 * G_LD;
        const LAS bf16_t* UT = (const LAS bf16_t*)(F.lds + G_UT) + dir * 144 * G_LD; const LAS bf16_t* WT = UT + 72 * G_LD;
        const int arow = PRW(ql), brow = (prod >= 2) ? PRW(ql) : ql, bstep = (prod >= 2) ? 18 : 16;
        GAS unsigned char* outp = gop + ((size_t)item * 2 + dir) * GOP_BYTES;
        const LAS bf16_t* Am = (prod == 0) ? UT : (prod == 3) ? kst : WT;
        const LAS bf16_t* Bm = (prod == 3) ? UT : (prod == 2) ? kst : At;
        f32x4 acc[4][4];
#pragma unroll
        for (int x = 0; x < 4; ++x)
#pragma unroll
            for (int y = 0; y < 4; ++y) acc[x][y] = (f32x4){0.f, 0.f, 0.f, 0.f};
#pragma unroll
        for (int ks = 0; ks < 2; ++ks) { bf16x8 bf[4];
#pragma unroll
            for (int y = 0; y < 4; ++y) bf[y] = *(const LAS bf16x8*)(Bm + (y * bstep + brow) * G_LD + ks * 32 + g * 8);
#pragma unroll
            for (int x = 0; x < 4; ++x) { const bf16x8 af = *(const LAS bf16x8*)(Am + (x * 18 + arow) * G_LD + ks * 32 + g * 8);
#pragma unroll
                for (int y = 0; y < 4; ++y) acc[x][y] = MFMA16(af, bf[y], acc[x][y]); } }
        if (prod == 0 || prod == 3) {
            GAS unsigned char* o = outp + (prod == 0 ? 16384 : 24576);
#pragma unroll
            for (int x = 0; x < 4; ++x)
#pragma unroll
                for (int y = 0; y < 4; ++y) { u32x2 w; w.x = pk2(acc[x][y][0], acc[x][y][1]); w.y = pk2(acc[x][y][2], acc[x][y][3]); *(GAS u32x2*)(o + ((size_t)(((prod == 0) ? (x * 4 + y) : (y * 4 + x)) * 64 + lane)) * 8) = w; }
        } else {
            const float a_last = __expf(gc[dir ? 0 : 63]);
#pragma unroll
            for (int y = 0; y < 4; ++y) { float val[4][4];
                const int col = y * 16 + ql;
#pragma unroll
                for (int x = 0; x < 4; ++x) {
                    if (prod == 1) { const int ni = natidx(dir, col); const float eg = __expf(gc[ni]); const u32x2 qv = *(const LAS u32x2*)(Qs + ni * G_LD + x * 16 + g * 4);
                        val[x][0] = bflo(qv.x) * eg - acc[x][y][0]; val[x][1] = bfhi(qv.x) * eg - acc[x][y][1]; val[x][2] = bflo(qv.y) * eg - acc[x][y][2]; val[x][3] = bfhi(qv.y) * eg - acc[x][y][3]; }
                    else {
#pragma unroll
                        for (int jj = 0; jj < 4; ++jj) val[x][jj] = ((x * 16 + g * 4 + jj == col) ? a_last : 0.f) - acc[x][y][jj]; } }
#pragma unroll
                for (int ks = 0; ks < 2; ++ks) { u32x4 w; w.x = pk2(val[2 * ks][0], val[2 * ks][1]); w.y = pk2(val[2 * ks][2], val[2 * ks][3]); w.z = pk2(val[2 * ks + 1][0], val[2 * ks + 1][1]); w.w = pk2(val[2 * ks + 1][2], val[2 * ks + 1][3]);
                    *(GAS u32x4*)(outp + (prod == 1 ? 0 : 8192) + ((size_t)((y * 2 + ks) * 64 + lane)) * 16) = w; } }
        }
    }
    NA_BAR();
}

constexpr int GS_SLOT = 20480, GS_NSLOT = 6;
struct GdnStage { u32x4 a[5]; };
__device__ __forceinline__ const GAS unsigned char* gdn_src_piece(const GAS unsigned char* src, int sl, int p) {
    const int off = p * 16;
    return src + (off < 16384 ? off : (off < 18432 ? off + sl * 2048 : 24576 + sl * 2048 + (off - 18432)));
}
__device__ __forceinline__ void gdn_ld_stage(GdnStage& R, const GAS unsigned char* src, int sl, int lw, int lane) {
#pragma unroll
    for (int j = 0; j < 5; ++j) R.a[j] = *(const GAS u32x4*)gdn_src_piece(src, sl, lw * 320 + j * 64 + lane);
}
__device__ __forceinline__ void gdn_st_stage(const GdnStage& R, LAS unsigned char* slot, int lw, int lane) {
#pragma unroll
    for (int j = 0; j < 5; ++j) *(LAS u32x4*)(slot + (lw * 320 + j * 64 + lane) * 16) = R.a[j];
}
__device__ __forceinline__ void gdn_compute(const LAS unsigned char* slot, f32x4 (&S)[4], GAS bf16_t* orow0, int dir, int ql, int lane) {
    bf16x8 qf[8]; u32x2 o0[4], b0[4];
#pragma unroll
    for (int i = 0; i < 8; ++i) qf[i] = *(const LAS bf16x8*)(slot + (i * 64 + lane) * 16);
#pragma unroll
    for (int x = 0; x < 4; ++x) { o0[x] = *(const LAS u32x2*)(slot + 16384 + (x * 64 + lane) * 8); b0[x] = *(const LAS u32x2*)(slot + 18432 + (x * 64 + lane) * 8); }
    bf16x8 sf[2];
#pragma unroll
    for (int ks = 0; ks < 2; ++ks) { u32x4 w; w.x = pk2(S[2 * ks][0], S[2 * ks][1]); w.y = pk2(S[2 * ks][2], S[2 * ks][3]); w.z = pk2(S[2 * ks + 1][0], S[2 * ks + 1][1]); w.w = pk2(S[2 * ks + 1][2], S[2 * ks + 1][3]); sf[ks] = __builtin_bit_cast(bf16x8, w); }
    asm volatile("s_waitcnt lgkmcnt(0)" : "+v"(qf[0]), "+v"(qf[1]), "+v"(qf[2]), "+v"(qf[3]), "+v"(qf[4]), "+v"(qf[5]), "+v"(qf[6]), "+v"(qf[7]), "+v"(o0[0]), "+v"(o0[1]), "+v"(o0[2]), "+v"(o0[3]), "+v"(b0[0]), "+v"(b0[1]), "+v"(b0[2]), "+v"(b0[3]));
    bf16x8 mf[8];
#pragma unroll
    for (int i = 0; i < 8; ++i) mf[i] = *(const LAS bf16x8*)(slot + 8192 + (i * 64 + lane) * 16);
#pragma unroll
    for (int xp = 0; xp < 2; ++xp) { u32x2 w[2];
#pragma unroll
        for (int xx = 0; xx < 2; ++xx) { const int x = xp * 2 + xx; f32x4 o = (f32x4){bflo(o0[x].x), bfhi(o0[x].x), bflo(o0[x].y), bfhi(o0[x].y)};
            o = MFMA16(sf[0], qf[x * 2], o); o = MFMA16(sf[1], qf[x * 2 + 1], o);
            w[xx].x = pk2(o[0], o[1]); w[xx].y = pk2(o[2], o[3]); }
        const auto r0 = __builtin_amdgcn_permlane16_swap(w[0].x, w[1].x, false, false), r1 = __builtin_amdgcn_permlane16_swap(w[0].y, w[1].y, false, false);
        const int godd = (lane >> 4) & 1;
        u32x4 v; v.x = r0[0]; v.y = r1[0]; v.z = r0[1]; v.w = r1[1];
        *(GAS u32x4*)(orow0 - 4 * godd + (size_t)natidx(dir, (xp * 2 + godd) * 16 + ql) * 256) = v; }
    asm volatile("s_waitcnt lgkmcnt(0)" : "+v"(mf[0]), "+v"(mf[1]), "+v"(mf[2]), "+v"(mf[3]), "+v"(mf[4]), "+v"(mf[5]), "+v"(mf[6]), "+v"(mf[7]));
#pragma unroll
    for (int x = 0; x < 4; ++x) { f32x4 n = (f32x4){bflo(b0[x].x), bfhi(b0[x].x), bflo(b0[x].y), bfhi(b0[x].y)};
        n = MFMA16(mf[x * 2], sf[0], n); n = MFMA16(mf[x * 2 + 1], sf[1], n); S[x] = n; }
}
__device__ __forceinline__ void gdn_scan_block(Frame& F, const GAS unsigned char* gop, GAS bf16_t* Og, int chain) {
    const int lane = F.lane, g = lane >> 4, ql = lane & 15, wave = F.wave, sl = chain & 3, dir = (chain >> 2) & 1, bh = chain >> 3, h = bh & 3, b = bh >> 2;
    const bool loader = (wave >= 1 && wave <= 4), comp = (wave == 0); const int lw = wave - 1;
    f32x4 S[4];
#pragma unroll
    for (int x = 0; x < 4; ++x) S[x] = (f32x4){0.f, 0.f, 0.f, 0.f};
    const GAS unsigned char* base = gop + ((size_t)bh * 128 * 2 + dir) * GOP_BYTES;
    GAS bf16_t* obase = Og + ((size_t)dir * NTOK + (size_t)b * SEQ) * 256 + h * 64 + sl * 16 + g * 4;
    LAS unsigned char* ring = F.lds;
#define GDN_BAR() do { asm volatile("s_waitcnt lgkmcnt(0)" ::: "memory"); __builtin_amdgcn_s_barrier(); asm volatile("" ::: "memory"); } while (0)
#define GDN_SRC(st) (base + (size_t)(dir ? 127 - (st) : (st)) * 2 * GOP_BYTES)
    if (loader) {
        GdnStage R0, R1, R2, R3;
        gdn_ld_stage(R0, GDN_SRC(0), sl, lw, lane); gdn_ld_stage(R1, GDN_SRC(1), sl, lw, lane); gdn_ld_stage(R2, GDN_SRC(2), sl, lw, lane); gdn_ld_stage(R3, GDN_SRC(3), sl, lw, lane);
        gdn_st_stage(R0, ring + 0 * GS_SLOT, lw, lane); gdn_st_stage(R1, ring + 1 * GS_SLOT, lw, lane); gdn_st_stage(R2, ring + 2 * GS_SLOT, lw, lane); gdn_st_stage(R3, ring + 3 * GS_SLOT, lw, lane);
        gdn_ld_stage(R0, GDN_SRC(4), sl, lw, lane); gdn_ld_stage(R1, GDN_SRC(5), sl, lw, lane); gdn_ld_stage(R2, GDN_SRC(6), sl, lw, lane); gdn_ld_stage(R3, GDN_SRC(7), sl, lw, lane);
        GDN_BAR();
        int sw = 4;
#define GDN_STEP(stv, RN) do { const int _st = (stv); gdn_st_stage(RN, ring + sw * GS_SLOT, lw, lane); gdn_ld_stage(RN, GDN_SRC(min(_st + 8, 127)), sl, lw, lane); \
        GDN_BAR(); sw = (sw == GS_NSLOT - 1) ? 0 : sw + 1; } while (0)
        GDN_STEP(0, R0); GDN_STEP(1, R1); GDN_STEP(2, R2); GDN_STEP(3, R3);
        for (int st = 4; st < 128; st += 4) { GDN_STEP(st, R0); GDN_STEP(st + 1, R1); GDN_STEP(st + 2, R2); GDN_STEP(st + 3, R3); }
    } else if (comp) {
        GDN_BAR();
        int s0 = 0;
        for (int st = 0; st < 128; ++st) { gdn_compute(ring + s0 * GS_SLOT, S, obase + (size_t)(dir ? 127 - st : st) * 64 * 256, dir, ql, lane); GDN_BAR(); s0 = (s0 == GS_NSLOT - 1) ? 0 : s0 + 1; }
    } else {
        GDN_BAR();
        for (int st = 0; st < 128; ++st) GDN_BAR();
    }
#undef GDN_STEP
#undef GDN_SRC
#undef GDN_BAR
}

__device__ __forceinline__ void gdn_finalize(Frame& F, const GAS bf16_t* proj, const GAS bf16_t* Og, const GAS float* gdng, GAS bf16_t* ycat, int gw, int ngw) {
    const int lane = F.lane, sub = lane >> 3, e8 = (lane & 7) * 8;
    const f32x4 gn0 = *(const GAS f32x4*)(gdng + e8), gn1 = *(const GAS f32x4*)(gdng + e8 + 4);
    for (int base = gw * 16; base < NTOK * 4; base += ngw * 16) {
        u32x4 av[2], bv[2], gv[2];
#pragma unroll
        for (int u = 0; u < 2; ++u) { const int pair = base + u * 8 + sub, t = pair >> 2, h = pair & 3; const size_t o = (size_t)t * 256 + h * 64 + e8;
            av[u] = *(const GAS u32x4*)(Og + o); bv[u] = *(const GAS u32x4*)(Og + (size_t)NTOK * 256 + o); gv[u] = *(const GAS u32x4*)(proj + PJ((size_t)t, 2816 + h * 64 + e8)); }
#pragma unroll
        for (int u = 0; u < 2; ++u) { const int pair = base + u * 8 + sub, t = pair >> 2, h = pair & 3; const u32x4 a = av[u], b = bv[u], gt = gv[u];
            const float x0 = bflo(a.x) + bflo(b.x), x1 = bfhi(a.x) + bfhi(b.x), x2 = bflo(a.y) + bflo(b.y), x3 = bfhi(a.y) + bfhi(b.y);
            const float x4 = bflo(a.z) + bflo(b.z), x5 = bfhi(a.z) + bfhi(b.z), x6 = bflo(a.w) + bflo(b.w), x7 = bfhi(a.w) + bfhi(b.w);
            float ms = ((x0 * x0 + x1 * x1) + (x2 * x2 + x3 * x3)) + ((x4 * x4 + x5 * x5) + (x6 * x6 + x7 * x7));
            ms += shfl_xor_f(ms, 1); ms += shfl_xor_f(ms, 2); ms += shfl_xor_f(ms, 4);
            const float rs = rsqrtf(ms * (1.0f / 64.0f) + EPS);
            u32x4 w; w.x = pk2(x0 * rs * gn0[0] * silu_f(bflo(gt.x)), x1 * rs * gn0[1] * silu_f(bfhi(gt.x))); w.y = pk2(x2 * rs * gn0[2] * silu_f(bflo(gt.y)), x3 * rs * gn0[3] * silu_f(bfhi(gt.y)));
            w.z = pk2(x4 * rs * gn1[0] * silu_f(bflo(gt.z)), x5 * rs * gn1[1] * silu_f(bfhi(gt.z))); w.w = pk2(x6 * rs * gn1[2] * silu_f(bflo(gt.w)), x7 * rs * gn1[3] * silu_f(bfhi(gt.w)));
            *(GAS u32x4*)(ycat + (size_t)t * DM + 768 + h * 64 + e8) = w; }
    }
}

__device__ __forceinline__ void router_phase(Frame& F, int l) {
    GAS unsigned char* ws = F.ws; const int lane = F.lane, g = lane >> 4;
    const GAS bf16_t* X = (const GAS bf16_t*)(ws + WS_XB); const GAS float* ssq = (const GAS float*)(ws + WS_SSQ);
    const GAS bf16x8* fh = (const GAS bf16x8*)(ws + WS_TAB + TAB_RFR + (size_t)l * 196608); const GAS bf16x8* fl = fh + 6144;
    GAS int* toke = (GAS int*)(ws + WS_TAB + TAB_TOKE); GAS float* tokw = (GAS float*)(ws + WS_TAB + TAB_TOKW);
    LAS float* lg = (LAS float*)(F.lds + F.wave * 4096);
    LAS int* hist = (LAS int*)(F.lds + LDS_MISC + 256);
    if (F.tid < NEXP) hist[F.tid] = 0;
    __syncthreads();
    const GAS float* bg = F.inp(I_BGRP) + l * 4; const GAS float* br = F.inp(I_BRT) + l * 32;
    for (int tile = F.gw; tile < NTOK / 16; tile += F.ngw) {
        const int t0 = tile * 16; const GAS bf16_t* xr = X + (size_t)(t0 + (lane & 15)) * DM + g * 8;
        f32x4 acc[3];
#pragma unroll
        for (int ct = 0; ct < 3; ++ct) acc[ct] = (f32x4){0.f, 0.f, 0.f, 0.f};
        if (F.ngw == NTOK / 16) {
            LAS unsigned char* wbuf = F.lds + 32768; const int stid = F.wave * 64 + lane_now();
            u32x4 pre[3];
#pragma unroll
            for (int j = 0; j < 3; ++j) { const int q = stid + 512 * j; pre[j] = *(const GAS u32x4*)(q < 768 ? fh + q : fl + (q - 768)); }
#pragma unroll 1
            for (int kb = 0; kb < 8; ++kb) { LAS unsigned char* buf = wbuf + (kb & 1) * 24576;
#pragma unroll
                for (int j = 0; j < 3; ++j) *(LAS u32x4*)(buf + (stid + 512 * j) * 16) = pre[j];
                NA_BAR();
                if (kb < 7) {
#pragma unroll
                    for (int j = 0; j < 3; ++j) { const int q = stid + 512 * j; pre[j] = *(const GAS u32x4*)(q < 768 ? fh + (kb + 1) * 768 + q : fl + (kb + 1) * 768 + (q - 768)); } }
                bf16x8 xa[4]; bf16x8 wh[4][3], wl[4][3];
#pragma unroll
                for (int i = 0; i < 4; ++i) { const int ks = kb * 4 + i; xa[i] = *(const GAS bf16x8*)(xr + ks * 32);
#pragma unroll
                    for (int ct = 0; ct < 3; ++ct) { wh[i][ct] = *(const LAS bf16x8*)(buf + ((i * 3 + ct) * 64 + lane) * 16); wl[i][ct] = *(const LAS bf16x8*)(buf + 12288 + ((i * 3 + ct) * 64 + lane) * 16); } }
                asm volatile("" : "+v"(xa[0]), "+v"(xa[1]), "+v"(xa[2]), "+v"(xa[3]),
                                  "+v"(wh[0][0]), "+v"(wh[0][1]), "+v"(wh[0][2]), "+v"(wh[1][0]), "+v"(wh[1][1]), "+v"(wh[1][2]), "+v"(wh[2][0]), "+v"(wh[2][1]), "+v"(wh[2][2]), "+v"(wh[3][0]), "+v"(wh[3][1]), "+v"(wh[3][2]));
#pragma unroll
                for (int i = 0; i < 4; ++i)
#pragma unroll
                    for (int ct = 0; ct < 3; ++ct) { acc[ct] = MFMA16(wh[i][ct], xa[i], acc[ct]); acc[ct] = MFMA16(wl[i][ct], xa[i], acc[ct]); }
            }
            NA_BAR();
        } else
#pragma unroll 1
        for (int kb = 0; kb < 8; ++kb) {
            bf16x8 xa[4]; bf16x8 wh[4][3], wl[4][3];
#pragma unroll
            for (int i = 0; i < 4; ++i) { const int ks = kb * 4 + i; xa[i] = *(const GAS bf16x8*)(xr + ks * 32);
#pragma unroll
                for (int ct = 0; ct < 3; ++ct) { wh[i][ct] = fh[(ks * 3 + ct) * 64 + lane]; wl[i][ct] = fl[(ks * 3 + ct) * 64 + lane]; } }
            asm volatile("" : "+v"(xa[0]), "+v"(xa[1]), "+v"(xa[2]), "+v"(xa[3]),
                              "+v"(wh[0][0]), "+v"(wh[0][1]), "+v"(wh[0][2]), "+v"(wh[1][0]), "+v"(wh[1][1]), "+v"(wh[1][2]), "+v"(wh[2][0]), "+v"(wh[2][1]), "+v"(wh[2][2]), "+v"(wh[3][0]), "+v"(wh[3][1]), "+v"(wh[3][2]));
#pragma unroll
            for (int i = 0; i < 4; ++i)
#pragma unroll
                for (int ct = 0; ct < 3; ++ct) { acc[ct] = MFMA16(wh[i][ct], xa[i], acc[ct]); acc[ct] = MFMA16(wl[i][ct], xa[i], acc[ct]); }
        }
#pragma unroll
        for (int ct = 0; ct < 3; ++ct)
#pragma unroll
            for (int j = 0; j < 4; ++j) lg[(lane & 15) * 48 + ct * 16 + g * 4 + j] = acc[ct][j];
        LDS_WAIT(); asm volatile("" ::: "memory");
        if (lane < 16) {
            const int t = t0 + lane; const float rs = row_rstd(ssq, t); const LAS float* L = lg + lane * 48;
            int gi = 0; float gm = L[32] * rs + bg[0];
            float gl[4]; gl[0] = gm;
#pragma unroll
            for (int j = 1; j < 4; ++j) { gl[j] = L[32 + j] * rs + bg[j]; if (gl[j] > gm) { gm = gl[j]; gi = j; } }
            float gs = 0.f;
#pragma unroll
            for (int j = 0; j < 4; ++j) gs += __expf(gl[j] - gm);
            const float gp = 1.0f / gs;
            int e1 = 0, e2 = 0; float l1 = -3.0e38f, l2 = -3.0e38f;
            for (int j = 0; j < 8; ++j) { const float v = L[gi * 8 + j] * rs + br[gi * 8 + j];
                if (v > l1) { l2 = l1; e2 = e1; l1 = v; e1 = j; } else if (v > l2) { l2 = v; e2 = j; } }
            const float p2 = __expf(l2 - l1), w1 = gp / (1.0f + p2), w2 = gp * p2 / (1.0f + p2);
            const int x1 = gi * 8 + e1, x2 = gi * 8 + e2;
            toke[t * 2] = x1; toke[t * 2 + 1] = x2; tokw[t * 2] = w1; tokw[t * 2 + 1] = w2;
            __hip_atomic_fetch_add(hist + x1, 1, __ATOMIC_RELAXED, __HIP_MEMORY_SCOPE_WORKGROUP); __hip_atomic_fetch_add(hist + x2, 1, __ATOMIC_RELAXED, __HIP_MEMORY_SCOPE_WORKGROUP);
        }
        LDS_WAIT(); asm volatile("" ::: "memory");
    }
    __syncthreads();
    if (F.tid < NEXP) __hip_atomic_fetch_add((GAS unsigned*)(ws + WS_CTL) + CW_CNT + l * 32 + F.tid, (unsigned)hist[F.tid], __ATOMIC_RELAXED, __HIP_MEMORY_SCOPE_AGENT);
}

__device__ __forceinline__ int moe_pad_table(Frame& F, int l, LAS int* pad_end) {
    if (F.wave == 0) {
        const int ln = lane_now(); const GAS unsigned* cnt = (const GAS unsigned*)(F.ws + WS_CTL) + CW_CNT + l * 32;
        const unsigned c = __hip_atomic_load(cnt + (ln & 31), __ATOMIC_RELAXED, __HIP_MEMORY_SCOPE_AGENT);
        int v = (ln < NEXP) ? (int)((c + 255u) & ~255u) : 0;
#pragma unroll
        for (int off = 1; off < 32; off <<= 1) { const int o = __builtin_amdgcn_ds_bpermute(((ln - off) & 63) << 2, v); if (ln >= off) v += o; }
        if (ln < NEXP) pad_end[ln] = v; }
    __syncthreads();
    return pad_end[NEXP - 1];
}

__device__ __forceinline__ void assign_gather_phase(Frame& F, int l) {
    GAS unsigned char* ws = F.ws;
    LAS int* pad_end = (LAS int*)(F.lds + LDS_MISC + 64);
    LAS int* lhist = (LAS int*)(F.lds + LDS_MISC + 256);
    LAS int* lbase = (LAS int*)(F.lds + LDS_MISC + 512);
    LAS int* aslot = (LAS int*)(F.lds);
    LAS int* atok = (LAS int*)(F.lds + 1024);
    moe_pad_table(F, l, pad_end);
    if ((int)blockIdx.x < NEXP) {
        const int e = blockIdx.x; const unsigned cnt = __hip_atomic_load((const GAS unsigned*)(ws + WS_CTL) + CW_CNT + l * 32 + e, __ATOMIC_RELAXED, __HIP_MEMORY_SCOPE_AGENT);
        const int p0 = (e ? pad_end[e - 1] : 0) + (int)cnt, p1 = pad_end[e];
        for (int sl = p0 + F.tid; sl < p1; sl += NTHREADS) { ((GAS int*)(ws + WS_SLOT + SL_TOK))[sl] = 0; ((GAS float*)(ws + WS_SLOT + SL_W))[sl] = 0.f; ((GAS float*)(ws + WS_SLOT + SL_RSTD))[sl] = 0.f; } }
    const GAS int* toke = (const GAS int*)(ws + WS_TAB + TAB_TOKE); const GAS float* tokw = (const GAS float*)(ws + WS_TAB + TAB_TOKW);
    GAS int* slot_tok = (GAS int*)(ws + WS_SLOT + SL_TOK); GAS float* slot_w = (GAS float*)(ws + WS_SLOT + SL_W); GAS float* slot_rstd = (GAS float*)(ws + WS_SLOT + SL_RSTD); GAS int* tok_slot = (GAS int*)(ws + WS_SLOT + SL_TSLOT);
    const GAS float* ssq = (const GAS float*)(ws + WS_SSQ);
    const GAS bf16_t* xb = (const GAS bf16_t*)(ws + WS_XB); GAS bf16_t* sa = (GAS bf16_t*)(ws + WS_SORTA);
    GAS unsigned* cur = (GAS unsigned*)(ws + WS_CTL) + CW_CUR + l * 32;
    for (int ch = blockIdx.x; ch < NTOK / 128; ch += F.G) {
        if (F.tid < NEXP) lhist[F.tid] = 0;
        __syncthreads();
        int e = 0, pos = 0, t = 0;
        if (F.tid < 256) { t = ch * 128 + (F.tid >> 1); e = toke[t * 2 + (F.tid & 1)]; pos = __hip_atomic_fetch_add(lhist + e, 1, __ATOMIC_RELAXED, __HIP_MEMORY_SCOPE_WORKGROUP); }
        __syncthreads();
        if (F.tid < NEXP) lbase[F.tid] = (int)__hip_atomic_fetch_add(cur + F.tid, (unsigned)lhist[F.tid], __ATOMIC_RELAXED, __HIP_MEMORY_SCOPE_AGENT);
        __syncthreads();
        if (F.tid < 256) { const int slot = (e ? pad_end[e - 1] : 0) + lbase[e] + pos;
            slot_tok[slot] = t; slot_w[slot] = tokw[t * 2 + (F.tid & 1)]; slot_rstd[slot] = row_rstd(ssq, t); tok_slot[t * 2 + (F.tid & 1)] = slot;
            aslot[F.tid] = slot; atok[F.tid] = t; }
        __syncthreads();
        __syncthreads();
    }
}

__device__ __forceinline__ void combine_phase(Frame& F, int l) {
    GAS unsigned char* ws = F.ws; const int lane = F.lane;
    const GAS int* tok_slot = (const GAS int*)(ws + WS_SLOT + SL_TSLOT); const GAS bf16_t* Y = (const GAS bf16_t*)(ws + WS_SORTA);
    GAS bf16_t* xb = (GAS bf16_t*)(ws + WS_XB); GAS float* ssq = (GAS float*)(ws + WS_SSQ);
    const GAS f32x4* fing = (const GAS f32x4*)F.inp(I_FING);
    for (int t0 = F.gw * 4; t0 < NTOK; t0 += F.ngw * 4) {
        int sl0[4], sl1[4];
#pragma unroll
        for (int k = 0; k < 4; ++k) { sl0[k] = tok_slot[(t0 + k) * 2]; sl1[k] = tok_slot[(t0 + k) * 2 + 1]; }
        f32x4 v[4][4]; u32x4 xa[4][2], ya[4][2], yb[4][2];
#pragma unroll
        for (int k = 0; k < 4; ++k) { const GAS u32x4* xr = (const GAS u32x4*)(xb + (size_t)(t0 + k) * DM) + lane;
            const GAS u32x4* y0 = (const GAS u32x4*)(Y + (size_t)sl0[k] * DM) + lane; const GAS u32x4* y1 = (const GAS u32x4*)(Y + (size_t)sl1[k] * DM) + lane;
#pragma unroll
            for (int j = 0; j < 2; ++j) { xa[k][j] = xr[64 * j]; ya[k][j] = y0[64 * j]; yb[k][j] = y1[64 * j]; } }
#pragma unroll
        for (int k = 0; k < 4; ++k) { const int t = t0 + k; float s = 0.f; u32x4 w[2];
#pragma unroll
            for (int j = 0; j < 2; ++j) { const u32x4 x = xa[k][j], a = ya[k][j], b = yb[k][j];
                f32x4& va = v[k][2 * j]; f32x4& vb = v[k][2 * j + 1];
                va.x = bflo(x.x) + bflo(a.x) + bflo(b.x); va.y = bfhi(x.x) + bfhi(a.x) + bfhi(b.x); va.z = bflo(x.y) + bflo(a.y) + bflo(b.y); va.w = bfhi(x.y) + bfhi(a.y) + bfhi(b.y);
                vb.x = bflo(x.z) + bflo(a.z) + bflo(b.z); vb.y = bfhi(x.z) + bfhi(a.z) + bfhi(b.z); vb.z = bflo(x.w) + bflo(a.w) + bflo(b.w); vb.w = bfhi(x.w) + bfhi(a.w) + bfhi(b.w);
                if (l == DEPTH - 1) s += ((va.x * va.x + va.y * va.y) + (va.z * va.z + va.w * va.w)) + ((vb.x * vb.x + vb.y * vb.y) + (vb.z * vb.z + vb.w * vb.w));
                else { w[j].x = pk2(va.x, va.y); w[j].y = pk2(va.z, va.w); w[j].z = pk2(vb.x, vb.y); w[j].w = pk2(vb.z, vb.w);
                    const float r0 = bflo(w[j].x), r1 = bfhi(w[j].x), r2 = bflo(w[j].y), r3 = bfhi(w[j].y), r4 = bflo(w[j].z), r5 = bfhi(w[j].z), r6 = bflo(w[j].w), r7 = bfhi(w[j].w);
                    s += ((r0 * r0 + r1 * r1) + (r2 * r2 + r3 * r3)) + ((r4 * r4 + r5 * r5) + (r6 * r6 + r7 * r7)); } }
            s = wave_sum(s);
            if (l == DEPTH - 1) { const float rs = rsqrtf(s * (1.0f / DM) + EPS); GAS f32x4* orow = (GAS f32x4*)(F.out + (size_t)t * DM) + lane * 2;
#pragma unroll
                for (int j = 0; j < 2; ++j) { orow[128 * j] = v[k][2 * j] * rs * fing[lane * 2 + 128 * j]; orow[128 * j + 1] = v[k][2 * j + 1] * rs * fing[lane * 2 + 128 * j + 1]; }
            } else {
                GAS u32x4* o16 = (GAS u32x4*)(xb + (size_t)t * DM) + lane;
#pragma unroll
                for (int j = 0; j < 2; ++j) o16[64 * j] = w[j];
                if (lane < 16) ssq[(size_t)t * 16 + lane] = (lane == 0) ? s : 0.f;
                if (lane == 0) ((GAS float*)(ws + WS_TAB + TAB_RSTD))[t] = rsqrtf(s * (1.0f / DM) + EPS);
            } }
    }
}

__device__ __forceinline__ void ab_phase(Frame& F, int l) {
    const int lane = lane_now(), g = lane >> 4, ql = lane & 15;
    const GAS bf16_t* xb = (const GAS bf16_t*)(F.ws + WS_XB); const GAS float* ssq = (const GAS float*)(F.ws + WS_SSQ); GAS float* ab = (GAS float*)(F.ws + WS_AB);
    const GAS bf16x8* fr = (const GAS bf16x8*)(F.ws + WS_TAB + TAB_ABF) + (size_t)l * 2048;
    for (int tile = F.gw; tile < NTOK / 16; tile += F.ngw) {
        const int t = tile * 16 + ql; const GAS bf16_t* xr = xb + (size_t)t * DM + g * 8;
        f32x4 acc = (f32x4){0.f, 0.f, 0.f, 0.f};
#pragma unroll
        for (int kb = 0; kb < 2; ++kb) { bf16x8 a[16], x[16];
#pragma unroll
            for (int i = 0; i < 16; ++i) { a[i] = fr[(kb * 16 + i) * 64 + lane]; x[i] = *(const GAS bf16x8*)(xr + (kb * 16 + i) * 32); }
            asm volatile("" : "+v"(x[0]), "+v"(x[1]), "+v"(x[2]), "+v"(x[3]), "+v"(x[4]), "+v"(x[5]), "+v"(x[6]), "+v"(x[7]), "+v"(x[8]), "+v"(x[9]), "+v"(x[10]), "+v"(x[11]), "+v"(x[12]), "+v"(x[13]), "+v"(x[14]), "+v"(x[15]),
                              "+v"(a[0]), "+v"(a[2]), "+v"(a[4]), "+v"(a[6]), "+v"(a[8]), "+v"(a[10]), "+v"(a[12]), "+v"(a[14]));
#pragma unroll
            for (int i = 0; i < 16; ++i) acc = MFMA16(a[i], x[i], acc); }
        const float rs = ((const GAS float*)(F.ws + WS_TAB + TAB_RSTD))[t];
        *(GAS f32x4*)(ab + (size_t)t * 16 + g * 4) = acc * rs;
    }
}

constexpr int PH_PRO = 0, PH_KV = 1, PH_FOLD = 2, PH_L0 = 3, PPL = 12, NPH = PH_L0 + DEPTH * PPL;
enum { LP_INPROJ = 0, LP_MIX, LP_MIX2, LP_FIN, LP_OUTPROJ, LP_SCORES, LP_PV, LP_ROUTER, LP_ASSIGN, LP_GATEUP, LP_DOWN, LP_COMBINE };

struct Args { const float* in[28]; float* out; unsigned char* ws; int ph_lo, ph_hi, mode, pad; };

__global__ void __launch_bounds__(NTHREADS, 2) fwd_kernel(Args args) {
    extern __shared__ __attribute__((aligned(16))) unsigned char lds_raw[];
    Frame F;
    F.lds = (LAS unsigned char*)lds_raw;
    F.tid = threadIdx.x; F.lane = F.tid & 63; F.wave = __builtin_amdgcn_readfirstlane(F.tid >> 6);
    F.G = gridDim.x; F.gw = blockIdx.x * NWAVES + F.wave; F.ngw = F.G * NWAVES;
    F.ka = (const CAS unsigned char*)__builtin_amdgcn_kernarg_segment_ptr();
    F.out = (GAS float*)args.out; F.ws = (GAS unsigned char*)args.ws;
    GAS unsigned char* ws0 = (GAS unsigned char*)args.ws;
    for (int u = F.tid; u < (LDS_BYTES - LDS_MISC) / 4; u += NTHREADS) ((LAS unsigned*)(F.lds + LDS_MISC))[u] = 0u;
    __syncthreads();
    const int lo = args.ph_lo, hi = args.ph_hi;
    XcdBarrier bar; bar.bar = (GAS unsigned*)(ws0 + WS_CTL) + CW_BAR; bar.x = 0; bar.st = (volatile LAS unsigned*)(F.lds + LDS_MISC);
    if (hi - lo > 1) bar = xcd_barrier_post((GAS unsigned*)(ws0 + WS_CTL) + CW_BAR, (volatile LAS unsigned*)(F.lds + LDS_MISC), F.tid == 0);
#ifndef LPMASK
#define LPMASK 0xfff
#endif
#ifndef PMASK
#define PMASK 7
#endif
#define IN(k) (lo <= (k) && (k) < hi)
#define INP(k) (((PMASK >> (k)) & 1) && IN(k))
#define INL(k) (((LPMASK >> (k)) & 1) && IN(pb + (k)))
#define SEAM(k) do { if (IN(k) && IN((k) + 1)) { unsigned _z = 0u; asm volatile("" : "+v"(_z));   \
        xcd_barrier(bar, F.wave == 0 && __builtin_amdgcn_mbcnt_hi(~0u, __builtin_amdgcn_mbcnt_lo(~0u, _z)) == 0u); } } while (0)
#define PH_ENTER() int c_id; GAS unsigned char* ws; do { unsigned _z0 = 0u; asm volatile("" : "+v"(_z0)); int _t = F.wave * 64 + (int)__builtin_amdgcn_mbcnt_hi(~0u, __builtin_amdgcn_mbcnt_lo(~0u, _z0)); asm volatile("" : "+v"(_t)); F.tid = _t; F.lane = _t & 63; GAS unsigned char* _w = (GAS unsigned char*)args.ws; asm volatile("" : "+s"(_w)); F.ws = _w; ws = _w; \
        GAS float* _o = (GAS float*)args.out; asm volatile("" : "+s"(_o)); F.out = _o;     int _c = blockIdx.x; asm volatile("" : "+s"(_c)); c_id = _c; F.gw = _c * NWAVES + F.wave; } while (0)

    if (INP(PH_PRO)) { PH_ENTER(); (void)c_id; (void)ws; p0_prologue(F); }
    SEAM(PH_PRO);

    for (int l = 0; l < DEPTH; ++l) {
        const int pb = PH_L0 + l * PPL;
        if (INL(LP_INPROJ)) { PH_ENTER();
            OrdInProj S{(const GAS char*)(ws + WS_XB), (const GAS char*)(ws + WS_WIN) + (size_t)l * PINP * DM * 2, (size_t)256 * DM * 2, NTOK / 256, PINP / 256, F.G, c_id};
            EpiProj E{(GAS bf16_t*)(ws + WS_PROJ), (GAS float*)(ws + WS_AB), (const GAS float*)(ws + WS_TAB + TAB_RSTD), (GAS bf16_t*)(ws + WS_VTA)};
            pg8::gemm_phase<EpiProj, OrdInProj>(F.lds, F.tid, pg8::Gemm{DM, DM, DM}, S, E);
            ab_phase(F, l);
            if (l == 0) { PH_ENTER();
                OrdKV S{(const GAS char*)(ws + WS_MEMN), (const GAS char*)(ws + WS_WKV), F.G, c_id};
                EpiBf E{(GAS bf16_t*)(ws + WS_KV), 2048};
                pg8::gemm_phase<EpiBf, OrdKV>(F.lds, F.tid, pg8::Gemm{DM, DM, DM}, S, E); }
        }
        SEAM(pb + LP_INPROJ);
        if (INL(LP_MIX) && l == 0) {
            { PH_ENTER(); OrdKq S{(const GAS char*)(ws + WS_KV), (const GAS char*)(ws + WS_WQB), F.G, c_id}; EpiBf E{(GAS bf16_t*)(ws + WS_KQT), DM};
              int kf = 256; asm volatile("" : "+s"(kf)); pg8::gemm_phase<EpiBf, OrdKq>(F.lds, F.tid, pg8::Gemm{2048, DM, kf}, S, E); }
            { PH_ENTER(); OrdVo S{(const GAS char*)(ws + WS_KV), (const GAS char*)(ws + WS_WOT), F.G, (c_id + 128) % F.G}; EpiBf E{(GAS bf16_t*)(ws + WS_VOT), DM};
              int kf = 256; asm volatile("" : "+s"(kf)); pg8::gemm_phase<EpiBf, OrdVo>(F.lds, F.tid, pg8::Gemm{DM, 2048, kf}, S, E); }
        }
        if (INL(LP_MIX)) { PH_ENTER();
            GAS bf16_t* proj = (GAS bf16_t*)(ws + WS_PROJ); GAS bf16_t* ycat = (GAS bf16_t*)(ws + WS_YCAT);
            const GAS float* rope = (const GAS float*)(ws + WS_TAB + TAB_ROPE);
            if (args.mode != 2 && args.mode != 4) {   const GAS bf16_t* pt = (const GAS bf16_t*)(ws + WS_TAB + TAB_POOL) + (size_t)l * 4 * 64 * 64;
                const GAS float* rpb = F.inp(I_RPB) + (size_t)l * 4 * 15 * 31;
                LAS float* rpbs = (LAS float*)(F.lds);
                for (int i = F.tid; i < 4 * 465; i += NTHREADS) rpbs[i] = rpb[i];
                __syncthreads();
                const int gws = ((F.G & 7) == 0 ? (c_id & 7) * (F.G >> 3) + (c_id >> 3) : c_id) * NWAVES + F.wave;
                if (args.mode == 0 && F.G == 256) {
                    na_rounds(F, proj, (const GAS bf16_t*)(ws + WS_VTA), rpbs, ycat, (c_id & 7) * 32 + (c_id >> 3));
                    pool_item(F, proj, pt, ycat, gws);
                } else
                for (int it = gws; it < 8192 + NTOK / 16; it += F.ngw) {
                    if (it < 8192) { if (args.mode != 3) na_item(F, proj, (const GAS bf16_t*)(ws + WS_VTA), rpbs, ycat, it); } else if (args.mode != 1) pool_item(F, proj, pt, ycat, it - 8192);
                }
                __syncthreads(); }
            if (args.mode == 0) for (int item = blockIdx.x; item < 1024; item += F.G) ret_r1_item(F, proj, rope, (GAS bf16_t*)(ws + WS_RET), item);
            const GAS float* convw = F.inp(I_CONVW) + (size_t)l * 4 * 768; const GAS float* alog = F.inp(I_ALOG) + l * 8; const GAS float* dtb = F.inp(I_DTB) + l * 8;
            if (args.mode != 1 && args.mode != 3 && args.mode != 4) {
                LAS float* cw0 = (LAS float*)(F.lds + 129792); LAS float* cw1 = (LAS float*)(F.lds + 134912); const bool cwok = (F.G == 256);
                const int stid = F.wave * 64 + lane_now();
                if (cwok && stid < 384) { const int hs = stid / 192, q = stid % 192, tap = q / 48, r = q % 48, part = r / 16, c4 = r % 16; const int hh = ((((int)blockIdx.x >> 7) & 3) + 2 * hs) & 3;
                    const f32x4 w = *(const GAS f32x4*)(convw + tap * 768 + part * 256 + hh * 64 + c4 * 4); *(LAS f32x4*)((hs ? cw1 : cw0) + (tap * 3 + part) * 64 + c4 * 4) = w; }
                __syncthreads();
                for (int item = blockIdx.x; item < 2048; item += F.G) gdn_g1_item(F, proj, (const GAS float*)(ws + WS_AB), convw, alog, dtb, ws + WS_MIXS, item, cwok ? (((item >> 8) & 1) ? cw1 : cw0) : nullptr); }
        }
        SEAM(pb + LP_MIX);
        if (INL(LP_MIX2)) { PH_ENTER(); (void)c_id;
            const int nsc = (F.G >= 256) ? 128 : 0;
            if (nsc == 0) { for (int ch = blockIdx.x; ch < 128; ch += F.G) gdn_scan_block(F, ws + WS_MIXS, (GAS bf16_t*)((GAS unsigned char*)F.out + 16 * MiB), ch);
                ret_r2_scan(F, (const GAS bf16_t*)(ws + WS_RET), (GAS bf16_t*)F.out, (size_t)blockIdx.x * NTHREADS + F.tid, (size_t)F.G * NTHREADS); }
            else if ((int)blockIdx.x < nsc) { const int cb = blockIdx.x, chain = (((cb & 7) * 4 + (cb >> 5)) * 4) + ((cb >> 3) & 3);
                gdn_scan_block(F, ws + WS_MIXS, (GAS bf16_t*)((GAS unsigned char*)F.out + 16 * MiB), chain); __syncthreads(); }
            else { const int wb = (int)blockIdx.x - nsc, nwb = F.G - nsc;
                ret_r2_scan(F, (const GAS bf16_t*)(ws + WS_RET), (GAS bf16_t*)F.out, (size_t)wb * NTHREADS + F.tid, (size_t)nwb * NTHREADS); }
            convert_experts_queue(F, l);
        }
        SEAM(pb + LP_MIX2);
        if (INL(LP_FIN)) { PH_ENTER(); (void)c_id;
            const GAS float* retg = F.inp(I_RETG) + l * 256; const GAS float* gdng = F.inp(I_GDNG) + l * 64;
            for (int item = blockIdx.x; item < 1024; item += F.G) ret_r3_item(F, (const GAS bf16_t*)(ws + WS_PROJ), (const GAS bf16_t*)F.out, retg, (GAS bf16_t*)(ws + WS_YCAT), item);
            gdn_finalize(F, (const GAS bf16_t*)(ws + WS_PROJ), (const GAS bf16_t*)((GAS unsigned char*)F.out + 16 * MiB), gdng, (GAS bf16_t*)(ws + WS_YCAT), F.gw, F.ngw);
        }
        SEAM(pb + LP_FIN);
        if (INL(LP_OUTPROJ)) { PH_ENTER();
            OrdStd S{(const GAS char*)(ws + WS_YCAT), (const GAS char*)(ws + WS_WOUT) + (size_t)l * DM * DM * 2, (size_t)256 * DM * 2, (size_t)256 * DM * 2, 0, NTOK / 256, 4, F.G, c_id};
            EpiResid E{(GAS bf16_t*)(ws + WS_XB), (GAS float*)(ws + WS_SSQ)};
            pg8::gemm_phase<EpiResid, OrdStd>(F.lds, F.tid, pg8::Gemm{DM, DM, DM}, S, E);
        }
        SEAM(pb + LP_OUTPROJ);
        if (INL(LP_SCORES)) { PH_ENTER();
            OrdStd S{(const GAS char*)(ws + WS_XB), (const GAS char*)(ws + WS_KQT) + (size_t)l * 4 * DM * DM * 2, (size_t)256 * DM * 2, (size_t)256 * DM * 2, (size_t)DM * DM * 2, NTOK / 256, 4, F.G, c_id};
            EpiSoftmax E{(GAS bf16_t*)(ws + WS_P), (const GAS float*)(ws + WS_SSQ), (LAS float*)(F.lds + LDS_EX)};
            pg8::gemm_phase<EpiSoftmax, OrdStd>(F.lds, F.tid, pg8::Gemm{DM, DM, DM}, S, E);
        }
        SEAM(pb + LP_SCORES);
        if (INL(LP_PV)) { PH_ENTER();
            OrdStd S{(const GAS char*)(ws + WS_P), (const GAS char*)(ws + WS_VOT) + (size_t)l * 4 * DM * DM * 2, (size_t)256 * DM * 2, (size_t)256 * DM * 2, (size_t)DM * DM * 2, NTOK / 256, 4, F.G, c_id};
            EpiResid E{(GAS bf16_t*)(ws + WS_XB), (GAS float*)(ws + WS_SSQ)};
            pg8::gemm_phase<EpiResid, OrdStd, false, true>(F.lds, F.tid, pg8::Gemm{DM, DM, DM}, S, E);
        }
        SEAM(pb + LP_PV);
        if (INL(LP_ROUTER)) { PH_ENTER(); (void)c_id; (void)ws; router_phase(F, l); }
        SEAM(pb + LP_ROUTER);
        if (INL(LP_ASSIGN)) { PH_ENTER(); (void)c_id; (void)ws; assign_gather_phase(F, l); }
        SEAM(pb + LP_ASSIGN);
        if (INL(LP_GATEUP)) { PH_ENTER();
            LAS int* pad_end = (LAS int*)(F.lds + LDS_MISC + 64);
            const int total = moe_pad_table(F, l, pad_end);
            int cs = ((F.G & 7) == 0) ? (c_id & 7) * (F.G >> 3) + (c_id >> 3) : c_id; asm volatile("" : "+s"(cs));
            OrdMoE S{(const GAS char*)(ws + WS_XB), (const GAS char*)(ws + WS_WGU), (size_t)0, (size_t)1024 * DM * 2, (size_t)256 * DM * 2, (total / 256) * 4, pad_end, F.G, cs, (const GAS int*)(ws + WS_SLOT + SL_TOK), (GAS unsigned*)(ws + WS_CTL) + CW_PAN + l * 320 * 16, 0};
            EpiGateUp E{(GAS bf16_t*)(ws + WS_HMID), (const GAS float*)(ws + WS_SLOT + SL_RSTD)};
            pg8::gemm_phase<EpiGateUp, OrdMoE, true, false, true>(F.lds, F.tid, pg8::Gemm{DM, DM, DM}, S, E);
        }
        if (INL(LP_DOWN)) { PH_ENTER();
            LAS int* pad_end = (LAS int*)(F.lds + LDS_MISC + 64);
            const int total = moe_pad_table(F, l, pad_end);
            int cs = ((F.G & 7) == 0) ? (c_id & 7) * (F.G >> 3) + (c_id >> 3) : c_id; const int nu = (total / 256) * 4, rem = nu % F.G; cs -= rem; if (cs < 0) cs += F.G; cs = __builtin_amdgcn_readfirstlane(cs); const int bal = __builtin_amdgcn_readfirstlane((3 * rem <= F.G && nu >= 2 * F.G) ? 1 : 0);
            OrdMoE S{(const GAS char*)(ws + WS_HMID), (const GAS char*)(ws + WS_WD), (size_t)256 * DEXP * 2, (size_t)1024 * DEXP * 2, (size_t)256 * DEXP * 2, (total / 256) * 4, pad_end, F.G, cs, nullptr, (GAS unsigned*)(ws + WS_CTL) + CW_PAN + l * 320 * 16, bal};
            EpiDown E{(GAS bf16_t*)(ws + WS_SORTA), (const GAS float*)(ws + WS_SLOT + SL_W)};
            pg8::gemm_phase<EpiDown, OrdMoE, false, true, true>(F.lds, F.tid, pg8::Gemm{DEXP, DEXP, DEXP}, S, E);
        }
        SEAM(pb + LP_DOWN);
        if (INL(LP_COMBINE)) { PH_ENTER(); (void)c_id; (void)ws; combine_phase(F, l); }
        SEAM(pb + LP_COMBINE);
    }
#undef IN
#undef SEAM
}

extern "C" void kernel_launch(void* const* d_in, const int* in_sizes, int n_in, void* d_out, int out_size, void* d_ws, size_t ws_size, hipStream_t stream) {
    static int grid = 0;
    if (grid == 0) {
        if (n_in != 28 || out_size != NTOK * DM || ws_size < WS_END) { fprintf(stderr, "kernel_launch: unexpected shapes (n_in %d out %d ws %zu need %zu)\n", n_in, out_size, ws_size, (size_t)WS_END); grid = -1; return; }
        int dev = 0, cus = 0;
        if (hipGetDevice(&dev) != hipSuccess || hipDeviceGetAttribute(&cus, hipDeviceAttributeMultiprocessorCount, dev) != hipSuccess) { grid = -1; return; }
        if (hipFuncSetAttribute((const void*)fwd_kernel, hipFuncAttributeMaxDynamicSharedMemorySize, LDS_BYTES) != hipSuccess) { grid = -1; return; }
        int per_cu = 0;
        if (hipOccupancyMaxActiveBlocksPerMultiprocessor(&per_cu, (const void*)fwd_kernel, NTHREADS, LDS_BYTES) != hipSuccess || per_cu < 1) { fprintf(stderr, "occupancy query: %d\n", per_cu); }
        (void)hipGetLastError();
        grid = cus;
    }
    if (grid < 0) return;
    (void)hipMemsetAsync((char*)d_ws + WS_CTL, 0, CTL_ZERO_BYTES, stream);
    Args a{};
    for (int i = 0; i < 28; ++i) a.in[i] = (const float*)d_in[i];
    a.out = (float*)d_out; a.ws = (unsigned char*)d_ws;
#if MK_ONE_LAUNCH
    a.ph_lo = 0; a.ph_hi = NPH;
    hipLaunchKernelGGL(fwd_kernel, dim3(grid), dim3(NTHREADS), LDS_BYTES, stream, a);
#else
#ifndef PROBE_PH
#define PROBE_PH -1
#endif
#ifndef PROBE_REPS
#define PROBE_REPS 1
#endif
    for (int p = 0; p < NPH; ++p) { a.ph_lo = p; a.ph_hi = p + 1; const int reps = (PROBE_PH >= 0 && (p == PROBE_PH || p == PROBE_PH + PPL)) ? 1 + PROBE_REPS : 1;
#ifndef PROBE_MODE
#define PROBE_MODE 0
#endif
        for (int r = 0; r < reps; ++r) { a.mode = (r > 0) ? PROBE_MODE : 0; hipLaunchKernelGGL(fwd_kernel, dim3(grid), dim3(NTHREADS), LDS_BYTES, stream, a); } a.mode = 0; }
#endif
}
```
